# Optimizing an MI355X kernel written in HIP

```python
import jax, jax.numpy as jnp
from jax import lax
import numpy as np

D_MODEL = 1024
BATCH = 4
SEQ = 4096
DEPTH = 2

RET_HEADS = 4
RET_QK_DIM = D_MODEL // RET_HEADS
RET_V_DIM = 2 * RET_QK_DIM
RET_QK_W = RET_HEADS * RET_QK_DIM
RET_V_W = RET_HEADS * RET_V_DIM
RET_CHUNK = 128
ROPE_BASE = 10000.0
SB_HEADS = 16
SB_DIM = 64
SB_W = SB_HEADS * SB_DIM
SB_BLOCK = 128
D_FF = 4 * D_MODEL
N_MOD = 6
EPS = 1e-6
GN_EPS = 1e-5
IN_SPLITS = (RET_QK_W, RET_QK_W, RET_V_W, RET_V_W, SB_W, SB_W, SB_W, D_MODEL, D_MODEL)
IN_W = sum(IN_SPLITS)

kernel_name = "hybrid_retention_stickbreaking_gated_block"


def _rmsnorm(x, g):
    xf = x.astype(jnp.float32)
    y = xf * lax.rsqrt(jnp.mean(xf * xf, axis=-1, keepdims=True) + EPS)
    return (y * g.astype(jnp.float32)).astype(x.dtype)


def _modulate(h, shift, scale):
    return h * (1.0 + scale[:, None, :]) + shift[:, None, :]


def _heads(t, n_heads):
    b, s, w = t.shape
    return t.reshape(b, s, n_heads, w // n_heads).transpose(0, 2, 1, 3)


def _merge_heads(t):
    b, h, s, d = t.shape
    return t.transpose(0, 2, 1, 3).reshape(b, s, h * d)


def _rotary(t):
    s, d = t.shape[2], t.shape[3]
    half = d // 2
    inv_freq = jnp.power(ROPE_BASE, -jnp.arange(half, dtype=jnp.float32) / half)
    ang = jnp.arange(s, dtype=jnp.float32)[:, None] * inv_freq[None, :]
    cos, sin = jnp.cos(ang), jnp.sin(ang)
    t1, t2 = t[..., :half], t[..., half:]
    return jnp.concatenate([t1 * cos - t2 * sin, t1 * sin + t2 * cos], axis=-1)


def _retention(q, k, v):
    out_dtype = v.dtype
    q = q.astype(jnp.float32)
    k = k.astype(jnp.float32) * (q.shape[-1] ** -0.5)
    v = v.astype(jnp.float32)
    b, h, s, dk = q.shape
    dv = v.shape[-1]
    c = RET_CHUNK
    n = s // c
    log_gamma = jnp.log1p(-jnp.power(2.0, -5.0 - jnp.arange(h, dtype=jnp.float32)))
    idx = jnp.arange(c, dtype=jnp.float32)
    rel = idx[:, None] - idx[None, :]
    decay = jnp.where(rel >= 0, jnp.exp(jnp.maximum(rel, 0.0) * log_gamma[:, None, None]), 0.0)
    xi = jnp.exp((idx + 1.0) * log_gamma[:, None])
    zeta = jnp.exp((c - 1.0 - idx) * log_gamma[:, None])
    gamma_c = jnp.exp(c * log_gamma)

    qc = q.reshape(b, h, n, c, dk)
    kc = k.reshape(b, h, n, c, dk)
    vc = v.reshape(b, h, n, c, dv)
    scores = jnp.einsum('bhncd,bhnmd->bhncm', qc, kc) * decay[None, :, None]
    o_inner = jnp.einsum('bhncm,bhnme->bhnce', scores, vc)

    def step(r, qkv):
        qn, kn, vn = qkv
        cross = jnp.einsum('bhcd,bhde->bhce', qn, r) * xi[None, :, :, None]
        r_new = r * gamma_c[None, :, None, None] + jnp.einsum(
            'bhcd,bhce->bhde', kn * zeta[None, :, :, None], vn)
        return r_new, cross

    r0 = jnp.zeros((b, h, dk, dv), jnp.float32)
    xs = (jnp.moveaxis(qc, 2, 0), jnp.moveaxis(kc, 2, 0), jnp.moveaxis(vc, 2, 0))
    _, o_cross = lax.scan(step, r0, xs)
    o = (o_inner + jnp.moveaxis(o_cross, 0, 2)).reshape(b, h, s, dv)
    mu = jnp.mean(o, axis=-1, keepdims=True)
    var = jnp.mean(jnp.square(o - mu), axis=-1, keepdims=True)
    return ((o - mu) * lax.rsqrt(var + GN_EPS)).astype(out_dtype)


def _stick_breaking(q, k, v):
    out_dtype = v.dtype
    b, h, s, d = q.shape
    nb = s // SB_BLOCK
    kf = k.astype(jnp.float32)
    vf = v.astype(jnp.float32)
    qb = jnp.moveaxis(q.astype(jnp.float32).reshape(b, h, nb, SB_BLOCK, d), 2, 0)
    kpos = jnp.arange(s)
    scale = d ** -0.5

    def block(args):
        qi, i = args
        qpos = i * SB_BLOCK + jnp.arange(SB_BLOCK)
        causal = kpos[None, :] < qpos[:, None]
        z = jnp.einsum('bhtd,bhsd->bhts', qi, kf) * scale
        log_1m_beta = jnp.where(causal, -jax.nn.softplus(z), 0.0)
        rev_incl = lax.cumsum(log_1m_beta, axis=3, reverse=True)
        rev_excl = jnp.concatenate([rev_incl[..., 1:], jnp.zeros_like(rev_incl[..., :1])], axis=-1)
        a = jnp.where(causal, jnp.exp(jax.nn.log_sigmoid(z) + rev_excl), 0.0)
        return jnp.einsum('bhts,bhsd->bhtd', a, vf)

    out = lax.map(block, (qb, jnp.arange(nb)))
    return jnp.moveaxis(out, 0, 2).reshape(b, h, s, d).astype(out_dtype)


def _mixer(h, w_in, w_ret_out, w_sb_out, w_mix_out):
    p = h @ w_in
    offsets = [int(o) for o in np.cumsum(IN_SPLITS)[:-1]]
    rq, rk, rv, rg, sq, sk, sv, ga, gb = jnp.split(p, offsets, axis=-1)
    y_ret = _retention(_rotary(_heads(rq, RET_HEADS)), _rotary(_heads(rk, RET_HEADS)), _heads(rv, RET_HEADS))
    y_a = (jax.nn.silu(rg) * _merge_heads(y_ret)) @ w_ret_out
    y_sb = _stick_breaking(_heads(sq, SB_HEADS), _heads(sk, SB_HEADS), _heads(sv, SB_HEADS))
    y_b = _merge_heads(y_sb) @ w_sb_out
    merged = jax.nn.sigmoid(ga) * y_a + jax.nn.sigmoid(gb) * y_b
    return merged @ w_mix_out


def setup_inputs(seed: int = 0) -> dict:
    key = jax.random.key(seed)
    ks = jax.random.split(key, 16)
    f32 = jnp.float32

    def w(k, shape, fan_in):
        return jax.random.normal(k, shape, f32) * (fan_in ** -0.5)

    def gain(k, shape):
        return 1.0 + 0.02 * jax.random.normal(k, shape, f32)

    return {
        "x": jax.random.normal(ks[0], (BATCH, SEQ, D_MODEL), f32),
        "c": jax.random.normal(ks[1], (BATCH, D_MODEL), f32),
        "norm_mix_g": gain(ks[2], (DEPTH, D_MODEL)),
        "w_in": w(ks[3], (DEPTH, D_MODEL, IN_W), D_MODEL),
        "w_ret_out": w(ks[4], (DEPTH, RET_V_W, D_MODEL), RET_V_W),
        "w_sb_out": w(ks[5], (DEPTH, SB_W, D_MODEL), SB_W),
        "w_mix_out": w(ks[6], (DEPTH, D_MODEL, D_MODEL), D_MODEL),
        "norm_mlp_g": gain(ks[7], (DEPTH, D_MODEL)),
        "w_up": w(ks[8], (DEPTH, D_MODEL, D_FF), D_MODEL),
        "w_down": w(ks[9], (DEPTH, D_FF, D_MODEL), D_FF),
        "w_ada": w(ks[10], (DEPTH, D_MODEL, N_MOD * D_MODEL), D_MODEL),
        "b_ada": 0.02 * jax.random.normal(ks[11], (DEPTH, N_MOD * D_MODEL), f32),
        "final_g": gain(ks[12], (D_MODEL,)),
    }


def reference(x, c, norm_mix_g, w_in, w_ret_out, w_sb_out, w_mix_out, norm_mlp_g,
              w_up, w_down, w_ada, b_ada, final_g):
    c_act = jax.nn.silu(c)
    for l in range(DEPTH):
        mod = c_act @ w_ada[l] + b_ada[l]
        shift1, scale1, gate1, shift2, scale2, gate2 = jnp.split(mod, N_MOD, axis=-1)
        h = _modulate(_rmsnorm(x, norm_mix_g[l]), shift1, scale1)
        x = x + gate1[:, None, :] * _mixer(h, w_in[l], w_ret_out[l], w_sb_out[l], w_mix_out[l])
        h2 = _modulate(_rmsnorm(x, norm_mlp_g[l]), shift2, scale2)
        u = jnp.square(jax.nn.relu(h2 @ w_up[l]))
        x = x + gate2[:, None, :] * (u @ w_down[l])
    return _rmsnorm(x, final_g)
```

```cpp
#include <hip/hip_runtime.h>
#include <hip/hip_cooperative_groups.h>
#include <cstdio>
#include <cstdint>
namespace cg = cooperative_groups;
#define DI __device__ __forceinline__
namespace pg8 {
#define PG8_LAS __attribute__((address_space(3)))
typedef unsigned short bf16_t;
typedef short bf16x8 __attribute__((ext_vector_type(8)));
typedef float f32x4 __attribute__((ext_vector_type(4)));
typedef unsigned u32x4 __attribute__((ext_vector_type(4)));
constexpr int BM = 256, BK = 64, HALF = 128, HTB = HALF * BK * 2  , STAGE_BYTES = 8 * HTB, NXCD = 8, WGM = 8;

__host__ __device__ __forceinline__ int lds_byte(int r, int c) { const int st = (r >> 4) * 2 + (c >> 5), rr = r & 15, cc = c & 31, ob = rr * 64 + cc * 2; return st * 1024 + (ob ^ (((ob >> 9) & 1) << 5)); }
__host__ __device__ __forceinline__ void stage_rc(int b, int& R, int& C) { const int st = b / 1024, sb = b % 1024, swz = sb ^ (((sb >> 9) & 1) << 5); R = (st >> 1) * 16 + swz / 64; C = (st & 1) * 32 + (swz % 64) / 2; }
__host__ __device__ __forceinline__ int perm32(int rho) { const int n = rho >> 4, i = rho & 15; return 8 * (i >> 2) + 4 * n + (i & 3); }

struct Unit { int pm, pn; };
struct Gemm { const bf16_t* A; const bf16_t* Bt; int M, N, K; };

struct StaticOrder {
    int nM, nN, nwg, G, c;
    __host__ __device__ void init(int M, int N, int G_, int c_) { nM = M / BM; nN = N / BM; nwg = nM * nN; G = G_; c = c_; }
    __host__ __device__ bool next(int i, Unit& u) const {
        const long L = (long)i * G + c; if (L >= nwg) return false;
        int wgid = (int)L; { const int q = nwg / NXCD, r = nwg % NXCD, xcd = wgid % NXCD, off = wgid / NXCD; wgid = (xcd < r ? xcd * (q + 1) : r * (q + 1) + (xcd - r) * q) + off; }
        const int nig = WGM * nN, gid = wgid / nig, fm = gid * WGM, gsz = (nM - fm) < WGM ? (nM - fm) : WGM;
        u.pm = fm + ((wgid % nig) % gsz); u.pn = (wgid % nig) / gsz; return true;
    }
    __device__ __forceinline__ void a_ready(const Unit&) const {}
    __device__ __forceinline__ void done(const Unit&) const {}
};

template <class Epi, class Sched, bool ALIGN_EPI = false, bool SP2 = false>
__device__ __forceinline__ void gemm_phase(PG8_LAS unsigned char* lds, const Gemm g, const Sched& S, const Epi& E) {
    int tid_l = threadIdx.x; asm volatile("" : "+v"(tid_l)); const int tid = tid_l, wid = __builtin_amdgcn_readfirstlane(tid >> 6), lane = tid & 63, wr = wid >> 2, wc = wid & 3, fr = lane & 15, fq = lane >> 4;
    const int K = g.K, nt = K / BK;
    unsigned voffA[2], voffB[2];
#pragma unroll
    for (int i = 0; i < 2; ++i) { int R, C; stage_rc(tid * 16 + i * 8192, R, C); const int Rb = Epi::PERM ? ((R & ~31) + perm32(R & 31)) : R;
        voffA[i] = (unsigned)(R * K + C) * 2u; voffB[i] = (unsigned)(Rb * K + C) * 2u; }
    const size_t kstep = (size_t)(BK * 2);
    const size_t hstep = (size_t)HALF * K * 2;
    const size_t tstep = 2 * hstep;
    const unsigned ldsw = (unsigned)wid * 1024u;
    const int aoff = lds_byte(wr * 64 + fr, fq * 8), boff = lds_byte(wc * 32 + fr, fq * 8);
#define PG8_SA(b, h) (((b) * 2 + (h)) * HTB)
#define PG8_SB(b, h) ((4 + (b) * 2 + (h)) * HTB)
#define PG8_STAGE(bufoff, gbase, voff) do { _Pragma("unroll") for (int _i = 0; _i < 2; ++_i) \
        __builtin_amdgcn_global_load_lds((const unsigned*)((const char*)(gbase) + (voff)[_i]), (PG8_LAS unsigned*)(lds + (bufoff) + ldsw + _i * 8192), 16, 0, 0); } while (0)
#define PG8_LDA(dst, b, h) do { _Pragma("unroll") for (int m = 0; m < 4; ++m) _Pragma("unroll") for (int k = 0; k < 2; ++k) dst[m][k] = *(const PG8_LAS bf16x8*)(lds + PG8_SA(b, h) + aoff + m * 2048 + k * 1024); } while (0)
#define PG8_LDB(dst, b, h) do { _Pragma("unroll") for (int n = 0; n < 2; ++n) _Pragma("unroll") for (int k = 0; k < 2; ++k) dst[n][k] = *(const PG8_LAS bf16x8*)(lds + PG8_SB(b, h) + boff + n * 2048 + k * 1024); } while (0)
#define PG8_MMA(ai, bj, At, Bt) do { __builtin_amdgcn_s_setprio(1); _Pragma("unroll") for (int m = 0; m < 4; ++m) _Pragma("unroll") for (int n = 0; n < 2; ++n) _Pragma("unroll") for (int k = 0; k < 2; ++k) \
        acc[ai][bj][m][n] = __builtin_amdgcn_mfma_f32_16x16x32_bf16(Bt[n][k], At[m][k], acc[ai][bj][m][n], 0, 0, 0); __builtin_amdgcn_s_setprio(0); } while (0)
#define PG8_WAIT_V(n) asm volatile("s_waitcnt vmcnt(" #n ")" ::: "memory")
#define PG8_WAIT_L(n) asm volatile("s_waitcnt lgkmcnt(" #n ")" ::: "memory")
#define PG8_BAR __builtin_amdgcn_s_barrier()
#define PG8_SCHED __builtin_amdgcn_sched_barrier(0)
    Unit cur, nxt; int ui = 0;
    if (!S.next(0, cur)) return;
    f32x4 acc[2][2][4][2];
#pragma unroll
    for (int a = 0; a < 2; ++a)
#pragma unroll
        for (int b = 0; b < 2; ++b)
#pragma unroll
            for (int m = 0; m < 4; ++m)
#pragma unroll
                for (int n = 0; n < 2; ++n) acc[a][b][m][n] = (f32x4){0.f, 0.f, 0.f, 0.f};
    bf16x8 At[4][2], B0[2][2], B1[2][2];
    const char* cA = (const char*)g.A + (size_t)cur.pm * tstep; const char* cB = (const char*)g.Bt + (size_t)cur.pn * tstep;
    S.a_ready(cur);
    if constexpr (SP2) {
        PG8_STAGE(PG8_SB(0, 0), cB, voffB); PG8_STAGE(PG8_SB(0, 1), cB + hstep, voffB); PG8_STAGE(PG8_SA(0, 0), cA, voffA); PG8_STAGE(PG8_SA(0, 1), cA + hstep, voffA);
        if (wr == 1) PG8_BAR;
        PG8_WAIT_V(2); PG8_BAR;
        PG8_STAGE(PG8_SB(1, 0), cB + kstep, voffB); PG8_STAGE(PG8_SA(1, 0), cA + kstep, voffA); PG8_STAGE(PG8_SB(1, 1), cB + hstep + kstep, voffB);
        PG8_WAIT_V(6); PG8_BAR;
    } else {
        PG8_STAGE(PG8_SB(0, 0), cB, voffB); PG8_STAGE(PG8_SA(0, 0), cA, voffA); PG8_STAGE(PG8_SB(0, 1), cB + hstep, voffB); PG8_STAGE(PG8_SA(0, 1), cA + hstep, voffA);
        if (wr == 1) PG8_BAR;
        PG8_WAIT_V(4); PG8_BAR;
        PG8_STAGE(PG8_SB(1, 0), cB + kstep, voffB); PG8_STAGE(PG8_SA(1, 0), cA + kstep, voffA); PG8_STAGE(PG8_SB(1, 1), cB + hstep + kstep, voffB);
        PG8_WAIT_V(6); PG8_BAR;
    }
    for (;;) {
        const bool has_next = S.next(ui + 1, nxt);
        const char* nA = has_next ? (const char*)g.A + (size_t)nxt.pm * tstep : cA; const char* nB = has_next ? (const char*)g.Bt + (size_t)nxt.pn * tstep : cB;
        for (int t = 0; t < nt; t += 2) {
            const bool last = (t == nt - 2);
            const char* a1 = cA + (size_t)(t + 1) * kstep;
            const char* a2 = last ? nA : cA + (size_t)(t + 2) * kstep; const char* b2 = last ? nB : cB + (size_t)(t + 2) * kstep;
            const char* a3 = a2 + kstep; const char* b3 = b2 + kstep;
            if (last && has_next) S.a_ready(nxt);
            if constexpr (SP2) {
            PG8_LDB(B0, 0, 0); PG8_LDB(B1, 0, 1); PG8_SCHED; PG8_LDA(At, 0, 0); PG8_STAGE(PG8_SA(1, 1), a1 + hstep, voffA);
            PG8_WAIT_V(8); PG8_WAIT_L(0); PG8_BAR; PG8_MMA(0, 0, At, B0); PG8_MMA(0, 1, At, B1); PG8_BAR; PG8_SCHED;
            PG8_LDA(At, 0, 1); PG8_STAGE(PG8_SB(0, 0), b2, voffB); PG8_STAGE(PG8_SB(0, 1), b2 + hstep, voffB); PG8_STAGE(PG8_SA(0, 0), a2, voffA);
            PG8_WAIT_V(8); PG8_WAIT_L(0); PG8_BAR; PG8_MMA(1, 0, At, B0); PG8_MMA(1, 1, At, B1); PG8_BAR; PG8_SCHED;
            PG8_LDB(B0, 1, 0); PG8_LDB(B1, 1, 1); PG8_SCHED; PG8_LDA(At, 1, 0); PG8_STAGE(PG8_SA(0, 1), a2 + hstep, voffA);
            PG8_WAIT_V(8); PG8_WAIT_L(0); PG8_BAR; PG8_MMA(0, 0, At, B0); PG8_MMA(0, 1, At, B1); PG8_BAR; PG8_SCHED;
            PG8_LDA(At, 1, 1); PG8_STAGE(PG8_SB(1, 0), b3, voffB); PG8_STAGE(PG8_SB(1, 1), b3 + hstep, voffB); PG8_STAGE(PG8_SA(1, 0), a3, voffA);
            PG8_WAIT_V(8); PG8_WAIT_L(0); PG8_BAR; PG8_MMA(1, 0, At, B0); PG8_MMA(1, 1, At, B1); PG8_BAR; PG8_SCHED;
            } else {
            PG8_LDB(B0, 0, 0); PG8_SCHED; PG8_LDA(At, 0, 0); PG8_STAGE(PG8_SA(1, 1), a1 + hstep, voffA);
            PG8_WAIT_L(8); PG8_BAR; PG8_WAIT_L(0); PG8_MMA(0, 0, At, B0); PG8_BAR; PG8_SCHED;
            PG8_LDB(B1, 0, 1); PG8_STAGE(PG8_SB(0, 0), b2, voffB);
            PG8_BAR; PG8_WAIT_L(0); PG8_MMA(0, 1, At, B1); PG8_BAR;
            PG8_LDA(At, 0, 1); PG8_STAGE(PG8_SA(0, 0), a2, voffA);
            PG8_BAR; PG8_WAIT_L(0); PG8_MMA(1, 0, At, B0); PG8_BAR; PG8_SCHED;
            PG8_STAGE(PG8_SB(0, 1), b2 + hstep, voffB);
            PG8_WAIT_V(6); PG8_BAR; PG8_MMA(1, 1, At, B1); PG8_BAR;
            PG8_LDB(B0, 1, 0); PG8_SCHED; PG8_LDA(At, 1, 0); PG8_STAGE(PG8_SA(0, 1), a2 + hstep, voffA);
            PG8_WAIT_L(8); PG8_BAR; PG8_WAIT_L(0); PG8_MMA(0, 0, At, B0); PG8_BAR; PG8_SCHED;
            PG8_LDB(B1, 1, 1); PG8_STAGE(PG8_SB(1, 0), b3, voffB);
            PG8_BAR; PG8_WAIT_L(0); PG8_MMA(0, 1, At, B1); PG8_BAR;
            PG8_LDA(At, 1, 1); PG8_STAGE(PG8_SA(1, 0), a3, voffA);
            PG8_BAR; PG8_WAIT_L(0); PG8_MMA(1, 0, At, B0); PG8_BAR; PG8_SCHED;
            PG8_STAGE(PG8_SB(1, 1), b3 + hstep, voffB);
            PG8_WAIT_V(6); PG8_BAR; PG8_MMA(1, 1, At, B1); PG8_BAR;
            }
        }
        if constexpr (ALIGN_EPI) { if (wr == 0) PG8_BAR; }
        if constexpr (!Epi::AFTER_DRAIN) { E(acc, cur, wr, wc, fr, fq); S.done(cur); }
        if (!has_next) break;
#pragma unroll
        for (int a = 0; a < 2; ++a)
#pragma unroll
            for (int b = 0; b < 2; ++b)
#pragma unroll
                for (int m = 0; m < 4; ++m)
#pragma unroll
                    for (int n = 0; n < 2; ++n) acc[a][b][m][n] = (f32x4){0.f, 0.f, 0.f, 0.f};
        cur = nxt; cA = nA; cB = nB; ++ui;
        if constexpr (ALIGN_EPI) { if (wr == 1) PG8_BAR; }
    }
    PG8_WAIT_V(0);
    if constexpr (!ALIGN_EPI) { if (wr == 0) PG8_BAR; }
    PG8_BAR;
    if constexpr (Epi::AFTER_DRAIN) { E.fused(acc, cur, wr, wc, fr, fq, lds, wid, lane); S.done(cur); }
#undef PG8_SA
#undef PG8_SB
#undef PG8_STAGE
#undef PG8_LDA
#undef PG8_LDB
#undef PG8_MMA
#undef PG8_WAIT_V
#undef PG8_WAIT_L
#undef PG8_BAR
#undef PG8_SCHED
}
}

using pg8::bf16_t; using pg8::bf16x8; using pg8::f32x4; using pg8::u32x4; using pg8::Unit;
typedef float f32x16 __attribute__((ext_vector_type(16)));
typedef float f32x2 __attribute__((ext_vector_type(2)));
typedef unsigned u32x2 __attribute__((ext_vector_type(2)));
typedef __bf16 bf16x2_t __attribute__((ext_vector_type(2)));
#define LAS __attribute__((address_space(3)))
#define MFMA32(a, b, c) __builtin_amdgcn_mfma_f32_32x32x16_bf16((a), (b), (c), 0, 0, 0)

constexpr int T = 16384, DM = 1024, SEQ = 4096, TH = 8192, FF = 4096, INW = 11264, NMOD = 6144;
constexpr int RCH = 512, NRCH = SEQ / RCH;
constexpr size_t MiB = 1u << 20;
constexpr size_t WS_MOD = 0, WS_COSP = 1 * MiB, WS_SINP = 3 * MiB, WS_COST = 5 * MiB, WS_SINT = 7 * MiB, WS_H = 9 * MiB;
constexpr size_t WS_WINA = 41 * MiB, WS_WINB = 53 * MiB, WS_WG = 61 * MiB, WS_WRET = 65 * MiB, WS_WSB = 69 * MiB, WS_WMIX = 71 * MiB, WS_WUP = 73 * MiB, WS_WDN = 81 * MiB;
constexpr size_t WS_YRET = 89 * MiB, WS_YSB = 153 * MiB, WS_RSNAP = 185 * MiB, WS_X = 201 * MiB, WS_END = 329 * MiB;
constexpr size_t WS_QR = WS_X, WS_KN = WS_X + 16 * MiB, WS_SQ = WS_X + 32 * MiB, WS_SK = WS_X + 48 * MiB, WS_KZT = WS_X + 64 * MiB, WS_VT = WS_X + 80 * MiB, WS_SVT = WS_X + 112 * MiB;
constexpr size_t WS_MERGED = WS_X, WS_TMP = WS_X + 32 * MiB, WS_U = WS_X;
constexpr int LDS_BYTES = 135168;
constexpr float SB_STOP = -80.0f;

DI unsigned pk2(float lo, float hi) { f32x2 v = {lo, hi}; bf16x2_t b = __builtin_convertvector(v, bf16x2_t); return __builtin_bit_cast(unsigned, b); }
DI float bflo(unsigned w) { return __uint_as_float(w << 16); }
DI float bfhi(unsigned w) { return __uint_as_float(w & 0xffff0000u); }
DI u32x4 pack8(f32x4 a, f32x4 b) { u32x4 w; w.x = pk2(a[0], a[1]); w.y = pk2(a[2], a[3]); w.z = pk2(b[0], b[1]); w.w = pk2(b[2], b[3]); return w; }
DI void unpack8(u32x4 w, f32x4& a, f32x4& b) { a = (f32x4){bflo(w.x), bfhi(w.x), bflo(w.y), bfhi(w.y)}; b = (f32x4){bflo(w.z), bfhi(w.z), bflo(w.w), bfhi(w.w)}; }
DI float wave_sum(float v) {
#pragma unroll
    for (int o = 1; o < 64; o <<= 1) v += __shfl_xor(v, o);
    return v;
}
DI float log2gamma(int h) { return log2f(1.0f - exp2f(-5.0f - (float)h)); }
DI float sigmoidf_(float v) { return 1.0f / (1.0f + __expf(-v)); }
DI int crow(int reg, int hh) { return (reg & 3) + 8 * (reg >> 2) + 4 * hh; }


struct EpiInA {
    static constexpr bool PERM = true, AFTER_DRAIN = false;
    bf16_t *qr, *kn, *sq, *sk, *yret; const float *cosP, *sinP;
    DI void operator()(const f32x4 (&acc)[2][2][4][2], const Unit& u, int wr, int wc, int fr_, int fq) const {
        int fr = fr_; asm volatile("" : "+v"(fr));
        const int pn = u.pn, row0 = u.pm * 256 + wr * 64 + fr, cl = wc * 32 + 8 * fq;
        if (pn < 8) {
            bf16_t* dst = (pn < 4 ? qr : kn) + (pn & 3) * 256 + cl;
            const float sc = pn < 4 ? 1.0f : 0.0625f;
#pragma unroll
            for (int ai = 0; ai < 2; ++ai)
#pragma unroll
                for (int m = 0; m < 4; ++m) {
                    const int row = row0 + ai * 128 + m * 16, pos = row & (SEQ - 1);
                    const f32x4* cp = (const f32x4*)(cosP + pos * 128 + cl); const f32x4* sp = (const f32x4*)(sinP + pos * 128 + cl);
                    f32x4 o1[2], o2[2];
#pragma unroll
                    for (int n = 0; n < 2; ++n) { const f32x4 c = cp[n], s = sp[n], t1 = acc[ai][0][m][n], t2 = acc[ai][1][m][n];
                        o1[n] = (t1 * c - t2 * s) * sc; o2[n] = (t1 * s + t2 * c) * sc; }
                    bf16_t* rp = dst + (size_t)row * 1024;
                    *(u32x4*)rp = pack8(o1[0], o1[1]); *(u32x4*)(rp + 128) = pack8(o2[0], o2[1]);
                    __builtin_amdgcn_sched_barrier(0);
                }
        } else {
            bf16_t* dst; int ld; int mode;
            if (pn < 16) { dst = yret + (pn - 8) * 256; ld = 2048; mode = 0; }
            else if (pn < 20) { dst = sq + (pn - 16) * 256; ld = 1024; mode = 1; }
            else { dst = sk + (pn - 20) * 256; ld = 1024; mode = 2; }
#pragma unroll
            for (int ai = 0; ai < 2; ++ai)
#pragma unroll
                for (int m = 0; m < 4; ++m) {
                    bf16_t* rp = dst + (size_t)(row0 + ai * 128 + m * 16) * ld + cl;
#pragma unroll
                    for (int bj = 0; bj < 2; ++bj) {
                        f32x4 v0 = acc[ai][bj][m][0], v1 = acc[ai][bj][m][1];
                        if (mode == 0) {
#pragma unroll
                            for (int e = 0; e < 4; ++e) { v0[e] = v0[e] * sigmoidf_(v0[e]); v1[e] = v1[e] * sigmoidf_(v1[e]); }
                        } else if (mode == 1) { v0 = v0 * 0.125f; v1 = v1 * 0.125f; }
                        *(u32x4*)(rp + bj * 128) = pack8(v0, v1);
                    }
                }
        }
    }
};

struct EpiInB {
    static constexpr bool PERM = true, AFTER_DRAIN = false;
    bf16_t *kzT, *vT, *svT; const float *cosT, *sinT;
    DI void operator()(const f32x4 (&acc)[2][2][4][2], const Unit& u, int wr, int wc, int fr_, int fq) const {
        int fr = fr_; asm volatile("" : "+v"(fr));
        const int pm = u.pm, tok0 = u.pn * 256 + wc * 32 + 8 * fq;
        if (pm < 4) {
            const float l2g = log2gamma(pm), ginv = __builtin_amdgcn_exp2f(-l2g);
#pragma unroll
            for (int m = 0; m < 4; ++m) {
                const int i = wr * 64 + m * 16 + fr;
#pragma unroll
                for (int bj = 0; bj < 2; ++bj) {
                    const int tok = tok0 + bj * 128, pos = tok & (SEQ - 1);
                    const f32x4* cp = (const f32x4*)(cosT + i * SEQ + pos); const f32x4* sp = (const f32x4*)(sinT + i * SEQ + pos);
                    f32x4 o1[2], o2[2];
                    float zr = __builtin_amdgcn_exp2f((float)((RCH - 1) - (pos & (RCH - 1))) * l2g) * 0.0625f;
#pragma unroll
                    for (int n = 0; n < 2; ++n) { const f32x4 c = cp[n], s = sp[n], t1 = acc[0][bj][m][n], t2 = acc[1][bj][m][n];
                        f32x4 z;
#pragma unroll
                        for (int e = 0; e < 4; ++e) { z[e] = zr; zr *= ginv; }
                        o1[n] = (t1 * c - t2 * s) * z; o2[n] = (t1 * s + t2 * c) * z; }
                    *(u32x4*)(kzT + (size_t)(pm * 256 + i) * TH + tok) = pack8(o1[0], o1[1]);
                    *(u32x4*)(kzT + (size_t)(pm * 256 + 128 + i) * TH + tok) = pack8(o2[0], o2[1]);
                    __builtin_amdgcn_sched_barrier(0);
                }
            }
        } else {
            bf16_t* dst = pm < 12 ? vT + (size_t)(pm - 4) * 256 * TH : svT + (size_t)(pm - 12) * 256 * TH;
#pragma unroll
            for (int ai = 0; ai < 2; ++ai)
#pragma unroll
                for (int m = 0; m < 4; ++m)
#pragma unroll
                    for (int bj = 0; bj < 2; ++bj)
                        *(u32x4*)(dst + (size_t)(ai * 128 + wr * 64 + m * 16 + fr) * TH + tok0 + bj * 128) = pack8(acc[ai][bj][m][0], acc[ai][bj][m][1]);
        }
    }
};

template <int MODE> struct EpiEw {
    static constexpr bool PERM = true, AFTER_DRAIN = false;
    bf16_t* O; const bf16_t* P; int ld;
    DI void operator()(const f32x4 (&acc)[2][2][4][2], const Unit& u, int wr, int wc, int fr_, int fq) const {
        int fr = fr_; asm volatile("" : "+v"(fr));
        const int row0 = u.pm * 256 + wr * 64 + fr, col0 = u.pn * 256 + wc * 32 + 8 * fq;
#pragma unroll
        for (int ai = 0; ai < 2; ++ai)
#pragma unroll
            for (int m = 0; m < 4; ++m)
#pragma unroll
                for (int bj = 0; bj < 2; ++bj) {
                    const size_t off = (size_t)(row0 + ai * 128 + m * 16) * ld + col0 + bj * 128;
                    f32x4 v0 = acc[ai][bj][m][0], v1 = acc[ai][bj][m][1];
                    if (MODE == 0) {
#pragma unroll
                        for (int e = 0; e < 4; ++e) { v0[e] = sigmoidf_(v0[e]); v1[e] = sigmoidf_(v1[e]); }
                    } else if (MODE == 1) {
#pragma unroll
                        for (int e = 0; e < 4; ++e) { const float a = fmaxf(v0[e], 0.f), b = fmaxf(v1[e], 0.f); v0[e] = a * a; v1[e] = b * b; }
                    } else if (MODE == 2) {
                        f32x4 a, b; unpack8(*(const u32x4*)(O + off), a, b); v0 = v0 * a; v1 = v1 * b;
                    } else {
                        f32x4 a, b, c, d; unpack8(*(const u32x4*)(O + off), a, b); unpack8(*(const u32x4*)(P + off), c, d); v0 = a + c * v0; v1 = b + d * v1;
                    }
                    *(u32x4*)(O + off) = pack8(v0, v1);
                }
    }
};

struct EpiRes {
    static constexpr bool PERM = true, AFTER_DRAIN = false;
    const float* xin; float* xout; const float* gate;
    DI void operator()(const f32x4 (&acc)[2][2][4][2], const Unit& u, int wr, int wc, int fr_, int fq) const {
        int fr = fr_; asm volatile("" : "+v"(fr));
        const int row0 = u.pm * 256 + wr * 64 + fr, col0 = u.pn * 256 + wc * 32 + 8 * fq;
#pragma unroll
        for (int ai = 0; ai < 2; ++ai)
#pragma unroll
            for (int m = 0; m < 4; ++m) {
                const int row = row0 + ai * 128 + m * 16; const float* gp = gate + (row >> 12) * NMOD;
#pragma unroll
                for (int bj = 0; bj < 2; ++bj) {
                    const int col = col0 + bj * 128; const size_t off = (size_t)row * DM + col;
                    const f32x4 g0 = *(const f32x4*)(gp + col), g1 = *(const f32x4*)(gp + col + 4);
                    const f32x4 x0 = *(const f32x4*)(xin + off), x1 = *(const f32x4*)(xin + off + 4);
                    *(f32x4*)(xout + off) = x0 + g0 * acc[ai][bj][m][0]; *(f32x4*)(xout + off + 4) = x1 + g1 * acc[ai][bj][m][1];
                }
            }
    }
};

DI void cvt_tile(const float* src, int ldsrc, int k0, int n0, bf16_t* dst1, bf16_t* dst2, int K, LAS float* tile, int tid) {
    const int kr = tid >> 4, nc = (tid & 15) * 4;
#pragma unroll
    for (int p = 0; p < 2; ++p) { const int k = kr + 32 * p; const f32x4 v = *(const f32x4*)(src + (size_t)(k0 + k) * ldsrc + n0 + nc);
        tile[k * 65 + nc] = v[0]; tile[k * 65 + nc + 1] = v[1]; tile[k * 65 + nc + 2] = v[2]; tile[k * 65 + nc + 3] = v[3]; }
    __syncthreads();
    const int n = tid >> 3, ks = (tid & 7) * 8; const LAS float* s = tile + ks * 65 + n;
    u32x4 o; o.x = pk2(s[0], s[65]); o.y = pk2(s[2 * 65], s[3 * 65]); o.z = pk2(s[4 * 65], s[5 * 65]); o.w = pk2(s[6 * 65], s[7 * 65]);
    *(u32x4*)(dst1 + (size_t)n * K + k0 + ks) = o;
    if (dst2) *(u32x4*)(dst2 + (size_t)n * K + k0 + ks) = o;
    __syncthreads();
}

struct Params {
    const float *x, *c, *norm_mix_g, *w_in, *w_ret_out, *w_sb_out, *w_mix_out, *norm_mlp_g, *w_up, *w_down, *w_ada, *b_ada, *final_g;
    float* out; unsigned char* ws;
};

DI void convert_weights(const Params& p, int l, LAS float* tile, int tid) {
    unsigned char* ws = p.ws;
    bf16_t* WinA = (bf16_t*)(ws + WS_WINA); bf16_t* WinB = (bf16_t*)(ws + WS_WINB); bf16_t* Wg = (bf16_t*)(ws + WS_WG);
    constexpr int I_IN = 16 * 176, I_RET = 32 * 16, I_SB = 16 * 16, I_MIX = 16 * 16, I_UP = 16 * 64, I_DN = 64 * 16;
    constexpr int NIT = I_IN + I_RET + I_SB + I_MIX + I_UP + I_DN;
    for (int it = blockIdx.x; it < NIT; it += gridDim.x) {
        int r = it;
        if (r < I_IN) {
            const int kb = r / 176, nb = r % 176, n0 = nb * 64; bf16_t* d1; bf16_t* d2 = nullptr;
            if (n0 < 1024) d1 = WinA + (size_t)n0 * 1024;
            else if (n0 < 2048) { d1 = WinA + (size_t)n0 * 1024; d2 = WinB + (size_t)(n0 - 1024) * 1024; }
            else if (n0 < 4096) d1 = WinB + (size_t)(n0 - 1024) * 1024;
            else if (n0 < 8192) d1 = WinA + (size_t)(n0 - 2048) * 1024;
            else if (n0 < 9216) d1 = WinB + (size_t)(n0 - 5120) * 1024;
            else d1 = Wg + (size_t)(n0 - 9216) * 1024;
            cvt_tile(p.w_in + (size_t)l * DM * INW, INW, kb * 64, n0, d1, d2, 1024, tile, tid); continue;
        }
        r -= I_IN;
        if (r < I_RET) { const int kb = r / 16, nb = r % 16; cvt_tile(p.w_ret_out + (size_t)l * 2048 * 1024, 1024, kb * 64, nb * 64, (bf16_t*)(ws + WS_WRET) + (size_t)nb * 64 * 2048, nullptr, 2048, tile, tid); continue; }
        r -= I_RET;
        if (r < I_SB) { const int kb = r / 16, nb = r % 16; cvt_tile(p.w_sb_out + (size_t)l * 1024 * 1024, 1024, kb * 64, nb * 64, (bf16_t*)(ws + WS_WSB) + (size_t)nb * 64 * 1024, nullptr, 1024, tile, tid); continue; }
        r -= I_SB;
        if (r < I_MIX) { const int kb = r / 16, nb = r % 16; cvt_tile(p.w_mix_out + (size_t)l * 1024 * 1024, 1024, kb * 64, nb * 64, (bf16_t*)(ws + WS_WMIX) + (size_t)nb * 64 * 1024, nullptr, 1024, tile, tid); continue; }
        r -= I_MIX;
        if (r < I_UP) { const int kb = r / 64, nb = r % 64; cvt_tile(p.w_up + (size_t)l * 1024 * 4096, 4096, kb * 64, nb * 64, (bf16_t*)(ws + WS_WUP) + (size_t)nb * 64 * 1024, nullptr, 1024, tile, tid); continue; }
        r -= I_UP;
        { const int kb = r / 16, nb = r % 16; cvt_tile(p.w_down + (size_t)l * 4096 * 1024, 1024, kb * 64, nb * 64, (bf16_t*)(ws + WS_WDN) + (size_t)nb * 64 * 4096, nullptr, 4096, tile, tid); }
    }
}

DI void tables_and_mod(const Params& p, LAS float* lds, int tid) {
    float* cosP = (float*)(p.ws + WS_COSP); float* sinP = (float*)(p.ws + WS_SINP); float* cosT = (float*)(p.ws + WS_COST); float* sinT = (float*)(p.ws + WS_SINT);
    for (int idx = blockIdx.x * 512 + tid; idx < SEQ * 128; idx += gridDim.x * 512) {
        const int pos = idx >> 7, i = idx & 127;
        const float inv = powf(10000.0f, -(float)i / 128.0f); const float ang = (float)pos * inv;
        const float c = cosf(ang), s = sinf(ang);
        cosP[idx] = c; sinP[idx] = s; cosT[i * SEQ + pos] = c; sinT[i * SEQ + pos] = s;
    }
    float* mod = (float*)(p.ws + WS_MOD);
    LAS float* cact = lds; LAS float* red = lds + 4096;
    const int wave = tid >> 6, lane = tid & 63;
    bool have = false;
    for (int it = blockIdx.x; it < 2 * 96; it += gridDim.x) {
        if (!have) { for (int e = tid; e < 4096; e += 512) { const float v = p.c[e]; cact[e] = v * sigmoidf_(v); } have = true; __syncthreads(); }
        const int l = it / 96, c0 = (it % 96) * 64;
        const float* w = p.w_ada + (size_t)l * DM * NMOD + c0 + lane;
        float a0 = 0.f, a1 = 0.f, a2 = 0.f, a3 = 0.f;
#pragma unroll 8
        for (int k = wave * 128; k < wave * 128 + 128; ++k) { const float wv = w[(size_t)k * NMOD]; a0 += cact[k] * wv; a1 += cact[1024 + k] * wv; a2 += cact[2048 + k] * wv; a3 += cact[3072 + k] * wv; }
        red[(wave * 4 + 0) * 64 + lane] = a0; red[(wave * 4 + 1) * 64 + lane] = a1; red[(wave * 4 + 2) * 64 + lane] = a2; red[(wave * 4 + 3) * 64 + lane] = a3;
        __syncthreads();
        if (tid < 256) { const int b = tid >> 6; float s = p.b_ada[l * NMOD + c0 + lane];
#pragma unroll
            for (int w8 = 0; w8 < 8; ++w8) s += red[(w8 * 4 + b) * 64 + lane];
            mod[(size_t)(l * 4 + b) * NMOD + c0 + lane] = s; }
        __syncthreads();
    }
}

DI void norm_phase(const float* xin, const float* g, const float* modl, int shift_i, int scale_i, bf16_t* hout, int gw, int ngw, int lane) {
    for (int row = gw; row < T; row += ngw) {
        const f32x4* xr = (const f32x4*)(xin + (size_t)row * DM) + lane;
        f32x4 v[4]; float s = 0.f;
#pragma unroll
        for (int j = 0; j < 4; ++j) { v[j] = xr[64 * j]; s += (v[j][0] * v[j][0] + v[j][1] * v[j][1]) + (v[j][2] * v[j][2] + v[j][3] * v[j][3]); }
        const float rstd = 1.0f / sqrtf(wave_sum(s) * (1.0f / DM) + 1e-6f);
        const float* mb = modl + (row >> 12) * NMOD;
        u32x2* o8 = (u32x2*)(hout + (size_t)row * DM) + lane;
#pragma unroll
        for (int j = 0; j < 4; ++j) { const int col = 4 * (lane + 64 * j);
            const f32x4 gg = *(const f32x4*)(g + col), sc = *(const f32x4*)(mb + scale_i * 1024 + col), sh = *(const f32x4*)(mb + shift_i * 1024 + col);
            const f32x4 y = v[j] * rstd * gg * (sc + 1.0f) + sh;
            u32x2 w; w.x = pk2(y[0], y[1]); w.y = pk2(y[2], y[3]); o8[64 * j] = w; }
    }
}
DI void final_norm_phase(float* x, const float* g, int gw, int ngw, int lane) {
    for (int row = gw; row < T; row += ngw) {
        f32x4* xr = (f32x4*)(x + (size_t)row * DM) + lane;
        f32x4 v[4]; float s = 0.f;
#pragma unroll
        for (int j = 0; j < 4; ++j) { v[j] = xr[64 * j]; s += (v[j][0] * v[j][0] + v[j][1] * v[j][1]) + (v[j][2] * v[j][2] + v[j][3] * v[j][3]); }
        const float rstd = 1.0f / sqrtf(wave_sum(s) * (1.0f / DM) + 1e-6f);
#pragma unroll
        for (int j = 0; j < 4; ++j) { const f32x4 gg = *(const f32x4*)(g + 4 * (lane + 64 * j)); xr[64 * j] = v[j] * rstd * gg; }
    }
}

DI void ret_state_item(int item, const bf16_t* kzT, const bf16_t* vT, bf16_t* rsnap, int lane) {
    const int dvt = item & 15, dkt = (item >> 4) & 7, bh = item >> 7, bl = bh >> 2, h = bh & 3, r = lane & 31, hh = lane >> 5;
    const bf16_t* ap = kzT + (size_t)(h * 256 + dkt * 32 + r) * TH + bl * SEQ + 8 * hh;
    const bf16_t* bp = vT + (size_t)(h * 512 + dvt * 32 + r) * TH + bl * SEQ + 8 * hh;
    const float dec = exp2f((float)RCH * log2gamma(h));
    f32x16 acc;
#pragma unroll
    for (int i = 0; i < 16; ++i) acc[i] = 0.f;
    for (int n = 0; n < NRCH; ++n) {
        bf16_t* sp = rsnap + ((size_t)(bh * NRCH + n) * 512 + dvt * 32 + r) * 256 + dkt * 32 + 4 * hh;
#pragma unroll
        for (int g = 0; g < 4; ++g) { u32x2 w; w.x = pk2(acc[4 * g], acc[4 * g + 1]); w.y = pk2(acc[4 * g + 2], acc[4 * g + 3]); *(u32x2*)(sp + 8 * g) = w; }
        if (n == NRCH - 1) break;
#pragma unroll
        for (int i = 0; i < 16; ++i) acc[i] *= dec;
        const bf16_t* a = ap + n * RCH; const bf16_t* b = bp + n * RCH;
#pragma unroll 8
        for (int ks = 0; ks < RCH / 16; ++ks) acc = MFMA32(*(const bf16x8*)(a + ks * 16), *(const bf16x8*)(b + ks * 16), acc);
    }
}

DI void sb_item(int item, const bf16_t* sq, const bf16_t* sk, const bf16_t* svT, bf16_t* ysb, int lane) {
    const int qt = 127 - (item & 127), h = (item >> 7) & 15, bl = item >> 11, r = lane & 31, hh = lane >> 5;
    const size_t rowbase = (size_t)bl * SEQ; const int tq = qt * 32 + r;
    const bf16_t* qp = sq + (rowbase + tq) * 1024 + h * 64 + 8 * hh;
    bf16x8 qf[4];
#pragma unroll
    for (int ks = 0; ks < 4; ++ks) qf[ks] = *(const bf16x8*)(qp + 16 * ks);
    f32x16 o0, o1;
#pragma unroll
    for (int i = 0; i < 16; ++i) { o0[i] = 0.f; o1[i] = 0.f; }
    float carry = 0.f;
    for (int j = qt; j >= 0; --j) {
        const bf16_t* kp = sk + (rowbase + j * 32 + r) * 1024 + h * 64 + 8 * hh;
        f32x16 st;
#pragma unroll
        for (int i = 0; i < 16; ++i) st[i] = 0.f;
#pragma unroll
        for (int ks = 0; ks < 4; ++ks) st = MFMA32(*(const bf16x8*)(kp + 16 * ks), qf[ks], st);
        float lp[16], aw[16], gs[4], pg[4];
#pragma unroll
        for (int i = 0; i < 16; ++i) { const int key = j * 32 + crow(i, hh); const float z = st[i];
            const float spv = fmaxf(z, 0.f) + __logf(1.0f + __expf(-fabsf(z)));
            lp[i] = key < tq ? -spv : 0.f; }
#pragma unroll
        for (int g = 0; g < 4; ++g) { gs[g] = (lp[4 * g] + lp[4 * g + 1]) + (lp[4 * g + 2] + lp[4 * g + 3]); pg[g] = __shfl_xor(gs[g], 32); }
        float after = carry;
#pragma unroll
        for (int g = 3; g >= 0; --g) {
            float run = after + (hh == 0 ? pg[g] : 0.f);
#pragma unroll
            for (int e = 3; e >= 0; --e) { const int i = 4 * g + e; const int key = j * 32 + crow(i, hh);
                aw[i] = key < tq ? __expf(st[i] + lp[i] + run) : 0.f; run += lp[i]; }
            after += gs[g] + pg[g];
        }
        carry = after;
#pragma unroll
        for (int s = 0; s < 2; ++s) {
            u32x4 bw; bw.x = pk2(aw[8 * s], aw[8 * s + 1]); bw.y = pk2(aw[8 * s + 2], aw[8 * s + 3]); bw.z = pk2(aw[8 * s + 4], aw[8 * s + 5]); bw.w = pk2(aw[8 * s + 6], aw[8 * s + 7]);
            const bf16x8 bp = __builtin_bit_cast(bf16x8, bw);
            const bf16_t* vp = svT + (size_t)(h * 64 + r) * TH + rowbase + j * 32 + 16 * s + 4 * hh;
            { const u32x2 lo = *(const u32x2*)vp, hi = *(const u32x2*)(vp + 8); u32x4 a; a.x = lo.x; a.y = lo.y; a.z = hi.x; a.w = hi.y; o0 = MFMA32(__builtin_bit_cast(bf16x8, a), bp, o0); }
            { const bf16_t* vq = vp + (size_t)32 * TH; const u32x2 lo = *(const u32x2*)vq, hi = *(const u32x2*)(vq + 8); u32x4 a; a.x = lo.x; a.y = lo.y; a.z = hi.x; a.w = hi.y; o1 = MFMA32(__builtin_bit_cast(bf16x8, a), bp, o1); }
        }
        if (__all(carry < SB_STOP)) break;
    }
    bf16_t* op = ysb + (rowbase + tq) * 1024 + h * 64 + 4 * hh;
#pragma unroll
    for (int g = 0; g < 4; ++g) {
        u32x2 w; w.x = pk2(o0[4 * g], o0[4 * g + 1]); w.y = pk2(o0[4 * g + 2], o0[4 * g + 3]); *(u32x2*)(op + 8 * g) = w;
        u32x2 w1; w1.x = pk2(o1[4 * g], o1[4 * g + 1]); w1.y = pk2(o1[4 * g + 2], o1[4 * g + 3]); *(u32x2*)(op + 32 + 8 * g) = w1;
    }
}

DI void ret_out_item(int item, const bf16_t* qr, const bf16_t* kn, const bf16_t* vT, const bf16_t* rsnap, bf16_t* yret, LAS float* stats, int wave, int lane) {
    const int bh = item >> 5, tg = 31 - (item & 31), bl = bh >> 2, h = bh & 3, tt = wave & 3, dh = wave >> 2, r = lane & 31, hh = lane >> 5;
    const int tok0 = tg * 128 + tt * 32, n = tok0 / RCH, tq = tok0 + r;
    const size_t rowbase = (size_t)bl * SEQ; const float l2g = log2gamma(h);
    const bf16_t* qp = qr + (rowbase + tq) * 1024 + h * 256 + 8 * hh;
    f32x16 acc[8];
#pragma unroll
    for (int dt = 0; dt < 8; ++dt)
#pragma unroll
        for (int i = 0; i < 16; ++i) acc[dt][i] = 0.f;
    const bf16_t* rp = rsnap + ((size_t)(bh * NRCH + n) * 512 + dh * 256 + r) * 256 + 8 * hh;
#pragma unroll 1
    for (int ks = 0; ks < 16; ++ks) {
        const bf16x8 bq = *(const bf16x8*)(qp + 16 * ks);
#pragma unroll
        for (int dt = 0; dt < 8; ++dt) acc[dt] = MFMA32(*(const bf16x8*)(rp + (size_t)dt * 32 * 256 + 16 * ks), bq, acc[dt]);
    }
    { const float xi = exp2f((float)((tq & (RCH - 1)) + 1) * l2g);
#pragma unroll
      for (int dt = 0; dt < 8; ++dt)
#pragma unroll
          for (int i = 0; i < 16; ++i) acc[dt][i] *= xi; }
    const bf16_t* vbase = vT + (size_t)(h * 512 + dh * 256 + r) * TH + rowbase + 4 * hh;
    for (int j = (n * RCH) >> 5; j <= (tok0 >> 5); ++j) {
        const bf16_t* kp = kn + (rowbase + j * 32 + r) * 1024 + h * 256 + 8 * hh;
        f32x16 st;
#pragma unroll
        for (int i = 0; i < 16; ++i) st[i] = 0.f;
#pragma unroll 4
        for (int ks = 0; ks < 16; ++ks) st = MFMA32(*(const bf16x8*)(kp + 16 * ks), *(const bf16x8*)(qp + 16 * ks), st);
        float pw[16];
#pragma unroll
        for (int i = 0; i < 16; ++i) { const int d = tq - (j * 32 + crow(i, hh)); pw[i] = d >= 0 ? st[i] * __builtin_amdgcn_exp2f((float)d * l2g) : 0.f; }
#pragma unroll
        for (int s = 0; s < 2; ++s) {
            u32x4 bw; bw.x = pk2(pw[8 * s], pw[8 * s + 1]); bw.y = pk2(pw[8 * s + 2], pw[8 * s + 3]); bw.z = pk2(pw[8 * s + 4], pw[8 * s + 5]); bw.w = pk2(pw[8 * s + 6], pw[8 * s + 7]);
            const bf16x8 bp = __builtin_bit_cast(bf16x8, bw);
            const bf16_t* vp = vbase + j * 32 + 16 * s;
#pragma unroll
            for (int dt = 0; dt < 8; ++dt) { const bf16_t* vq = vp + (size_t)dt * 32 * TH; const u32x2 lo = *(const u32x2*)vq, hi = *(const u32x2*)(vq + 8);
                u32x4 a; a.x = lo.x; a.y = lo.y; a.z = hi.x; a.w = hi.y; acc[dt] = MFMA32(__builtin_bit_cast(bf16x8, a), bp, acc[dt]); }
        }
    }
    float s1 = 0.f, s2 = 0.f;
#pragma unroll
    for (int dt = 0; dt < 8; ++dt)
#pragma unroll
        for (int i = 0; i < 16; ++i) { const float v = acc[dt][i]; s1 += v; s2 += v * v; }
    s1 += __shfl_xor(s1, 32); s2 += __shfl_xor(s2, 32);
    if (hh == 0) { stats[(dh * 128 + tt * 32 + r) * 2] = s1; stats[(dh * 128 + tt * 32 + r) * 2 + 1] = s2; }
    __syncthreads();
    s1 += stats[((dh ^ 1) * 128 + tt * 32 + r) * 2]; s2 += stats[((dh ^ 1) * 128 + tt * 32 + r) * 2 + 1];
    const float mu = s1 * (1.0f / 512.0f), var = fmaxf(s2 * (1.0f / 512.0f) - mu * mu, 0.f), rstd = 1.0f / sqrtf(var + 1e-5f);
    bf16_t* op = yret + (rowbase + tq) * 2048 + h * 512 + dh * 256 + 4 * hh;
#pragma unroll
    for (int dt = 0; dt < 8; ++dt)
#pragma unroll
        for (int g = 0; g < 4; ++g) {
            u32x2* pp = (u32x2*)(op + dt * 32 + 8 * g); const u32x2 gv = *pp;
            u32x2 w; w.x = pk2(bflo(gv.x) * (acc[dt][4 * g] - mu) * rstd, bfhi(gv.x) * (acc[dt][4 * g + 1] - mu) * rstd);
            w.y = pk2(bflo(gv.y) * (acc[dt][4 * g + 2] - mu) * rstd, bfhi(gv.y) * (acc[dt][4 * g + 3] - mu) * rstd); *pp = w;
        }
    __syncthreads();
}

__global__ void __launch_bounds__(512, 2) hybrid_fwd(Params p) {
    extern __shared__ __attribute__((aligned(16))) unsigned char lds_raw[];
    cg::grid_group grid = cg::this_grid();
    PG8_LAS unsigned char* lds = (PG8_LAS unsigned char*)lds_raw;
    LAS float* ldsf = (LAS float*)lds_raw;
#define PH_BEGIN int tid = threadIdx.x; asm volatile("" : "+v"(tid)); int bx = blockIdx.x, G = gridDim.x; asm volatile("" : "+s"(bx), "+s"(G)); \
    unsigned char* ws = p.ws; asm volatile("" : "+s"(ws)); float* xo = p.out; asm volatile("" : "+s"(xo)); \
    const int lane = tid & 63, wave = __builtin_amdgcn_readfirstlane(tid >> 6), gw = bx * 8 + wave, ngw = G * 8; (void)lane; (void)wave; (void)gw; (void)ngw; \
    const float* modl = (const float*)(ws + WS_MOD) + (size_t)l * 4 * NMOD; (void)modl; bf16_t* H = (bf16_t*)(ws + WS_H); (void)H;
#pragma unroll 1
    for (int l = 0; l < 2; ++l) {
        { PH_BEGIN
          if (l == 0) { tables_and_mod(p, ldsf, tid); __syncthreads(); }
          convert_weights(p, l, ldsf, tid); }
        if (l == 0) grid.sync();
        { PH_BEGIN
          norm_phase(l == 0 ? p.x : xo, p.norm_mix_g + l * DM, modl, 0, 1, H, gw, ngw, lane); }
        grid.sync();
#pragma unroll 1
        for (int half = 0; half < 2; ++half) {
            { PH_BEGIN
              pg8::Gemm g{H + (size_t)half * TH * DM, (const bf16_t*)(ws + WS_WINA), TH, 6144, DM}; pg8::StaticOrder S; S.init(TH, 6144, G, bx);
              EpiInA E{(bf16_t*)(ws + WS_QR), (bf16_t*)(ws + WS_KN), (bf16_t*)(ws + WS_SQ), (bf16_t*)(ws + WS_SK), (bf16_t*)(ws + WS_YRET) + (size_t)half * TH * 2048, (const float*)(ws + WS_COSP), (const float*)(ws + WS_SINP)};
              pg8::gemm_phase<EpiInA, pg8::StaticOrder, true, true>(lds, g, S, E); }
            { PH_BEGIN
              pg8::Gemm g{(const bf16_t*)(ws + WS_WINB), H + (size_t)half * TH * DM, 4096, TH, DM}; pg8::StaticOrder S; S.init(4096, TH, G, bx);
              EpiInB E{(bf16_t*)(ws + WS_KZT), (bf16_t*)(ws + WS_VT), (bf16_t*)(ws + WS_SVT), (const float*)(ws + WS_COST), (const float*)(ws + WS_SINT)};
              pg8::gemm_phase<EpiInB, pg8::StaticOrder, true, true>(lds, g, S, E); }
            grid.sync();
            { PH_BEGIN
              for (int s = gw; s < 2048; s += ngw) if (!(s & 1)) ret_state_item(s >> 1, (const bf16_t*)(ws + WS_KZT), (const bf16_t*)(ws + WS_VT), (bf16_t*)(ws + WS_RSNAP), lane); }
            { PH_BEGIN
              for (int it = gw; it < 4096; it += ngw) sb_item(it, (const bf16_t*)(ws + WS_SQ), (const bf16_t*)(ws + WS_SK), (const bf16_t*)(ws + WS_SVT), (bf16_t*)(ws + WS_YSB) + (size_t)half * TH * 1024, lane); }
            grid.sync();
            { PH_BEGIN
              for (int it = bx; it < 256; it += G) ret_out_item(it, (const bf16_t*)(ws + WS_QR), (const bf16_t*)(ws + WS_KN), (const bf16_t*)(ws + WS_VT), (const bf16_t*)(ws + WS_RSNAP), (bf16_t*)(ws + WS_YRET) + (size_t)half * TH * 2048, ldsf, wave, lane); }
            grid.sync();
        }
        { PH_BEGIN pg8::StaticOrder S; S.init(T, DM, G, bx);
          pg8::Gemm g{H, (const bf16_t*)(ws + WS_WG), T, DM, DM}; EpiEw<0> E{(bf16_t*)(ws + WS_MERGED), nullptr, DM}; pg8::gemm_phase<EpiEw<0>, pg8::StaticOrder, false, true>(lds, g, S, E); }
        { PH_BEGIN pg8::StaticOrder S; S.init(T, DM, G, bx);
          pg8::Gemm g{(const bf16_t*)(ws + WS_YRET), (const bf16_t*)(ws + WS_WRET), T, DM, 2048}; EpiEw<2> E{(bf16_t*)(ws + WS_MERGED), nullptr, DM}; pg8::gemm_phase<EpiEw<2>, pg8::StaticOrder, false, true>(lds, g, S, E); }
        { PH_BEGIN pg8::StaticOrder S; S.init(T, DM, G, bx);
          pg8::Gemm g{H, (const bf16_t*)(ws + WS_WG) + (size_t)1024 * 1024, T, DM, DM}; EpiEw<0> E{(bf16_t*)(ws + WS_TMP), nullptr, DM}; pg8::gemm_phase<EpiEw<0>, pg8::StaticOrder, false, true>(lds, g, S, E); }
        { PH_BEGIN pg8::StaticOrder S; S.init(T, DM, G, bx);
          pg8::Gemm g{(const bf16_t*)(ws + WS_YSB), (const bf16_t*)(ws + WS_WSB), T, DM, DM}; EpiEw<3> E{(bf16_t*)(ws + WS_MERGED), (const bf16_t*)(ws + WS_TMP), DM}; pg8::gemm_phase<EpiEw<3>, pg8::StaticOrder, false, true>(lds, g, S, E); }
        grid.sync();
        { PH_BEGIN pg8::StaticOrder S; S.init(T, DM, G, bx);
          pg8::Gemm g{(const bf16_t*)(ws + WS_MERGED), (const bf16_t*)(ws + WS_WMIX), T, DM, DM}; EpiRes E{l == 0 ? p.x : xo, xo, modl + 2 * 1024};
          pg8::gemm_phase<EpiRes, pg8::StaticOrder, false, true>(lds, g, S, E); }
        grid.sync();
        { PH_BEGIN
          norm_phase(xo, p.norm_mlp_g + l * DM, modl, 3, 4, H, gw, ngw, lane); }
        grid.sync();
        { PH_BEGIN pg8::StaticOrder S; S.init(T, FF, G, bx);
          pg8::Gemm g{H, (const bf16_t*)(ws + WS_WUP), T, FF, DM}; EpiEw<1> E{(bf16_t*)(ws + WS_U), nullptr, FF};
          pg8::gemm_phase<EpiEw<1>, pg8::StaticOrder, true, true>(lds, g, S, E); }
        grid.sync();
        { PH_BEGIN pg8::StaticOrder S; S.init(T, DM, G, bx);
          pg8::Gemm g{(const bf16_t*)(ws + WS_U), (const bf16_t*)(ws + WS_WDN), T, DM, FF}; EpiRes E{xo, xo, modl + 5 * 1024};
          pg8::gemm_phase<EpiRes, pg8::StaticOrder, false, true>(lds, g, S, E); }
        grid.sync();
    }
    { const int l = 0; PH_BEGIN
      final_norm_phase(xo, p.final_g, gw, ngw, lane); }
#undef PH_BEGIN
}

extern "C" void kernel_launch(void* const* d_in, const int* in_sizes, int n_in, void* d_out, int out_size, void* d_ws, size_t ws_size, hipStream_t stream) {
    static int grid_blocks = 0;
    if (grid_blocks == 0) {
        if (n_in != 13 || out_size != T * DM || ws_size < WS_END) { fprintf(stderr, "kernel_launch: unexpected shapes (n_in %d out %d ws %zu need %zu)\n", n_in, out_size, ws_size, (size_t)WS_END); grid_blocks = -1; return; }
        int dev = 0, cus = 0, per_cu = 0;
        (void)hipGetDevice(&dev); (void)hipDeviceGetAttribute(&cus, hipDeviceAttributeMultiprocessorCount, dev);
        if (hipFuncSetAttribute((const void*)hybrid_fwd, hipFuncAttributeMaxDynamicSharedMemorySize, LDS_BYTES) != hipSuccess) { fprintf(stderr, "kernel_launch: hipFuncSetAttribute failed\n"); grid_blocks = -1; return; }
        if (hipOccupancyMaxActiveBlocksPerMultiprocessor(&per_cu, (const void*)hybrid_fwd, 512, LDS_BYTES) != hipSuccess || per_cu < 1) { fprintf(stderr, "kernel_launch: occupancy query gave %d\n", per_cu); per_cu = 1; (void)hipGetLastError(); }
        grid_blocks = cus * per_cu;
    }
    if (grid_blocks < 0) return;
    Params p{};
    p.x = (const float*)d_in[0]; p.c = (const float*)d_in[1]; p.norm_mix_g = (const float*)d_in[2]; p.w_in = (const float*)d_in[3]; p.w_ret_out = (const float*)d_in[4];
    p.w_sb_out = (const float*)d_in[5]; p.w_mix_out = (const float*)d_in[6]; p.norm_mlp_g = (const float*)d_in[7]; p.w_up = (const float*)d_in[8]; p.w_down = (const float*)d_in[9];
    p.w_ada = (const float*)d_in[10]; p.b_ada = (const float*)d_in[11]; p.final_g = (const float*)d_in[12];
    p.out = (float*)d_out; p.ws = (unsigned char*)d_ws;
    void* args[] = {&p};
    hipError_t e = hipLaunchCooperativeKernel((const void*)hybrid_fwd, dim3(grid_blocks), dim3(512), args, LDS_BYTES, stream);
    if (e != hipSuccess) fprintf(stderr, "kernel_launch: cooperative launch failed: %s (grid %d)\n", hipGetErrorString(e), grid_blocks);
}
```

```cpp
#include <hip/hip_runtime.h>
#include <hip/hip_cooperative_groups.h>
#include <cstdio>
#include <cstdint>
namespace cg = cooperative_groups;
#define DI __device__ __forceinline__
#define PROBE_CLASS -1
namespace pg8 {
#define PG8_LAS __attribute__((address_space(3)))
typedef unsigned short bf16_t;
typedef short bf16x8 __attribute__((ext_vector_type(8)));
typedef float f32x4 __attribute__((ext_vector_type(4)));
typedef unsigned u32x4 __attribute__((ext_vector_type(4)));
constexpr int BM = 256, BK = 64, HALF = 128, HTB = HALF * BK * 2  , STAGE_BYTES = 8 * HTB, NXCD = 8, WGM = 8;

__host__ __device__ __forceinline__ int lds_byte(int r, int c) { const int st = (r >> 4) * 2 + (c >> 5), rr = r & 15, cc = c & 31, ob = rr * 64 + cc * 2; return st * 1024 + (ob ^ (((ob >> 9) & 1) << 5)); }
__host__ __device__ __forceinline__ void stage_rc(int b, int& R, int& C) { const int st = b / 1024, sb = b % 1024, swz = sb ^ (((sb >> 9) & 1) << 5); R = (st >> 1) * 16 + swz / 64; C = (st & 1) * 32 + (swz % 64) / 2; }
__host__ __device__ __forceinline__ int perm32(int rho) { const int n = rho >> 4, i = rho & 15; return 8 * (i >> 2) + 4 * n + (i & 3); }

struct Unit { int pm, pn; };
struct Gemm { const bf16_t* A; const bf16_t* Bt; int M, N, K; };

struct StaticOrder {
    int nM, nN, nwg, G, c;
    __host__ __device__ void init(int M, int N, int G_, int c_) { nM = M / BM; nN = N / BM; nwg = nM * nN; G = G_; c = c_; }
    __host__ __device__ bool next(int i, Unit& u) const {
        const long L = (long)i * G + c; if (L >= nwg) return false;
        int wgid = (int)L; { const int q = nwg / NXCD, r = nwg % NXCD, xcd = wgid % NXCD, off = wgid / NXCD; wgid = (xcd < r ? xcd * (q + 1) : r * (q + 1) + (xcd - r) * q) + off; }
        const int nig = WGM * nN, gid = wgid / nig, fm = gid * WGM, gsz = (nM - fm) < WGM ? (nM - fm) : WGM;
        u.pm = fm + ((wgid % nig) % gsz); u.pn = (wgid % nig) / gsz; return true;
    }
    __device__ __forceinline__ void a_ready(const Unit&) const {}
    __device__ __forceinline__ void done(const Unit&) const {}
};

template <class Epi, class Sched, bool ALIGN_EPI = false, bool SP2 = false>
__device__ __forceinline__ void gemm_phase(PG8_LAS unsigned char* lds, const Gemm g, const Sched& S, const Epi& E) {
    int tid_l = threadIdx.x; asm volatile("" : "+v"(tid_l)); const int tid = tid_l, wid = __builtin_amdgcn_readfirstlane(tid >> 6), lane = tid & 63, wr = wid >> 2, wc = wid & 3, fr = lane & 15, fq = lane >> 4;
    const int K = g.K, nt = K / BK;
    unsigned voffA[2], voffB[2];
#pragma unroll
    for (int i = 0; i < 2; ++i) { int R, C; stage_rc(tid * 16 + i * 8192, R, C); const int Rb = Epi::PERM ? ((R & ~31) + perm32(R & 31)) : R;
        voffA[i] = (unsigned)(R * K + C) * 2u; voffB[i] = (unsigned)(Rb * K + C) * 2u; }
    const size_t kstep = (size_t)(BK * 2);
    const size_t hstep = (size_t)HALF * K * 2;
    const size_t tstep = 2 * hstep;
    const unsigned ldsw = (unsigned)wid * 1024u;
    const int aoff = lds_byte(wr * 64 + fr, fq * 8), boff = lds_byte(wc * 32 + fr, fq * 8);
#define PG8_SA(b, h) (((b) * 2 + (h)) * HTB)
#define PG8_SB(b, h) ((4 + (b) * 2 + (h)) * HTB)
#define PG8_STAGE(bufoff, gbase, voff) do { _Pragma("unroll") for (int _i = 0; _i < 2; ++_i) \
        __builtin_amdgcn_global_load_lds((const unsigned*)((const char*)(gbase) + (voff)[_i]), (PG8_LAS unsigned*)(lds + (bufoff) + ldsw + _i * 8192), 16, 0, 0); } while (0)
#define PG8_LDA(dst, b, h) do { _Pragma("unroll") for (int m = 0; m < 4; ++m) _Pragma("unroll") for (int k = 0; k < 2; ++k) dst[m][k] = *(const PG8_LAS bf16x8*)(lds + PG8_SA(b, h) + aoff + m * 2048 + k * 1024); } while (0)
#define PG8_LDB(dst, b, h) do { _Pragma("unroll") for (int n = 0; n < 2; ++n) _Pragma("unroll") for (int k = 0; k < 2; ++k) dst[n][k] = *(const PG8_LAS bf16x8*)(lds + PG8_SB(b, h) + boff + n * 2048 + k * 1024); } while (0)
#define PG8_MMA(ai, bj, At, Bt) do { __builtin_amdgcn_s_setprio(1); _Pragma("unroll") for (int m = 0; m < 4; ++m) _Pragma("unroll") for (int n = 0; n < 2; ++n) _Pragma("unroll") for (int k = 0; k < 2; ++k) \
        acc[ai][bj][m][n] = __builtin_amdgcn_mfma_f32_16x16x32_bf16(Bt[n][k], At[m][k], acc[ai][bj][m][n], 0, 0, 0); __builtin_amdgcn_s_setprio(0); } while (0)
#define PG8_WAIT_V(n) asm volatile("s_waitcnt vmcnt(" #n ")" ::: "memory")
#define PG8_WAIT_L(n) asm volatile("s_waitcnt lgkmcnt(" #n ")" ::: "memory")
#define PG8_BAR __builtin_amdgcn_s_barrier()
#define PG8_SCHED __builtin_amdgcn_sched_barrier(0)
    Unit cur, nxt; int ui = 0;
    if (!S.next(0, cur)) return;
    f32x4 acc[2][2][4][2];
#pragma unroll
    for (int a = 0; a < 2; ++a)
#pragma unroll
        for (int b = 0; b < 2; ++b)
#pragma unroll
            for (int m = 0; m < 4; ++m)
#pragma unroll
                for (int n = 0; n < 2; ++n) acc[a][b][m][n] = (f32x4){0.f, 0.f, 0.f, 0.f};
    bf16x8 At[4][2], B0[2][2], B1[2][2];
    const char* cA = (const char*)g.A + (size_t)cur.pm * tstep; const char* cB = (const char*)g.Bt + (size_t)cur.pn * tstep;
    S.a_ready(cur);
    if constexpr (SP2) {
        PG8_STAGE(PG8_SB(0, 0), cB, voffB); PG8_STAGE(PG8_SB(0, 1), cB + hstep, voffB); PG8_STAGE(PG8_SA(0, 0), cA, voffA); PG8_STAGE(PG8_SA(0, 1), cA + hstep, voffA);
        if (wr == 1) PG8_BAR;
        PG8_WAIT_V(2); PG8_BAR;
        PG8_STAGE(PG8_SB(1, 0), cB + kstep, voffB); PG8_STAGE(PG8_SA(1, 0), cA + kstep, voffA); PG8_STAGE(PG8_SB(1, 1), cB + hstep + kstep, voffB);
        PG8_WAIT_V(6); PG8_BAR;
    } else {
        PG8_STAGE(PG8_SB(0, 0), cB, voffB); PG8_STAGE(PG8_SA(0, 0), cA, voffA); PG8_STAGE(PG8_SB(0, 1), cB + hstep, voffB); PG8_STAGE(PG8_SA(0, 1), cA + hstep, voffA);
        if (wr == 1) PG8_BAR;
        PG8_WAIT_V(4); PG8_BAR;
        PG8_STAGE(PG8_SB(1, 0), cB + kstep, voffB); PG8_STAGE(PG8_SA(1, 0), cA + kstep, voffA); PG8_STAGE(PG8_SB(1, 1), cB + hstep + kstep, voffB);
        PG8_WAIT_V(6); PG8_BAR;
    }
    for (;;) {
        const bool has_next = S.next(ui + 1, nxt);
        const char* nA = has_next ? (const char*)g.A + (size_t)nxt.pm * tstep : cA; const char* nB = has_next ? (const char*)g.Bt + (size_t)nxt.pn * tstep : cB;
        for (int t = 0; t < nt; t += 2) {
            const bool last = (t == nt - 2);
            const char* a1 = cA + (size_t)(t + 1) * kstep;
            const char* a2 = last ? nA : cA + (size_t)(t + 2) * kstep; const char* b2 = last ? nB : cB + (size_t)(t + 2) * kstep;
            const char* a3 = a2 + kstep; const char* b3 = b2 + kstep;
            if (last && has_next) S.a_ready(nxt);
            if constexpr (SP2) {
            PG8_LDB(B0, 0, 0); PG8_LDB(B1, 0, 1); PG8_SCHED; PG8_LDA(At, 0, 0); PG8_STAGE(PG8_SA(1, 1), a1 + hstep, voffA);
            PG8_WAIT_V(8); PG8_WAIT_L(0); PG8_BAR; PG8_MMA(0, 0, At, B0); PG8_MMA(0, 1, At, B1); PG8_BAR; PG8_SCHED;
            PG8_LDA(At, 0, 1); PG8_STAGE(PG8_SB(0, 0), b2, voffB); PG8_STAGE(PG8_SB(0, 1), b2 + hstep, voffB); PG8_STAGE(PG8_SA(0, 0), a2, voffA);
            PG8_WAIT_V(8); PG8_WAIT_L(0); PG8_BAR; PG8_MMA(1, 0, At, B0); PG8_MMA(1, 1, At, B1); PG8_BAR; PG8_SCHED;
            PG8_LDB(B0, 1, 0); PG8_LDB(B1, 1, 1); PG8_SCHED; PG8_LDA(At, 1, 0); PG8_STAGE(PG8_SA(0, 1), a2 + hstep, voffA);
            PG8_WAIT_V(8); PG8_WAIT_L(0); PG8_BAR; PG8_MMA(0, 0, At, B0); PG8_MMA(0, 1, At, B1); PG8_BAR; PG8_SCHED;
            PG8_LDA(At, 1, 1); PG8_STAGE(PG8_SB(1, 0), b3, voffB); PG8_STAGE(PG8_SB(1, 1), b3 + hstep, voffB); PG8_STAGE(PG8_SA(1, 0), a3, voffA);
            PG8_WAIT_V(8); PG8_WAIT_L(0); PG8_BAR; PG8_MMA(1, 0, At, B0); PG8_MMA(1, 1, At, B1); PG8_BAR; PG8_SCHED;
            } else {
            PG8_LDB(B0, 0, 0); PG8_SCHED; PG8_LDA(At, 0, 0); PG8_STAGE(PG8_SA(1, 1), a1 + hstep, voffA);
            PG8_WAIT_L(8); PG8_BAR; PG8_WAIT_L(0); PG8_MMA(0, 0, At, B0); PG8_BAR; PG8_SCHED;
            PG8_LDB(B1, 0, 1); PG8_STAGE(PG8_SB(0, 0), b2, voffB);
            PG8_BAR; PG8_WAIT_L(0); PG8_MMA(0, 1, At, B1); PG8_BAR;
            PG8_LDA(At, 0, 1); PG8_STAGE(PG8_SA(0, 0), a2, voffA);
            PG8_BAR; PG8_WAIT_L(0); PG8_MMA(1, 0, At, B0); PG8_BAR; PG8_SCHED;
            PG8_STAGE(PG8_SB(0, 1), b2 + hstep, voffB);
            PG8_WAIT_V(6); PG8_BAR; PG8_MMA(1, 1, At, B1); PG8_BAR;
            PG8_LDB(B0, 1, 0); PG8_SCHED; PG8_LDA(At, 1, 0); PG8_STAGE(PG8_SA(0, 1), a2 + hstep, voffA);
            PG8_WAIT_L(8); PG8_BAR; PG8_WAIT_L(0); PG8_MMA(0, 0, At, B0); PG8_BAR; PG8_SCHED;
            PG8_LDB(B1, 1, 1); PG8_STAGE(PG8_SB(1, 0), b3, voffB);
            PG8_BAR; PG8_WAIT_L(0); PG8_MMA(0, 1, At, B1); PG8_BAR;
            PG8_LDA(At, 1, 1); PG8_STAGE(PG8_SA(1, 0), a3, voffA);
            PG8_BAR; PG8_WAIT_L(0); PG8_MMA(1, 0, At, B0); PG8_BAR; PG8_SCHED;
            PG8_STAGE(PG8_SB(1, 1), b3 + hstep, voffB);
            PG8_WAIT_V(6); PG8_BAR; PG8_MMA(1, 1, At, B1); PG8_BAR;
            }
        }
        if constexpr (ALIGN_EPI) { if (wr == 0) PG8_BAR; }
        if constexpr (!Epi::AFTER_DRAIN) { E(acc, cur, wr, wc, fr, fq); S.done(cur); }
        if (!has_next) break;
#pragma unroll
        for (int a = 0; a < 2; ++a)
#pragma unroll
            for (int b = 0; b < 2; ++b)
#pragma unroll
                for (int m = 0; m < 4; ++m)
#pragma unroll
                    for (int n = 0; n < 2; ++n) acc[a][b][m][n] = (f32x4){0.f, 0.f, 0.f, 0.f};
        cur = nxt; cA = nA; cB = nB; ++ui;
        if constexpr (ALIGN_EPI) { if (wr == 1) PG8_BAR; }
    }
    PG8_WAIT_V(0);
    if constexpr (!ALIGN_EPI) { if (wr == 0) PG8_BAR; }
    PG8_BAR;
    if constexpr (Epi::AFTER_DRAIN) { E.fused(acc, cur, wr, wc, fr, fq, lds, wid, lane); S.done(cur); }
#undef PG8_SA
#undef PG8_SB
#undef PG8_STAGE
#undef PG8_LDA
#undef PG8_LDB
#undef PG8_MMA
#undef PG8_WAIT_V
#undef PG8_WAIT_L
#undef PG8_BAR
#undef PG8_SCHED
}
}

using pg8::bf16_t; using pg8::bf16x8; using pg8::f32x4; using pg8::u32x4; using pg8::Unit;
typedef float f32x16 __attribute__((ext_vector_type(16)));
typedef float f32x2 __attribute__((ext_vector_type(2)));
typedef unsigned u32x2 __attribute__((ext_vector_type(2)));
typedef __bf16 bf16x2_t __attribute__((ext_vector_type(2)));
#define LAS __attribute__((address_space(3)))
#define MFMA32(a, b, c) __builtin_amdgcn_mfma_f32_32x32x16_bf16((a), (b), (c), 0, 0, 0)

constexpr int T = 16384, DM = 1024, SEQ = 4096, TH = 8192, FF = 4096, INW = 11264, NMOD = 6144;
constexpr int RCH = 512, NRCH = SEQ / RCH;
constexpr size_t MiB = 1u << 20;
constexpr size_t WS_MOD = 0, WS_COSP = 1 * MiB, WS_SINP = 3 * MiB, WS_COST = 5 * MiB, WS_SINT = 7 * MiB, WS_H = 9 * MiB;
constexpr size_t WS_WINA = 41 * MiB, WS_WINB = 53 * MiB, WS_WG = 61 * MiB, WS_WRET = 65 * MiB, WS_WSB = 69 * MiB, WS_WMIX = 71 * MiB, WS_WUP = 73 * MiB, WS_WDN = 81 * MiB;
constexpr size_t WS_YRET = 89 * MiB, WS_YSB = 153 * MiB, WS_RSNAP = 185 * MiB, WS_X = 201 * MiB, WS_END = 329 * MiB;
constexpr size_t WS_QR = WS_X, WS_KN = WS_X + 16 * MiB, WS_SQ = WS_X + 32 * MiB, WS_SK = WS_X + 48 * MiB, WS_KZT = WS_X + 64 * MiB, WS_VT = WS_X + 80 * MiB, WS_SVT = WS_X + 112 * MiB;
static_assert(WS_KN == WS_QR + 16 * MiB && WS_SQ == WS_QR + 32 * MiB && WS_SK == WS_QR + 48 * MiB && WS_VT == WS_KZT + 16 * MiB && WS_SVT == WS_KZT + 48 * MiB, "epilogue pointer arithmetic");
constexpr size_t WS_MERGED = WS_X, WS_TMP = WS_X + 32 * MiB, WS_U = WS_X;
constexpr int LDS_BYTES = 135168;
constexpr float SB_STOP = -80.0f;

DI unsigned pk2(float lo, float hi) { f32x2 v = {lo, hi}; bf16x2_t b = __builtin_convertvector(v, bf16x2_t); return __builtin_bit_cast(unsigned, b); }
DI float bflo(unsigned w) { return __uint_as_float(w << 16); }
DI float bfhi(unsigned w) { return __uint_as_float(w & 0xffff0000u); }
DI u32x4 pack8(f32x4 a, f32x4 b) { u32x4 w; w.x = pk2(a[0], a[1]); w.y = pk2(a[2], a[3]); w.z = pk2(b[0], b[1]); w.w = pk2(b[2], b[3]); return w; }
DI void unpack8(u32x4 w, f32x4& a, f32x4& b) { a = (f32x4){bflo(w.x), bfhi(w.x), bflo(w.y), bfhi(w.y)}; b = (f32x4){bflo(w.z), bfhi(w.z), bflo(w.w), bfhi(w.w)}; }
DI float wave_sum(float v) {
#pragma unroll
    for (int o = 1; o < 64; o <<= 1) v += __shfl_xor(v, o);
    return v;
}
DI float log2gamma(int h) { return log2f(1.0f - exp2f(-5.0f - (float)h)); }
DI float sigmoidf_(float v) { return 1.0f / (1.0f + __expf(-v)); }
DI int crow(int reg, int hh) { return (reg & 3) + 8 * (reg >> 2) + 4 * hh; }
DI size_t nfrag(int row, int col, int C) { return ((((size_t)(row >> 5) * (C >> 4) + (col >> 4)) * 2 + ((col >> 3) & 1)) * 32 + (row & 31)) * 8 + (col & 7); }
DI size_t tfrag0(int ch, int tok0, int NTOK) { return ((((size_t)(ch >> 5) * (NTOK >> 4) + (tok0 >> 4)) * 2) * 32 + (ch & 31)) * 8 + 4 * ((tok0 >> 3) & 1); }
DI void st_tfrag(bf16_t* base, int ch, int tok0, int NTOK, f32x4 a, f32x4 b) {
    bf16_t* q = base + tfrag0(ch, tok0, NTOK); u32x2 w0, w1; w0.x = pk2(a[0], a[1]); w0.y = pk2(a[2], a[3]); w1.x = pk2(b[0], b[1]); w1.y = pk2(b[2], b[3]);
    *(u32x2*)q = w0; *(u32x2*)(q + 256) = w1; }


struct EpiInA {
    static constexpr bool PERM = true, AFTER_DRAIN = false;
    bf16_t *xb, *yret; const float *cosP, *sinP;
    DI void operator()(const f32x4 (&acc)[2][2][4][2], const Unit& u, int wr, int wc, int fr_, int fq) const {
        int fr = fr_; asm volatile("" : "+v"(fr));
        const int pn = u.pn, row0 = u.pm * 256 + wr * 64 + fr, cl = wc * 32 + 8 * fq;
        if (pn < 8) {
            bf16_t* dst = xb + (size_t)(pn >> 2) * (8u << 20); const int hc = (pn & 3) * 256 + cl;
            const float sc = pn < 4 ? 1.0f : 0.0625f;
#pragma unroll
            for (int ai = 0; ai < 2; ++ai)
#pragma unroll
                for (int m = 0; m < 4; ++m) {
                    const int row = row0 + ai * 128 + m * 16, pos = row & (SEQ - 1);
                    const f32x4* cp = (const f32x4*)(cosP + pos * 128 + cl); const f32x4* sp = (const f32x4*)(sinP + pos * 128 + cl);
                    f32x4 o1[2], o2[2];
#pragma unroll
                    for (int n = 0; n < 2; ++n) { const f32x4 c = cp[n], s = sp[n], t1 = acc[ai][0][m][n], t2 = acc[ai][1][m][n];
                        o1[n] = (t1 * c - t2 * s) * sc; o2[n] = (t1 * s + t2 * c) * sc; }
                    *(u32x4*)(dst + nfrag(row, hc, 1024)) = pack8(o1[0], o1[1]); *(u32x4*)(dst + nfrag(row, hc + 128, 1024)) = pack8(o2[0], o2[1]);
                    __builtin_amdgcn_sched_barrier(0);
                }
        } else {
            const int mode = pn < 16 ? 0 : (pn < 20 ? 1 : 2);
            const int hc = (pn < 16 ? (pn - 8) : (pn & 3)) * 256 + cl;
            bf16_t* dst = xb + (size_t)(mode + 1) * (8u << 20);
#pragma unroll
            for (int ai = 0; ai < 2; ++ai)
#pragma unroll
                for (int m = 0; m < 4; ++m) {
                    const int row = row0 + ai * 128 + m * 16;
#pragma unroll
                    for (int bj = 0; bj < 2; ++bj) {
                        f32x4 v0 = acc[ai][bj][m][0], v1 = acc[ai][bj][m][1];
                        if (mode == 0) {
#pragma unroll
                            for (int e = 0; e < 4; ++e) { v0[e] = v0[e] * sigmoidf_(v0[e]); v1[e] = v1[e] * sigmoidf_(v1[e]); }
                        } else if (mode == 1) { v0 = v0 * 0.125f; v1 = v1 * 0.125f; }
                        if (mode == 0) *(u32x4*)(yret + (size_t)row * 2048 + hc + bj * 128) = pack8(v0, v1);
                        else *(u32x4*)(dst + nfrag(row, hc + bj * 128, 1024)) = pack8(v0, v1);
                    }
                }
        }
    }
};

struct EpiInB {
    static constexpr bool PERM = true, AFTER_DRAIN = false;
    bf16_t *kzT; const float *cosT, *sinT;
    DI void operator()(const f32x4 (&acc)[2][2][4][2], const Unit& u, int wr, int wc, int fr_, int fq) const {
        int fr = fr_; asm volatile("" : "+v"(fr));
        const int pm = u.pm, tok0 = u.pn * 256 + wc * 32 + 8 * fq;
        if (pm < 4) {
            const float l2g = log2gamma(pm), ginv = __builtin_amdgcn_exp2f(-l2g);
#pragma unroll
            for (int m = 0; m < 4; ++m) {
                const int i = wr * 64 + m * 16 + fr;
#pragma unroll
                for (int bj = 0; bj < 2; ++bj) {
                    const int tok = tok0 + bj * 128, pos = tok & (SEQ - 1);
                    const f32x4* cp = (const f32x4*)(cosT + i * SEQ + pos); const f32x4* sp = (const f32x4*)(sinT + i * SEQ + pos);
                    f32x4 o1[2], o2[2];
                    float zr = __builtin_amdgcn_exp2f((float)((RCH - 1) - (pos & (RCH - 1))) * l2g) * 0.0625f;
#pragma unroll
                    for (int n = 0; n < 2; ++n) { const f32x4 c = cp[n], s = sp[n], t1 = acc[0][bj][m][n], t2 = acc[1][bj][m][n];
                        f32x4 z;
#pragma unroll
                        for (int e = 0; e < 4; ++e) { z[e] = zr; zr *= ginv; }
                        o1[n] = (t1 * c - t2 * s) * z; o2[n] = (t1 * s + t2 * c) * z; }
                    st_tfrag(kzT, pm * 256 + i, tok, TH, o1[0], o1[1]);
                    st_tfrag(kzT, pm * 256 + 128 + i, tok, TH, o2[0], o2[1]);
                    __builtin_amdgcn_sched_barrier(0);
                }
            }
        } else {
            bf16_t* dst = kzT + (size_t)(pm < 12 ? 8u << 20 : 24u << 20); const int ch0 = (pm < 12 ? (pm - 4) : (pm - 12)) * 256 + wr * 64 + fr;
#pragma unroll
            for (int ai = 0; ai < 2; ++ai)
#pragma unroll
                for (int m = 0; m < 4; ++m)
#pragma unroll
                    for (int bj = 0; bj < 2; ++bj)
                        st_tfrag(dst, ch0 + ai * 128 + m * 16, tok0 + bj * 128, TH, acc[ai][bj][m][0], acc[ai][bj][m][1]);
        }
    }
};

template <int MODE> struct EpiEw {
    static constexpr bool PERM = true, AFTER_DRAIN = false;
    bf16_t* O; const bf16_t* P; int ld;
    DI void operator()(const f32x4 (&acc)[2][2][4][2], const Unit& u, int wr, int wc, int fr_, int fq) const {
        int fr = fr_; asm volatile("" : "+v"(fr));
        const int row0 = u.pm * 256 + wr * 64 + fr, col0 = u.pn * 256 + wc * 32 + 8 * fq;
#pragma unroll
        for (int ai = 0; ai < 2; ++ai)
#pragma unroll
            for (int m = 0; m < 4; ++m)
#pragma unroll
                for (int bj = 0; bj < 2; ++bj) {
                    const size_t off = (size_t)(row0 + ai * 128 + m * 16) * ld + col0 + bj * 128;
                    f32x4 v0 = acc[ai][bj][m][0], v1 = acc[ai][bj][m][1];
                    if (MODE == 0) {
#pragma unroll
                        for (int e = 0; e < 4; ++e) { v0[e] = sigmoidf_(v0[e]); v1[e] = sigmoidf_(v1[e]); }
                    } else if (MODE == 1) {
#pragma unroll
                        for (int e = 0; e < 4; ++e) { const float a = fmaxf(v0[e], 0.f), b = fmaxf(v1[e], 0.f); v0[e] = a * a; v1[e] = b * b; }
                    } else if (MODE == 2) {
                        f32x4 a, b; unpack8(*(const u32x4*)(O + off), a, b); v0 = v0 * a; v1 = v1 * b;
                    } else {
                        f32x4 a, b, c, d; unpack8(*(const u32x4*)(O + off), a, b); unpack8(*(const u32x4*)(P + off), c, d); v0 = a + c * v0; v1 = b + d * v1;
                    }
                    *(u32x4*)(O + off) = pack8(v0, v1);
                }
    }
};

struct EpiRes {
    static constexpr bool PERM = true, AFTER_DRAIN = false;
    const float* xin; float* xout; const float* gate;
    DI void operator()(const f32x4 (&acc)[2][2][4][2], const Unit& u, int wr, int wc, int fr_, int fq) const {
        int fr = fr_; asm volatile("" : "+v"(fr));
        const int row0 = u.pm * 256 + wr * 64 + fr, col0 = u.pn * 256 + wc * 32 + 8 * fq;
#pragma unroll
        for (int ai = 0; ai < 2; ++ai)
#pragma unroll
            for (int m = 0; m < 4; ++m) {
                const int row = row0 + ai * 128 + m * 16; const float* gp = gate + (row >> 12) * NMOD;
#pragma unroll
                for (int bj = 0; bj < 2; ++bj) {
                    const int col = col0 + bj * 128; const size_t off = (size_t)row * DM + col;
                    const f32x4 g0 = *(const f32x4*)(gp + col), g1 = *(const f32x4*)(gp + col + 4);
                    const f32x4 x0 = *(const f32x4*)(xin + off), x1 = *(const f32x4*)(xin + off + 4);
                    *(f32x4*)(xout + off) = x0 + g0 * acc[ai][bj][m][0]; *(f32x4*)(xout + off + 4) = x1 + g1 * acc[ai][bj][m][1];
                }
            }
    }
};

DI void cvt_tile(const float* src, int ldsrc, int k0, int n0, bf16_t* dst1, bf16_t* dst2, int K, LAS float* tile, int tid) {
    const int kr = tid >> 4, nc = (tid & 15) * 4;
#pragma unroll
    for (int p = 0; p < 2; ++p) { const int k = kr + 32 * p; const f32x4 v = *(const f32x4*)(src + (size_t)(k0 + k) * ldsrc + n0 + nc);
        tile[k * 65 + nc] = v[0]; tile[k * 65 + nc + 1] = v[1]; tile[k * 65 + nc + 2] = v[2]; tile[k * 65 + nc + 3] = v[3]; }
    __syncthreads();
    const int n = tid >> 3, ks = (tid & 7) * 8; const LAS float* s = tile + ks * 65 + n;
    u32x4 o; o.x = pk2(s[0], s[65]); o.y = pk2(s[2 * 65], s[3 * 65]); o.z = pk2(s[4 * 65], s[5 * 65]); o.w = pk2(s[6 * 65], s[7 * 65]);
    *(u32x4*)(dst1 + (size_t)n * K + k0 + ks) = o;
    if (dst2) *(u32x4*)(dst2 + (size_t)n * K + k0 + ks) = o;
    __syncthreads();
}

struct Params {
    const float *x, *c, *norm_mix_g, *w_in, *w_ret_out, *w_sb_out, *w_mix_out, *norm_mlp_g, *w_up, *w_down, *w_ada, *b_ada, *final_g;
    float* out; unsigned char* ws;
};

DI void convert_weights(const Params& p, int l, LAS float* tile, int tid) {
    unsigned char* ws = p.ws;
    bf16_t* WinA = (bf16_t*)(ws + WS_WINA); bf16_t* WinB = (bf16_t*)(ws + WS_WINB); bf16_t* Wg = (bf16_t*)(ws + WS_WG);
    constexpr int I_IN = 16 * 176, I_RET = 32 * 16, I_SB = 16 * 16, I_MIX = 16 * 16, I_UP = 16 * 64, I_DN = 64 * 16;
    constexpr int NIT = I_IN + I_RET + I_SB + I_MIX + I_UP + I_DN;
    for (int it = blockIdx.x; it < NIT; it += gridDim.x) {
        int r = it;
        if (r < I_IN) {
            const int kb = r / 176, nb = r % 176, n0 = nb * 64; bf16_t* d1; bf16_t* d2 = nullptr;
            if (n0 < 1024) d1 = WinA + (size_t)n0 * 1024;
            else if (n0 < 2048) { d1 = WinA + (size_t)n0 * 1024; d2 = WinB + (size_t)(n0 - 1024) * 1024; }
            else if (n0 < 4096) d1 = WinB + (size_t)(n0 - 1024) * 1024;
            else if (n0 < 8192) d1 = WinA + (size_t)(n0 - 2048) * 1024;
            else if (n0 < 9216) d1 = WinB + (size_t)(n0 - 5120) * 1024;
            else d1 = Wg + (size_t)(n0 - 9216) * 1024;
            cvt_tile(p.w_in + (size_t)l * DM * INW, INW, kb * 64, n0, d1, d2, 1024, tile, tid); continue;
        }
        r -= I_IN;
        if (r < I_RET) { const int kb = r / 16, nb = r % 16; cvt_tile(p.w_ret_out + (size_t)l * 2048 * 1024, 1024, kb * 64, nb * 64, (bf16_t*)(ws + WS_WRET) + (size_t)nb * 64 * 2048, nullptr, 2048, tile, tid); continue; }
        r -= I_RET;
        if (r < I_SB) { const int kb = r / 16, nb = r % 16; cvt_tile(p.w_sb_out + (size_t)l * 1024 * 1024, 1024, kb * 64, nb * 64, (bf16_t*)(ws + WS_WSB) + (size_t)nb * 64 * 1024, nullptr, 1024, tile, tid); continue; }
        r -= I_SB;
        if (r < I_MIX) { const int kb = r / 16, nb = r % 16; cvt_tile(p.w_mix_out + (size_t)l * 1024 * 1024, 1024, kb * 64, nb * 64, (bf16_t*)(ws + WS_WMIX) + (size_t)nb * 64 * 1024, nullptr, 1024, tile, tid); continue; }
        r -= I_MIX;
        if (r < I_UP) { const int kb = r / 64, nb = r % 64; cvt_tile(p.w_up + (size_t)l * 1024 * 4096, 4096, kb * 64, nb * 64, (bf16_t*)(ws + WS_WUP) + (size_t)nb * 64 * 1024, nullptr, 1024, tile, tid); continue; }
        r -= I_UP;
        { const int kb = r / 16, nb = r % 16; cvt_tile(p.w_down + (size_t)l * 4096 * 1024, 1024, kb * 64, nb * 64, (bf16_t*)(ws + WS_WDN) + (size_t)nb * 64 * 4096, nullptr, 4096, tile, tid); }
    }
}

DI void tables_and_mod(const Params& p, LAS float* lds, int tid) {
    float* cosP = (float*)(p.ws + WS_COSP); float* sinP = (float*)(p.ws + WS_SINP); float* cosT = (float*)(p.ws + WS_COST); float* sinT = (float*)(p.ws + WS_SINT);
    for (int idx = blockIdx.x * 512 + tid; idx < SEQ * 128; idx += gridDim.x * 512) {
        const int pos = idx >> 7, i = idx & 127;
        const float inv = powf(10000.0f, -(float)i / 128.0f); const float ang = (float)pos * inv;
        const float c = cosf(ang), s = sinf(ang);
        cosP[idx] = c; sinP[idx] = s; cosT[i * SEQ + pos] = c; sinT[i * SEQ + pos] = s;
    }
    float* mod = (float*)(p.ws + WS_MOD);
    LAS float* cact = lds; LAS float* red = lds + 4096;
    const int wave = tid >> 6, lane = tid & 63;
    bool have = false;
    for (int it = blockIdx.x; it < 2 * 96; it += gridDim.x) {
        if (!have) { for (int e = tid; e < 4096; e += 512) { const float v = p.c[e]; cact[e] = v * sigmoidf_(v); } have = true; __syncthreads(); }
        const int l = it / 96, c0 = (it % 96) * 64;
        const float* w = p.w_ada + (size_t)l * DM * NMOD + c0 + lane;
        float a0 = 0.f, a1 = 0.f, a2 = 0.f, a3 = 0.f;
#pragma unroll 8
        for (int k = wave * 128; k < wave * 128 + 128; ++k) { const float wv = w[(size_t)k * NMOD]; a0 += cact[k] * wv; a1 += cact[1024 + k] * wv; a2 += cact[2048 + k] * wv; a3 += cact[3072 + k] * wv; }
        red[(wave * 4 + 0) * 64 + lane] = a0; red[(wave * 4 + 1) * 64 + lane] = a1; red[(wave * 4 + 2) * 64 + lane] = a2; red[(wave * 4 + 3) * 64 + lane] = a3;
        __syncthreads();
        if (tid < 256) { const int b = tid >> 6; float s = p.b_ada[l * NMOD + c0 + lane];
#pragma unroll
            for (int w8 = 0; w8 < 8; ++w8) s += red[(w8 * 4 + b) * 64 + lane];
            mod[(size_t)(l * 4 + b) * NMOD + c0 + lane] = s; }
        __syncthreads();
    }
}

DI void norm_phase(const float* xin, const float* g, const float* modl, int shift_i, int scale_i, bf16_t* hout, int gw, int ngw, int lane) {
    for (int row = gw; row < T; row += ngw) {
        const f32x4* xr = (const f32x4*)(xin + (size_t)row * DM) + lane;
        f32x4 v[4]; float s = 0.f;
#pragma unroll
        for (int j = 0; j < 4; ++j) { v[j] = xr[64 * j]; s += (v[j][0] * v[j][0] + v[j][1] * v[j][1]) + (v[j][2] * v[j][2] + v[j][3] * v[j][3]); }
        const float rstd = 1.0f / sqrtf(wave_sum(s) * (1.0f / DM) + 1e-6f);
        const float* mb = modl + (row >> 12) * NMOD;
        u32x2* o8 = (u32x2*)(hout + (size_t)row * DM) + lane;
#pragma unroll
        for (int j = 0; j < 4; ++j) { const int col = 4 * (lane + 64 * j);
            const f32x4 gg = *(const f32x4*)(g + col), sc = *(const f32x4*)(mb + scale_i * 1024 + col), sh = *(const f32x4*)(mb + shift_i * 1024 + col);
            const f32x4 y = v[j] * rstd * gg * (sc + 1.0f) + sh;
            u32x2 w; w.x = pk2(y[0], y[1]); w.y = pk2(y[2], y[3]); o8[64 * j] = w; }
    }
}
DI void final_norm_phase(float* x, const float* g, int gw, int ngw, int lane) {
    for (int row = gw; row < T; row += ngw) {
        f32x4* xr = (f32x4*)(x + (size_t)row * DM) + lane;
        f32x4 v[4]; float s = 0.f;
#pragma unroll
        for (int j = 0; j < 4; ++j) { v[j] = xr[64 * j]; s += (v[j][0] * v[j][0] + v[j][1] * v[j][1]) + (v[j][2] * v[j][2] + v[j][3] * v[j][3]); }
        const float rstd = 1.0f / sqrtf(wave_sum(s) * (1.0f / DM) + 1e-6f);
#pragma unroll
        for (int j = 0; j < 4; ++j) { const f32x4 gg = *(const f32x4*)(g + 4 * (lane + 64 * j)); xr[64 * j] = v[j] * rstd * gg; }
    }
}

DI void ret_state_item(int item, const bf16_t* kzT, const bf16_t* vT, bf16_t* rsnap, int lane) {
    const int dvt = item & 15, dkt = (item >> 4) & 7, bh = item >> 7, bl = bh >> 2, h = bh & 3, r = lane & 31, hh = lane >> 5;
    const bf16_t* ap = kzT + (((size_t)(h * 8 + dkt) * (TH / 16) + bl * (SEQ / 16)) * 2 + hh) * 256 + r * 8;
    const bf16_t* bp = vT + (((size_t)(h * 16 + dvt) * (TH / 16) + bl * (SEQ / 16)) * 2 + hh) * 256 + r * 8;
    const float dec = exp2f((float)RCH * log2gamma(h));
    f32x16 acc;
#pragma unroll
    for (int i = 0; i < 16; ++i) acc[i] = 0.f;
    for (int n = 0; n < NRCH; ++n) {
        bf16_t* sp = rsnap + (size_t)(bh * NRCH + n) * (512 * 256) + (size_t)(dvt * 16 + 2 * dkt) * 512 + r * 8 + 4 * hh;
#pragma unroll
        for (int g = 0; g < 4; ++g) { u32x2 w; w.x = pk2(acc[4 * g], acc[4 * g + 1]); w.y = pk2(acc[4 * g + 2], acc[4 * g + 3]); *(u32x2*)(sp + (g >> 1) * 512 + (g & 1) * 256) = w; }
        if (n == NRCH - 1) break;
#pragma unroll
        for (int i = 0; i < 16; ++i) acc[i] *= dec;
        const bf16_t* a = ap + (size_t)n * (RCH / 16) * 512; const bf16_t* b = bp + (size_t)n * (RCH / 16) * 512;
#pragma unroll 8
        for (int ks = 0; ks < RCH / 16; ++ks) acc = MFMA32(*(const bf16x8*)(a + ks * 512), *(const bf16x8*)(b + ks * 512), acc);
    }
}

DI void sb_item(int item, const bf16_t* sq, const bf16_t* sk, const bf16_t* svT, bf16_t* ysb, int lane) {
    const int qt = 127 - (item & 127), h = (item >> 7) & 15, bl = item >> 11, r = lane & 31, hh = lane >> 5;
    const size_t rowbase = (size_t)bl * SEQ; const int tq = qt * 32 + r;
    const int rt0 = (int)(rowbase >> 5);
    const bf16_t* qp = sq + (((size_t)(rt0 + qt) * 64 + h * 4) * 2 + hh) * 256 + r * 8;
    bf16x8 qf[4];
#pragma unroll
    for (int ks = 0; ks < 4; ++ks) qf[ks] = *(const bf16x8*)(qp + ks * 512);
    f32x16 o0, o1;
#pragma unroll
    for (int i = 0; i < 16; ++i) { o0[i] = 0.f; o1[i] = 0.f; }
    float carry = 0.f;
    for (int j = qt; j >= 0; --j) {
        const bf16_t* kp = sk + (((size_t)(rt0 + j) * 64 + h * 4) * 2 + hh) * 256 + r * 8;
        f32x16 st;
#pragma unroll
        for (int i = 0; i < 16; ++i) st[i] = 0.f;
#pragma unroll
        for (int ks = 0; ks < 4; ++ks) st = MFMA32(*(const bf16x8*)(kp + ks * 512), qf[ks], st);
        float lp[16], aw[16], gs[4], pg[4];
#pragma unroll
        for (int i = 0; i < 16; ++i) { const int key = j * 32 + crow(i, hh); const float z = st[i];
            const float spv = fmaxf(z, 0.f) + __logf(1.0f + __expf(-fabsf(z)));
            lp[i] = key < tq ? -spv : 0.f; }
#pragma unroll
        for (int g = 0; g < 4; ++g) { gs[g] = (lp[4 * g] + lp[4 * g + 1]) + (lp[4 * g + 2] + lp[4 * g + 3]); pg[g] = __shfl_xor(gs[g], 32); }
        float after = carry;
#pragma unroll
        for (int g = 3; g >= 0; --g) {
            float run = after + (hh == 0 ? pg[g] : 0.f);
#pragma unroll
            for (int e = 3; e >= 0; --e) { const int i = 4 * g + e; const int key = j * 32 + crow(i, hh);
                aw[i] = key < tq ? __expf(st[i] + lp[i] + run) : 0.f; run += lp[i]; }
            after += gs[g] + pg[g];
        }
        carry = after;
#pragma unroll
        for (int s = 0; s < 2; ++s) {
            u32x4 bw; bw.x = pk2(aw[8 * s], aw[8 * s + 1]); bw.y = pk2(aw[8 * s + 2], aw[8 * s + 3]); bw.z = pk2(aw[8 * s + 4], aw[8 * s + 5]); bw.w = pk2(aw[8 * s + 6], aw[8 * s + 7]);
            const bf16x8 bp = __builtin_bit_cast(bf16x8, bw);
            const bf16_t* vp = svT + (((size_t)(h * 2) * (TH / 16) + (rowbase >> 4) + 2 * j + s) * 2 + hh) * 256 + r * 8;
            o0 = MFMA32(*(const bf16x8*)vp, bp, o0);
            o1 = MFMA32(*(const bf16x8*)(vp + (size_t)(TH / 16) * 512), bp, o1);
        }
        if (__all(carry < SB_STOP)) break;
    }
    bf16_t* op = ysb + (rowbase + tq) * 1024 + h * 64 + 4 * hh;
#pragma unroll
    for (int g = 0; g < 4; ++g) {
        u32x2 w; w.x = pk2(o0[4 * g], o0[4 * g + 1]); w.y = pk2(o0[4 * g + 2], o0[4 * g + 3]); *(u32x2*)(op + 8 * g) = w;
        u32x2 w1; w1.x = pk2(o1[4 * g], o1[4 * g + 1]); w1.y = pk2(o1[4 * g + 2], o1[4 * g + 3]); *(u32x2*)(op + 32 + 8 * g) = w1;
    }
}

DI void ret_out_item(int item, const bf16_t* qr, const bf16_t* kn, const bf16_t* vT, const bf16_t* rsnap, bf16_t* yret, LAS float* stats, int wave, int lane) {
    const int bh = item >> 5, tg = 31 - (item & 31), bl = bh >> 2, h = bh & 3, tt = wave & 3, dh = wave >> 2, r = lane & 31, hh = lane >> 5;
    const int tok0 = tg * 128 + tt * 32, n = tok0 / RCH, tq = tok0 + r;
    const size_t rowbase = (size_t)bl * SEQ; const float l2g = log2gamma(h);
    const int rt0 = (int)(rowbase >> 5);
    const bf16_t* qp = qr + (((size_t)(rt0 + (tok0 >> 5)) * 64 + h * 16) * 2 + hh) * 256 + r * 8;
    f32x16 acc[8];
#pragma unroll
    for (int dt = 0; dt < 8; ++dt)
#pragma unroll
        for (int i = 0; i < 16; ++i) acc[dt][i] = 0.f;
    const bf16_t* rp = rsnap + (size_t)(bh * NRCH + n) * (512 * 256) + (size_t)(dh * 8 * 16) * 512 + hh * 256 + r * 8;
#pragma unroll 1
    for (int ks = 0; ks < 16; ++ks) {
        const bf16x8 bq = *(const bf16x8*)(qp + ks * 512);
#pragma unroll
        for (int dt = 0; dt < 8; ++dt) acc[dt] = MFMA32(*(const bf16x8*)(rp + (size_t)(dt * 16 + ks) * 512), bq, acc[dt]);
    }
    { const float xi = exp2f((float)((tq & (RCH - 1)) + 1) * l2g);
#pragma unroll
      for (int dt = 0; dt < 8; ++dt)
#pragma unroll
          for (int i = 0; i < 16; ++i) acc[dt][i] *= xi; }
    const bf16_t* vbase = vT + (((size_t)(h * 16 + dh * 8) * (TH / 16) + (rowbase >> 4)) * 2 + hh) * 256 + r * 8;
    for (int j = (n * RCH) >> 5; j <= (tok0 >> 5); ++j) {
        const bf16_t* kp = kn + (((size_t)(rt0 + j) * 64 + h * 16) * 2 + hh) * 256 + r * 8;
        f32x16 st;
#pragma unroll
        for (int i = 0; i < 16; ++i) st[i] = 0.f;
#pragma unroll 4
        for (int ks = 0; ks < 16; ++ks) st = MFMA32(*(const bf16x8*)(kp + ks * 512), *(const bf16x8*)(qp + ks * 512), st);
        float pw[16];
#pragma unroll
        for (int i = 0; i < 16; ++i) { const int d = tq - (j * 32 + crow(i, hh)); pw[i] = d >= 0 ? st[i] * __builtin_amdgcn_exp2f((float)d * l2g) : 0.f; }
#pragma unroll
        for (int s = 0; s < 2; ++s) {
            u32x4 bw; bw.x = pk2(pw[8 * s], pw[8 * s + 1]); bw.y = pk2(pw[8 * s + 2], pw[8 * s + 3]); bw.z = pk2(pw[8 * s + 4], pw[8 * s + 5]); bw.w = pk2(pw[8 * s + 6], pw[8 * s + 7]);
            const bf16x8 bp = __builtin_bit_cast(bf16x8, bw);
            const bf16_t* vp = vbase + (size_t)(2 * j + s) * 512;
#pragma unroll
            for (int dt = 0; dt < 8; ++dt) acc[dt] = MFMA32(*(const bf16x8*)(vp + (size_t)dt * (TH / 16) * 512), bp, acc[dt]);
        }
    }
    float s1 = 0.f, s2 = 0.f;
#pragma unroll
    for (int dt = 0; dt < 8; ++dt)
#pragma unroll
        for (int i = 0; i < 16; ++i) { const float v = acc[dt][i]; s1 += v; s2 += v * v; }
    s1 += __shfl_xor(s1, 32); s2 += __shfl_xor(s2, 32);
    if (hh == 0) { stats[(dh * 128 + tt * 32 + r) * 2] = s1; stats[(dh * 128 + tt * 32 + r) * 2 + 1] = s2; }
    __syncthreads();
    s1 += stats[((dh ^ 1) * 128 + tt * 32 + r) * 2]; s2 += stats[((dh ^ 1) * 128 + tt * 32 + r) * 2 + 1];
    const float mu = s1 * (1.0f / 512.0f), var = fmaxf(s2 * (1.0f / 512.0f) - mu * mu, 0.f), rstd = 1.0f / sqrtf(var + 1e-5f);
    bf16_t* op = yret + (rowbase + tq) * 2048 + h * 512 + dh * 256 + 4 * hh;
#pragma unroll
    for (int dt = 0; dt < 8; ++dt)
#pragma unroll
        for (int g = 0; g < 4; ++g) {
            u32x2* pp = (u32x2*)(op + dt * 32 + 8 * g); const u32x2 gv = *pp;
            u32x2 w; w.x = pk2(bflo(gv.x) * (acc[dt][4 * g] - mu) * rstd, bfhi(gv.x) * (acc[dt][4 * g + 1] - mu) * rstd);
            w.y = pk2(bflo(gv.y) * (acc[dt][4 * g + 2] - mu) * rstd, bfhi(gv.y) * (acc[dt][4 * g + 3] - mu) * rstd); *pp = w;
        }
    __syncthreads();
}

__global__ void __launch_bounds__(512, 2) hybrid_fwd(Params p) {
    extern __shared__ __attribute__((aligned(16))) unsigned char lds_raw[];
    cg::grid_group grid = cg::this_grid();
    PG8_LAS unsigned char* lds = (PG8_LAS unsigned char*)lds_raw;
    LAS float* ldsf = (LAS float*)lds_raw;
#if PROBE_CLASS >= 0
    unsigned long long tacc = 0, tst = 0;
#define TSTART() (tst = __builtin_amdgcn_s_memrealtime())
#define TSTOP(c) do { if ((c) == PROBE_CLASS) tacc += __builtin_amdgcn_s_memrealtime() - tst; } while (0)
#else
#define TSTART() ((void)0)
#define TSTOP(c) ((void)0)
#endif
#define GSYNC() do { TSTART(); grid.sync(); TSTOP(0); } while (0)
#define PH_BEGIN int tid = threadIdx.x; asm volatile("" : "+v"(tid)); int bx = blockIdx.x, G = gridDim.x; asm volatile("" : "+s"(bx), "+s"(G)); \
    unsigned char* ws = p.ws; asm volatile("" : "+s"(ws)); float* xo = p.out; asm volatile("" : "+s"(xo)); \
    const int lane = tid & 63, wave = __builtin_amdgcn_readfirstlane(tid >> 6), gw = bx * 8 + wave, ngw = G * 8; (void)lane; (void)wave; (void)gw; (void)ngw; \
    const float* modl = (const float*)(ws + WS_MOD) + (size_t)l * 4 * NMOD; (void)modl; bf16_t* H = (bf16_t*)(ws + WS_H); (void)H;
#pragma unroll 1
    for (int l = 0; l < 2; ++l) {
        TSTART(); { PH_BEGIN
          if (l == 0) { tables_and_mod(p, ldsf, tid); __syncthreads(); }
          convert_weights(p, l, ldsf, tid); } TSTOP(4);
        if (l == 0) GSYNC();
        TSTART(); { PH_BEGIN
          norm_phase(l == 0 ? p.x : xo, p.norm_mix_g + l * DM, modl, 0, 1, H, gw, ngw, lane); } TSTOP(5);
        GSYNC();
#pragma unroll 1
        for (int half = 0; half < 2; ++half) {
            TSTART(); { PH_BEGIN
              pg8::Gemm g{H + (size_t)half * TH * DM, (const bf16_t*)(ws + WS_WINA), TH, 6144, DM}; pg8::StaticOrder S; S.init(TH, 6144, G, bx);
              EpiInA E{(bf16_t*)(ws + WS_X), (bf16_t*)(ws + WS_YRET) + (size_t)half * TH * 2048, (const float*)(ws + WS_COSP), (const float*)(ws + WS_SINP)};
              pg8::gemm_phase<EpiInA, pg8::StaticOrder, true, true>(lds, g, S, E); } TSTOP(1);
            TSTART(); { PH_BEGIN
              pg8::Gemm g{(const bf16_t*)(ws + WS_WINB), H + (size_t)half * TH * DM, 4096, TH, DM}; pg8::StaticOrder S; S.init(4096, TH, G, bx);
              EpiInB E{(bf16_t*)(ws + WS_KZT), (const float*)(ws + WS_COST), (const float*)(ws + WS_SINT)};
              pg8::gemm_phase<EpiInB, pg8::StaticOrder, true, true>(lds, g, S, E); } TSTOP(1);
            GSYNC();
            TSTART(); { PH_BEGIN
              for (int s = gw; s < 2048; s += ngw) if (!(s & 1)) ret_state_item(s >> 1, (const bf16_t*)(ws + WS_KZT), (const bf16_t*)(ws + WS_VT), (bf16_t*)(ws + WS_RSNAP), lane); } TSTOP(2);
            TSTART(); { PH_BEGIN
              for (int it = gw; it < 4096; it += ngw) sb_item(it, (const bf16_t*)(ws + WS_SQ), (const bf16_t*)(ws + WS_SK), (const bf16_t*)(ws + WS_SVT), (bf16_t*)(ws + WS_YSB) + (size_t)half * TH * 1024, lane); } TSTOP(6);
            GSYNC();
            TSTART(); { PH_BEGIN
              for (int it = bx; it < 256; it += G) ret_out_item(it, (const bf16_t*)(ws + WS_QR), (const bf16_t*)(ws + WS_KN), (const bf16_t*)(ws + WS_VT), (const bf16_t*)(ws + WS_RSNAP), (bf16_t*)(ws + WS_YRET) + (size_t)half * TH * 2048, ldsf, wave, lane); } TSTOP(3);
            GSYNC();
        }
        TSTART(); { PH_BEGIN pg8::StaticOrder S; S.init(T, DM, G, bx);
          pg8::Gemm g{H, (const bf16_t*)(ws + WS_WG), T, DM, DM}; EpiEw<0> E{(bf16_t*)(ws + WS_MERGED), nullptr, DM}; pg8::gemm_phase<EpiEw<0>, pg8::StaticOrder, false, true>(lds, g, S, E); } TSTOP(7);
        TSTART(); { PH_BEGIN pg8::StaticOrder S; S.init(T, DM, G, bx);
          pg8::Gemm g{(const bf16_t*)(ws + WS_YRET), (const bf16_t*)(ws + WS_WRET), T, DM, 2048}; EpiEw<2> E{(bf16_t*)(ws + WS_MERGED), nullptr, DM}; pg8::gemm_phase<EpiEw<2>, pg8::StaticOrder, false, true>(lds, g, S, E); } TSTOP(7);
        TSTART(); { PH_BEGIN pg8::StaticOrder S; S.init(T, DM, G, bx);
          pg8::Gemm g{H, (const bf16_t*)(ws + WS_WG) + (size_t)1024 * 1024, T, DM, DM}; EpiEw<0> E{(bf16_t*)(ws + WS_TMP), nullptr, DM}; pg8::gemm_phase<EpiEw<0>, pg8::StaticOrder, false, true>(lds, g, S, E); } TSTOP(7);
        TSTART(); { PH_BEGIN pg8::StaticOrder S; S.init(T, DM, G, bx);
          pg8::Gemm g{(const bf16_t*)(ws + WS_YSB), (const bf16_t*)(ws + WS_WSB), T, DM, DM}; EpiEw<3> E{(bf16_t*)(ws + WS_MERGED), (const bf16_t*)(ws + WS_TMP), DM}; pg8::gemm_phase<EpiEw<3>, pg8::StaticOrder, false, true>(lds, g, S, E); } TSTOP(7);
        GSYNC();
        TSTART(); { PH_BEGIN pg8::StaticOrder S; S.init(T, DM, G, bx);
          pg8::Gemm g{(const bf16_t*)(ws + WS_MERGED), (const bf16_t*)(ws + WS_WMIX), T, DM, DM}; EpiRes E{l == 0 ? p.x : xo, xo, modl + 2 * 1024};
          pg8::gemm_phase<EpiRes, pg8::StaticOrder, false, true>(lds, g, S, E); } TSTOP(7);
        GSYNC();
        TSTART(); { PH_BEGIN
          norm_phase(xo, p.norm_mlp_g + l * DM, modl, 3, 4, H, gw, ngw, lane); } TSTOP(5);
        GSYNC();
        TSTART(); { PH_BEGIN pg8::StaticOrder S; S.init(T, FF, G, bx);
          pg8::Gemm g{H, (const bf16_t*)(ws + WS_WUP), T, FF, DM}; EpiEw<1> E{(bf16_t*)(ws + WS_U), nullptr, FF};
          pg8::gemm_phase<EpiEw<1>, pg8::StaticOrder, true, true>(lds, g, S, E); } TSTOP(8);
        GSYNC();
        TSTART(); { PH_BEGIN pg8::StaticOrder S; S.init(T, DM, G, bx);
          pg8::Gemm g{(const bf16_t*)(ws + WS_U), (const bf16_t*)(ws + WS_WDN), T, DM, FF}; EpiRes E{xo, xo, modl + 5 * 1024};
          pg8::gemm_phase<EpiRes, pg8::StaticOrder, false, true>(lds, g, S, E); } TSTOP(8);
        GSYNC();
    }
    TSTART(); { const int l = 0; PH_BEGIN
      final_norm_phase(xo, p.final_g, gw, ngw, lane); } TSTOP(5);
#if PROBE_CLASS >= 0
    grid.sync();
    if (blockIdx.x == 0) { const unsigned kk = (unsigned)(tacc * 4ull / 25ull);
        for (unsigned i = threadIdx.x; i < kk; i += 512) p.out[i] += 0.1f; }
#endif
#undef PH_BEGIN
}

extern "C" void kernel_launch(void* const* d_in, const int* in_sizes, int n_in, void* d_out, int out_size, void* d_ws, size_t ws_size, hipStream_t stream) {
    static int grid_blocks = 0;
    if (grid_blocks == 0) {
        if (n_in != 13 || out_size != T * DM || ws_size < WS_END) { fprintf(stderr, "kernel_launch: unexpected shapes (n_in %d out %d ws %zu need %zu)\n", n_in, out_size, ws_size, (size_t)WS_END); grid_blocks = -1; return; }
        int dev = 0, cus = 0, per_cu = 0;
        (void)hipGetDevice(&dev); (void)hipDeviceGetAttribute(&cus, hipDeviceAttributeMultiprocessorCount, dev);
        if (hipFuncSetAttribute((const void*)hybrid_fwd, hipFuncAttributeMaxDynamicSharedMemorySize, LDS_BYTES) != hipSuccess) { fprintf(stderr, "kernel_launch: hipFuncSetAttribute failed\n"); grid_blocks = -1; return; }
        if (hipOccupancyMaxActiveBlocksPerMultiprocessor(&per_cu, (const void*)hybrid_fwd, 512, LDS_BYTES) != hipSuccess || per_cu < 1) { fprintf(stderr, "kernel_launch: occupancy query gave %d\n", per_cu); per_cu = 1; (void)hipGetLastError(); }
        grid_blocks = cus * per_cu;
    }
    if (grid_blocks < 0) return;
    Params p{};
    p.x = (const float*)d_in[0]; p.c = (const float*)d_in[1]; p.norm_mix_g = (const float*)d_in[2]; p.w_in = (const float*)d_in[3]; p.w_ret_out = (const float*)d_in[4];
    p.w_sb_out = (const float*)d_in[5]; p.w_mix_out = (const float*)d_in[6]; p.norm_mlp_g = (const float*)d_in[7]; p.w_up = (const float*)d_in[8]; p.w_down = (const float*)d_in[9];
    p.w_ada = (const float*)d_in[10]; p.b_ada = (const float*)d_in[11]; p.final_g = (const float*)d_in[12];
    p.out = (float*)d_out; p.ws = (unsigned char*)d_ws;
    void* args[] = {&p};
    hipError_t e = hipLaunchCooperativeKernel((const void*)hybrid_fwd, dim3(grid_blocks), dim3(512), args, LDS_BYTES, stream);
    if (e != hipSuccess) fprintf(stderr, "kernel_launch: cooperative launch failed: %s (grid %d)\n", hipGetErrorString(e), grid_blocks);
}
```

```cpp
#include <hip/hip_runtime.h>
#include <hip/hip_cooperative_groups.h>
#include <cstdio>
#include <cstdint>
namespace cg = cooperative_groups;
#define DI __device__ __forceinline__
#define PROBE_CLASS -1
namespace pg8 {
#define PG8_LAS __attribute__((address_space(3)))
typedef unsigned short bf16_t;
typedef short bf16x8 __attribute__((ext_vector_type(8)));
typedef float f32x4 __attribute__((ext_vector_type(4)));
typedef unsigned u32x4 __attribute__((ext_vector_type(4)));
constexpr int BM = 256, BK = 64, HALF = 128, HTB = HALF * BK * 2  , STAGE_BYTES = 8 * HTB, NXCD = 8, WGM = 8;

__host__ __device__ __forceinline__ int lds_byte(int r, int c) { const int st = (r >> 4) * 2 + (c >> 5), rr = r & 15, cc = c & 31, ob = rr * 64 + cc * 2; return st * 1024 + (ob ^ (((ob >> 9) & 1) << 5)); }
__host__ __device__ __forceinline__ void stage_rc(int b, int& R, int& C) { const int st = b / 1024, sb = b % 1024, swz = sb ^ (((sb >> 9) & 1) << 5); R = (st >> 1) * 16 + swz / 64; C = (st & 1) * 32 + (swz % 64) / 2; }
__host__ __device__ __forceinline__ int perm32(int rho) { const int n = rho >> 4, i = rho & 15; return 8 * (i >> 2) + 4 * n + (i & 3); }

struct Unit { int pm, pn; };
struct Gemm { const bf16_t* A; const bf16_t* Bt; int M, N, K; };

struct StaticOrder {
    int nM, nN, nwg, G, c;
    __host__ __device__ void init(int M, int N, int G_, int c_) { nM = M / BM; nN = N / BM; nwg = nM * nN; G = G_; c = c_; }
    __host__ __device__ bool next(int i, Unit& u) const {
        const long L = (long)i * G + c; if (L >= nwg) return false;
        int wgid = (int)L; { const int q = nwg / NXCD, r = nwg % NXCD, xcd = wgid % NXCD, off = wgid / NXCD; wgid = (xcd < r ? xcd * (q + 1) : r * (q + 1) + (xcd - r) * q) + off; }
        const int nig = WGM * nN, gid = wgid / nig, fm = gid * WGM, gsz = (nM - fm) < WGM ? (nM - fm) : WGM;
        u.pm = fm + ((wgid % nig) % gsz); u.pn = (wgid % nig) / gsz; return true;
    }
    __device__ __forceinline__ void a_ready(const Unit&) const {}
    __device__ __forceinline__ void done(const Unit&) const {}
};

template <class Epi, class Sched, bool ALIGN_EPI = false, bool SP2 = false>
__device__ __forceinline__ void gemm_phase(PG8_LAS unsigned char* lds, const Gemm g, const Sched& S, const Epi& E) {
    int tid_l = threadIdx.x; asm volatile("" : "+v"(tid_l)); const int tid = tid_l, wid = __builtin_amdgcn_readfirstlane(tid >> 6), lane = tid & 63, wr = wid >> 2, wc = wid & 3, fr = lane & 15, fq = lane >> 4;
    const int K = g.K, nt = K / BK;
    unsigned voffA[2], voffB[2];
#pragma unroll
    for (int i = 0; i < 2; ++i) { int R, C; stage_rc(tid * 16 + i * 8192, R, C); const int Rb = Epi::PERM ? ((R & ~31) + perm32(R & 31)) : R;
        voffA[i] = (unsigned)(R * K + C) * 2u; voffB[i] = (unsigned)(Rb * K + C) * 2u; }
    const size_t kstep = (size_t)(BK * 2);
    const size_t hstep = (size_t)HALF * K * 2;
    const size_t tstep = 2 * hstep;
    const unsigned ldsw = (unsigned)wid * 1024u;
    const int aoff = lds_byte(wr * 64 + fr, fq * 8), boff = lds_byte(wc * 32 + fr, fq * 8);
#define PG8_SA(b, h) (((b) * 2 + (h)) * HTB)
#define PG8_SB(b, h) ((4 + (b) * 2 + (h)) * HTB)
#define PG8_STAGE(bufoff, gbase, voff) do { _Pragma("unroll") for (int _i = 0; _i < 2; ++_i) \
        __builtin_amdgcn_global_load_lds((const unsigned*)((const char*)(gbase) + (voff)[_i]), (PG8_LAS unsigned*)(lds + (bufoff) + ldsw + _i * 8192), 16, 0, 0); } while (0)
#define PG8_LDA(dst, b, h) do { _Pragma("unroll") for (int m = 0; m < 4; ++m) _Pragma("unroll") for (int k = 0; k < 2; ++k) dst[m][k] = *(const PG8_LAS bf16x8*)(lds + PG8_SA(b, h) + aoff + m * 2048 + k * 1024); } while (0)
#define PG8_LDB(dst, b, h) do { _Pragma("unroll") for (int n = 0; n < 2; ++n) _Pragma("unroll") for (int k = 0; k < 2; ++k) dst[n][k] = *(const PG8_LAS bf16x8*)(lds + PG8_SB(b, h) + boff + n * 2048 + k * 1024); } while (0)
#define PG8_MMA(ai, bj, At, Bt) do { __builtin_amdgcn_s_setprio(1); _Pragma("unroll") for (int m = 0; m < 4; ++m) _Pragma("unroll") for (int n = 0; n < 2; ++n) _Pragma("unroll") for (int k = 0; k < 2; ++k) \
        acc[ai][bj][m][n] = __builtin_amdgcn_mfma_f32_16x16x32_bf16(Bt[n][k], At[m][k], acc[ai][bj][m][n], 0, 0, 0); __builtin_amdgcn_s_setprio(0); } while (0)
#define PG8_WAIT_V(n) asm volatile("s_waitcnt vmcnt(" #n ")" ::: "memory")
#define PG8_WAIT_L(n) asm volatile("s_waitcnt lgkmcnt(" #n ")" ::: "memory")
#define PG8_BAR __builtin_amdgcn_s_barrier()
#define PG8_SCHED __builtin_amdgcn_sched_barrier(0)
    Unit cur, nxt; int ui = 0;
    if (!S.next(0, cur)) return;
    f32x4 acc[2][2][4][2];
#pragma unroll
    for (int a = 0; a < 2; ++a)
#pragma unroll
        for (int b = 0; b < 2; ++b)
#pragma unroll
            for (int m = 0; m < 4; ++m)
#pragma unroll
                for (int n = 0; n < 2; ++n) acc[a][b][m][n] = (f32x4){0.f, 0.f, 0.f, 0.f};
    bf16x8 At[4][2], B0[2][2], B1[2][2];
    const char* cA = (const char*)g.A + (size_t)cur.pm * tstep; const char* cB = (const char*)g.Bt + (size_t)cur.pn * tstep;
    S.a_ready(cur);
    if constexpr (SP2) {
        PG8_STAGE(PG8_SB(0, 0), cB, voffB); PG8_STAGE(PG8_SB(0, 1), cB + hstep, voffB); PG8_STAGE(PG8_SA(0, 0), cA, voffA); PG8_STAGE(PG8_SA(0, 1), cA + hstep, voffA);
        if (wr == 1) PG8_BAR;
        PG8_WAIT_V(2); PG8_BAR;
        PG8_STAGE(PG8_SB(1, 0), cB + kstep, voffB); PG8_STAGE(PG8_SA(1, 0), cA + kstep, voffA); PG8_STAGE(PG8_SB(1, 1), cB + hstep + kstep, voffB);
        PG8_WAIT_V(6); PG8_BAR;
    } else {
        PG8_STAGE(PG8_SB(0, 0), cB, voffB); PG8_STAGE(PG8_SA(0, 0), cA, voffA); PG8_STAGE(PG8_SB(0, 1), cB + hstep, voffB); PG8_STAGE(PG8_SA(0, 1), cA + hstep, voffA);
        if (wr == 1) PG8_BAR;
        PG8_WAIT_V(4); PG8_BAR;
        PG8_STAGE(PG8_SB(1, 0), cB + kstep, voffB); PG8_STAGE(PG8_SA(1, 0), cA + kstep, voffA); PG8_STAGE(PG8_SB(1, 1), cB + hstep + kstep, voffB);
        PG8_WAIT_V(6); PG8_BAR;
    }
    for (;;) {
        const bool has_next = S.next(ui + 1, nxt);
        const char* nA = has_next ? (const char*)g.A + (size_t)nxt.pm * tstep : cA; const char* nB = has_next ? (const char*)g.Bt + (size_t)nxt.pn * tstep : cB;
        for (int t = 0; t < nt; t += 2) {
            const bool last = (t == nt - 2);
            const char* a1 = cA + (size_t)(t + 1) * kstep;
            const char* a2 = last ? nA : cA + (size_t)(t + 2) * kstep; const char* b2 = last ? nB : cB + (size_t)(t + 2) * kstep;
            const char* a3 = a2 + kstep; const char* b3 = b2 + kstep;
            if (last && has_next) S.a_ready(nxt);
            if constexpr (SP2) {
            PG8_LDB(B0, 0, 0); PG8_LDB(B1, 0, 1); PG8_SCHED; PG8_LDA(At, 0, 0); PG8_STAGE(PG8_SA(1, 1), a1 + hstep, voffA);
            PG8_WAIT_V(8); PG8_WAIT_L(0); PG8_BAR; PG8_MMA(0, 0, At, B0); PG8_MMA(0, 1, At, B1); PG8_BAR; PG8_SCHED;
            PG8_LDA(At, 0, 1); PG8_STAGE(PG8_SB(0, 0), b2, voffB); PG8_STAGE(PG8_SB(0, 1), b2 + hstep, voffB); PG8_STAGE(PG8_SA(0, 0), a2, voffA);
            PG8_WAIT_V(8); PG8_WAIT_L(0); PG8_BAR; PG8_MMA(1, 0, At, B0); PG8_MMA(1, 1, At, B1); PG8_BAR; PG8_SCHED;
            PG8_LDB(B0, 1, 0); PG8_LDB(B1, 1, 1); PG8_SCHED; PG8_LDA(At, 1, 0); PG8_STAGE(PG8_SA(0, 1), a2 + hstep, voffA);
            PG8_WAIT_V(8); PG8_WAIT_L(0); PG8_BAR; PG8_MMA(0, 0, At, B0); PG8_MMA(0, 1, At, B1); PG8_BAR; PG8_SCHED;
            PG8_LDA(At, 1, 1); PG8_STAGE(PG8_SB(1, 0), b3, voffB); PG8_STAGE(PG8_SB(1, 1), b3 + hstep, voffB); PG8_STAGE(PG8_SA(1, 0), a3, voffA);
            PG8_WAIT_V(8); PG8_WAIT_L(0); PG8_BAR; PG8_MMA(1, 0, At, B0); PG8_MMA(1, 1, At, B1); PG8_BAR; PG8_SCHED;
            } else {
            PG8_LDB(B0, 0, 0); PG8_SCHED; PG8_LDA(At, 0, 0); PG8_STAGE(PG8_SA(1, 1), a1 + hstep, voffA);
            PG8_WAIT_L(8); PG8_BAR; PG8_WAIT_L(0); PG8_MMA(0, 0, At, B0); PG8_BAR; PG8_SCHED;
            PG8_LDB(B1, 0, 1); PG8_STAGE(PG8_SB(0, 0), b2, voffB);
            PG8_BAR; PG8_WAIT_L(0); PG8_MMA(0, 1, At, B1); PG8_BAR;
            PG8_LDA(At, 0, 1); PG8_STAGE(PG8_SA(0, 0), a2, voffA);
            PG8_BAR; PG8_WAIT_L(0); PG8_MMA(1, 0, At, B0); PG8_BAR; PG8_SCHED;
            PG8_STAGE(PG8_SB(0, 1), b2 + hstep, voffB);
            PG8_WAIT_V(6); PG8_BAR; PG8_MMA(1, 1, At, B1); PG8_BAR;
            PG8_LDB(B0, 1, 0); PG8_SCHED; PG8_LDA(At, 1, 0); PG8_STAGE(PG8_SA(0, 1), a2 + hstep, voffA);
            PG8_WAIT_L(8); PG8_BAR; PG8_WAIT_L(0); PG8_MMA(0, 0, At, B0); PG8_BAR; PG8_SCHED;
            PG8_LDB(B1, 1, 1); PG8_STAGE(PG8_SB(1, 0), b3, voffB);
            PG8_BAR; PG8_WAIT_L(0); PG8_MMA(0, 1, At, B1); PG8_BAR;
            PG8_LDA(At, 1, 1); PG8_STAGE(PG8_SA(1, 0), a3, voffA);
            PG8_BAR; PG8_WAIT_L(0); PG8_MMA(1, 0, At, B0); PG8_BAR; PG8_SCHED;
            PG8_STAGE(PG8_SB(1, 1), b3 + hstep, voffB);
            PG8_WAIT_V(6); PG8_BAR; PG8_MMA(1, 1, At, B1); PG8_BAR;
            }
        }
        if constexpr (ALIGN_EPI) { if (wr == 0) PG8_BAR; }
        if constexpr (!Epi::AFTER_DRAIN) { E(acc, cur, wr, wc, fr, fq); S.done(cur); }
        if (!has_next) break;
#pragma unroll
        for (int a = 0; a < 2; ++a)
#pragma unroll
            for (int b = 0; b < 2; ++b)
#pragma unroll
                for (int m = 0; m < 4; ++m)
#pragma unroll
                    for (int n = 0; n < 2; ++n) acc[a][b][m][n] = (f32x4){0.f, 0.f, 0.f, 0.f};
        cur = nxt; cA = nA; cB = nB; ++ui;
        if constexpr (ALIGN_EPI) { if (wr == 1) PG8_BAR; }
    }
    PG8_WAIT_V(0);
    if constexpr (!ALIGN_EPI) { if (wr == 0) PG8_BAR; }
    PG8_BAR;
    if constexpr (Epi::AFTER_DRAIN) { E.fused(acc, cur, wr, wc, fr, fq, lds, wid, lane); S.done(cur); }
#undef PG8_SA
#undef PG8_SB
#undef PG8_STAGE
#undef PG8_LDA
#undef PG8_LDB
#undef PG8_MMA
#undef PG8_WAIT_V
#undef PG8_WAIT_L
#undef PG8_BAR
#undef PG8_SCHED
}
}

using pg8::bf16_t; using pg8::bf16x8; using pg8::f32x4; using pg8::u32x4; using pg8::Unit;
typedef float f32x16 __attribute__((ext_vector_type(16)));
typedef float f32x2 __attribute__((ext_vector_type(2)));
typedef unsigned u32x2 __attribute__((ext_vector_type(2)));
typedef __bf16 bf16x2_t __attribute__((ext_vector_type(2)));
#define LAS __attribute__((address_space(3)))
#define MFMA32(a, b, c) __builtin_amdgcn_mfma_f32_32x32x16_bf16((a), (b), (c), 0, 0, 0)

constexpr int T = 16384, DM = 1024, SEQ = 4096, TH = 8192, FF = 4096, INW = 11264, NMOD = 6144;
constexpr int RCH = 512, NRCH = SEQ / RCH;
constexpr size_t MiB = 1u << 20;
constexpr size_t WS_BAR = 768 * 1024;
constexpr size_t WS_MOD = 0, WS_COSP = 1 * MiB, WS_SINP = 3 * MiB, WS_COST = 5 * MiB, WS_SINT = 7 * MiB, WS_H = 9 * MiB;
constexpr size_t WS_WINA = 41 * MiB, WS_WINB = 53 * MiB, WS_WG = 61 * MiB, WS_WRET = 65 * MiB, WS_WSB = 69 * MiB, WS_WMIX = 71 * MiB, WS_WUP = 73 * MiB, WS_WDN = 81 * MiB;
constexpr size_t WS_YRET = 89 * MiB, WS_YSB = 153 * MiB, WS_RSNAP = 185 * MiB, WS_X = 201 * MiB, WS_END = 329 * MiB;
constexpr size_t WS_QR = WS_X, WS_KN = WS_X + 16 * MiB, WS_SQ = WS_X + 32 * MiB, WS_SK = WS_X + 48 * MiB, WS_KZT = WS_X + 64 * MiB, WS_VT = WS_X + 80 * MiB, WS_SVT = WS_X + 112 * MiB;
static_assert(WS_KN == WS_QR + 16 * MiB && WS_SQ == WS_QR + 32 * MiB && WS_SK == WS_QR + 48 * MiB && WS_VT == WS_KZT + 16 * MiB && WS_SVT == WS_KZT + 48 * MiB, "epilogue pointer arithmetic");
constexpr size_t WS_MERGED = WS_X, WS_TMP = WS_X + 32 * MiB, WS_U = WS_X;
constexpr int LDS_BYTES = 135168;
constexpr float SB_STOP = -80.0f;

DI unsigned pk2(float lo, float hi) { f32x2 v = {lo, hi}; bf16x2_t b = __builtin_convertvector(v, bf16x2_t); return __builtin_bit_cast(unsigned, b); }
DI float bflo(unsigned w) { return __uint_as_float(w << 16); }
DI float bfhi(unsigned w) { return __uint_as_float(w & 0xffff0000u); }
DI u32x4 pack8(f32x4 a, f32x4 b) { u32x4 w; w.x = pk2(a[0], a[1]); w.y = pk2(a[2], a[3]); w.z = pk2(b[0], b[1]); w.w = pk2(b[2], b[3]); return w; }
DI void unpack8(u32x4 w, f32x4& a, f32x4& b) { a = (f32x4){bflo(w.x), bfhi(w.x), bflo(w.y), bfhi(w.y)}; b = (f32x4){bflo(w.z), bfhi(w.z), bflo(w.w), bfhi(w.w)}; }
DI float wave_sum(float v) {
#pragma unroll
    for (int o = 1; o < 64; o <<= 1) v += __shfl_xor(v, o);
    return v;
}
DI float log2gamma(int h) { return log2f(1.0f - exp2f(-5.0f - (float)h)); }
DI float sigmoidf_(float v) { return 1.0f / (1.0f + __expf(-v)); }
DI int crow(int reg, int hh) { return (reg & 3) + 8 * (reg >> 2) + 4 * hh; }
DI size_t nfrag(int row, int col, int C) { return ((((size_t)(row >> 5) * (C >> 4) + (col >> 4)) * 2 + ((col >> 3) & 1)) * 32 + (row & 31)) * 8 + (col & 7); }
DI size_t tfrag0(int ch, int tok0, int NTOK) { return ((((size_t)(ch >> 5) * (NTOK >> 4) + (tok0 >> 4)) * 2) * 32 + (ch & 31)) * 8 + 4 * ((tok0 >> 3) & 1); }
DI void st_tfrag(bf16_t* base, int ch, int tok0, int NTOK, f32x4 a, f32x4 b) {
    bf16_t* q = base + tfrag0(ch, tok0, NTOK); u32x2 w0, w1; w0.x = pk2(a[0], a[1]); w0.y = pk2(a[2], a[3]); w1.x = pk2(b[0], b[1]); w1.y = pk2(b[2], b[3]);
    *(u32x2*)q = w0; *(u32x2*)(q + 256) = w1; }


struct EpiInA {
    static constexpr bool PERM = true, AFTER_DRAIN = false;
    bf16_t *xb, *yret; const float *cosP, *sinP;
    DI void operator()(const f32x4 (&acc)[2][2][4][2], const Unit& u, int wr, int wc, int fr_, int fq) const {
        int fr = fr_; asm volatile("" : "+v"(fr));
        const int pn = u.pn, row0 = u.pm * 256 + wr * 64 + fr, cl = wc * 32 + 8 * fq;
        if (pn < 8) {
            bf16_t* dst = xb + (size_t)(pn >> 2) * (8u << 20); const int hc = (pn & 3) * 256 + cl;
            const float sc = pn < 4 ? 1.0f : 0.0625f;
#pragma unroll
            for (int ai = 0; ai < 2; ++ai)
#pragma unroll
                for (int m = 0; m < 4; ++m) {
                    const int row = row0 + ai * 128 + m * 16, pos = row & (SEQ - 1);
                    const f32x4* cp = (const f32x4*)(cosP + pos * 128 + cl); const f32x4* sp = (const f32x4*)(sinP + pos * 128 + cl);
                    f32x4 o1[2], o2[2];
#pragma unroll
                    for (int n = 0; n < 2; ++n) { const f32x4 c = cp[n], s = sp[n], t1 = acc[ai][0][m][n], t2 = acc[ai][1][m][n];
                        o1[n] = (t1 * c - t2 * s) * sc; o2[n] = (t1 * s + t2 * c) * sc; }
                    *(u32x4*)(dst + nfrag(row, hc, 1024)) = pack8(o1[0], o1[1]); *(u32x4*)(dst + nfrag(row, hc + 128, 1024)) = pack8(o2[0], o2[1]);
                    __builtin_amdgcn_sched_barrier(0);
                }
        } else {
            const int mode = pn < 16 ? 0 : (pn < 20 ? 1 : 2);
            const int hc = (pn < 16 ? (pn - 8) : (pn & 3)) * 256 + cl;
            bf16_t* dst = xb + (size_t)(mode + 1) * (8u << 20);
#pragma unroll
            for (int ai = 0; ai < 2; ++ai)
#pragma unroll
                for (int m = 0; m < 4; ++m) {
                    const int row = row0 + ai * 128 + m * 16;
#pragma unroll
                    for (int bj = 0; bj < 2; ++bj) {
                        f32x4 v0 = acc[ai][bj][m][0], v1 = acc[ai][bj][m][1];
                        if (mode == 0) {
#pragma unroll
                            for (int e = 0; e < 4; ++e) { v0[e] = v0[e] * sigmoidf_(v0[e]); v1[e] = v1[e] * sigmoidf_(v1[e]); }
                        } else if (mode == 1) { v0 = v0 * 0.125f; v1 = v1 * 0.125f; }
                        if (mode == 0) *(u32x4*)(yret + (size_t)row * 2048 + hc + bj * 128) = pack8(v0, v1);
                        else *(u32x4*)(dst + nfrag(row, hc + bj * 128, 1024)) = pack8(v0, v1);
                    }
                }
        }
    }
};

struct EpiInB {
    static constexpr bool PERM = true, AFTER_DRAIN = false;
    bf16_t *kzT; const float *cosT, *sinT;
    DI void operator()(const f32x4 (&acc)[2][2][4][2], const Unit& u, int wr, int wc, int fr_, int fq) const {
        int fr = fr_; asm volatile("" : "+v"(fr));
        const int pm = u.pm, tok0 = u.pn * 256 + wc * 32 + 8 * fq;
        if (pm < 4) {
            const float l2g = log2gamma(pm), ginv = __builtin_amdgcn_exp2f(-l2g);
#pragma unroll
            for (int m = 0; m < 4; ++m) {
                const int i = wr * 64 + m * 16 + fr;
#pragma unroll
                for (int bj = 0; bj < 2; ++bj) {
                    const int tok = tok0 + bj * 128, pos = tok & (SEQ - 1);
                    const f32x4* cp = (const f32x4*)(cosT + i * SEQ + pos); const f32x4* sp = (const f32x4*)(sinT + i * SEQ + pos);
                    f32x4 o1[2], o2[2];
                    float zr = __builtin_amdgcn_exp2f((float)((RCH - 1) - (pos & (RCH - 1))) * l2g) * 0.0625f;
#pragma unroll
                    for (int n = 0; n < 2; ++n) { const f32x4 c = cp[n], s = sp[n], t1 = acc[0][bj][m][n], t2 = acc[1][bj][m][n];
                        f32x4 z;
#pragma unroll
                        for (int e = 0; e < 4; ++e) { z[e] = zr; zr *= ginv; }
                        o1[n] = (t1 * c - t2 * s) * z; o2[n] = (t1 * s + t2 * c) * z; }
                    st_tfrag(kzT, pm * 256 + i, tok, TH, o1[0], o1[1]);
                    st_tfrag(kzT, pm * 256 + 128 + i, tok, TH, o2[0], o2[1]);
                    __builtin_amdgcn_sched_barrier(0);
                }
            }
        } else {
            bf16_t* dst = kzT + (size_t)(pm < 12 ? 8u << 20 : 24u << 20); const int ch0 = (pm < 12 ? (pm - 4) : (pm - 12)) * 256 + wr * 64 + fr;
#pragma unroll
            for (int ai = 0; ai < 2; ++ai)
#pragma unroll
                for (int m = 0; m < 4; ++m)
#pragma unroll
                    for (int bj = 0; bj < 2; ++bj)
                        st_tfrag(dst, ch0 + ai * 128 + m * 16, tok0 + bj * 128, TH, acc[ai][bj][m][0], acc[ai][bj][m][1]);
        }
    }
};

template <int MODE> struct EpiEw {
    static constexpr bool PERM = true, AFTER_DRAIN = false;
    bf16_t* O; const bf16_t* P; int ld;
    DI void operator()(const f32x4 (&acc)[2][2][4][2], const Unit& u, int wr, int wc, int fr_, int fq) const {
        int fr = fr_; asm volatile("" : "+v"(fr));
        const int row0 = u.pm * 256 + wr * 64 + fr, col0 = u.pn * 256 + wc * 32 + 8 * fq;
#pragma unroll
        for (int ai = 0; ai < 2; ++ai)
#pragma unroll
            for (int m = 0; m < 4; ++m)
#pragma unroll
                for (int bj = 0; bj < 2; ++bj) {
                    const size_t off = (size_t)(row0 + ai * 128 + m * 16) * ld + col0 + bj * 128;
                    f32x4 v0 = acc[ai][bj][m][0], v1 = acc[ai][bj][m][1];
                    if (MODE == 0) {
#pragma unroll
                        for (int e = 0; e < 4; ++e) { v0[e] = sigmoidf_(v0[e]); v1[e] = sigmoidf_(v1[e]); }
                    } else if (MODE == 1) {
#pragma unroll
                        for (int e = 0; e < 4; ++e) { const float a = fmaxf(v0[e], 0.f), b = fmaxf(v1[e], 0.f); v0[e] = a * a; v1[e] = b * b; }
                    } else if (MODE == 2) {
                        f32x4 a, b; unpack8(*(const u32x4*)(O + off), a, b); v0 = v0 * a; v1 = v1 * b;
                    } else {
                        f32x4 a, b, c, d; unpack8(*(const u32x4*)(O + off), a, b); unpack8(*(const u32x4*)(P + off), c, d); v0 = a + c * v0; v1 = b + d * v1;
                    }
                    *(u32x4*)(O + off) = pack8(v0, v1);
                }
    }
};

struct EpiRes {
    static constexpr bool PERM = true, AFTER_DRAIN = false;
    const float* xin; float* xout; const float* gate;
    DI void operator()(const f32x4 (&acc)[2][2][4][2], const Unit& u, int wr, int wc, int fr_, int fq) const {
        int fr = fr_; asm volatile("" : "+v"(fr));
        const int row0 = u.pm * 256 + wr * 64 + fr, col0 = u.pn * 256 + wc * 32 + 8 * fq;
#pragma unroll
        for (int ai = 0; ai < 2; ++ai)
#pragma unroll
            for (int m = 0; m < 4; ++m) {
                const int row = row0 + ai * 128 + m * 16; const float* gp = gate + (row >> 12) * NMOD;
#pragma unroll
                for (int bj = 0; bj < 2; ++bj) {
                    const int col = col0 + bj * 128; const size_t off = (size_t)row * DM + col;
                    const f32x4 g0 = *(const f32x4*)(gp + col), g1 = *(const f32x4*)(gp + col + 4);
                    const f32x4 x0 = *(const f32x4*)(xin + off), x1 = *(const f32x4*)(xin + off + 4);
                    *(f32x4*)(xout + off) = x0 + g0 * acc[ai][bj][m][0]; *(f32x4*)(xout + off + 4) = x1 + g1 * acc[ai][bj][m][1];
                }
            }
    }
};

DI void cvt_tile(const float* src, int ldsrc, int k0, int n0, bf16_t* dst1, bf16_t* dst2, int K, LAS float* tile, int tid) {
    const int kr = tid >> 4, nc = (tid & 15) * 4;
#pragma unroll
    for (int p = 0; p < 2; ++p) { const int k = kr + 32 * p; const f32x4 v = *(const f32x4*)(src + (size_t)(k0 + k) * ldsrc + n0 + nc);
        tile[k * 65 + nc] = v[0]; tile[k * 65 + nc + 1] = v[1]; tile[k * 65 + nc + 2] = v[2]; tile[k * 65 + nc + 3] = v[3]; }
    __syncthreads();
    const int n = tid >> 3, ks = (tid & 7) * 8; const LAS float* s = tile + ks * 65 + n;
    u32x4 o; o.x = pk2(s[0], s[65]); o.y = pk2(s[2 * 65], s[3 * 65]); o.z = pk2(s[4 * 65], s[5 * 65]); o.w = pk2(s[6 * 65], s[7 * 65]);
    *(u32x4*)(dst1 + (size_t)n * K + k0 + ks) = o;
    if (dst2) *(u32x4*)(dst2 + (size_t)n * K + k0 + ks) = o;
    __syncthreads();
}

struct Params {
    const float *x, *c, *norm_mix_g, *w_in, *w_ret_out, *w_sb_out, *w_mix_out, *norm_mlp_g, *w_up, *w_down, *w_ada, *b_ada, *final_g;
    float* out; unsigned char* ws;
};

DI void convert_weights(const Params& p, int l, LAS float* tile, int tid) {
    unsigned char* ws = p.ws;
    bf16_t* WinA = (bf16_t*)(ws + WS_WINA); bf16_t* WinB = (bf16_t*)(ws + WS_WINB); bf16_t* Wg = (bf16_t*)(ws + WS_WG);
    constexpr int I_IN = 16 * 176, I_RET = 32 * 16, I_SB = 16 * 16, I_MIX = 16 * 16, I_UP = 16 * 64, I_DN = 64 * 16;
    constexpr int NIT = I_IN + I_RET + I_SB + I_MIX + I_UP + I_DN;
    for (int it = blockIdx.x; it < NIT; it += gridDim.x) {
        int r = it;
        if (r < I_IN) {
            const int kb = r / 176, nb = r % 176, n0 = nb * 64; bf16_t* d1; bf16_t* d2 = nullptr;
            if (n0 < 1024) d1 = WinA + (size_t)n0 * 1024;
            else if (n0 < 2048) { d1 = WinA + (size_t)n0 * 1024; d2 = WinB + (size_t)(n0 - 1024) * 1024; }
            else if (n0 < 4096) d1 = WinB + (size_t)(n0 - 1024) * 1024;
            else if (n0 < 8192) d1 = WinA + (size_t)(n0 - 2048) * 1024;
            else if (n0 < 9216) d1 = WinB + (size_t)(n0 - 5120) * 1024;
            else d1 = Wg + (size_t)(n0 - 9216) * 1024;
            cvt_tile(p.w_in + (size_t)l * DM * INW, INW, kb * 64, n0, d1, d2, 1024, tile, tid); continue;
        }
        r -= I_IN;
        if (r < I_RET) { const int kb = r / 16, nb = r % 16; cvt_tile(p.w_ret_out + (size_t)l * 2048 * 1024, 1024, kb * 64, nb * 64, (bf16_t*)(ws + WS_WRET) + (size_t)nb * 64 * 2048, nullptr, 2048, tile, tid); continue; }
        r -= I_RET;
        if (r < I_SB) { const int kb = r / 16, nb = r % 16; cvt_tile(p.w_sb_out + (size_t)l * 1024 * 1024, 1024, kb * 64, nb * 64, (bf16_t*)(ws + WS_WSB) + (size_t)nb * 64 * 1024, nullptr, 1024, tile, tid); continue; }
        r -= I_SB;
        if (r < I_MIX) { const int kb = r / 16, nb = r % 16; cvt_tile(p.w_mix_out + (size_t)l * 1024 * 1024, 1024, kb * 64, nb * 64, (bf16_t*)(ws + WS_WMIX) + (size_t)nb * 64 * 1024, nullptr, 1024, tile, tid); continue; }
        r -= I_MIX;
        if (r < I_UP) { const int kb = r / 64, nb = r % 64; cvt_tile(p.w_up + (size_t)l * 1024 * 4096, 4096, kb * 64, nb * 64, (bf16_t*)(ws + WS_WUP) + (size_t)nb * 64 * 1024, nullptr, 1024, tile, tid); continue; }
        r -= I_UP;
        { const int kb = r / 16, nb = r % 16; cvt_tile(p.w_down + (size_t)l * 4096 * 1024, 1024, kb * 64, nb * 64, (bf16_t*)(ws + WS_WDN) + (size_t)nb * 64 * 4096, nullptr, 4096, tile, tid); }
    }
}

DI void tables_and_mod(const Params& p, LAS float* lds, int tid) {
    float* cosP = (float*)(p.ws + WS_COSP); float* sinP = (float*)(p.ws + WS_SINP); float* cosT = (float*)(p.ws + WS_COST); float* sinT = (float*)(p.ws + WS_SINT);
    for (int idx = blockIdx.x * 512 + tid; idx < SEQ * 128; idx += gridDim.x * 512) {
        const int pos = idx >> 7, i = idx & 127;
        const float inv = powf(10000.0f, -(float)i / 128.0f); const float ang = (float)pos * inv;
        const float c = cosf(ang), s = sinf(ang);
        cosP[idx] = c; sinP[idx] = s; cosT[i * SEQ + pos] = c; sinT[i * SEQ + pos] = s;
    }
    float* mod = (float*)(p.ws + WS_MOD);
    LAS float* cact = lds; LAS float* red = lds + 4096;
    const int wave = tid >> 6, lane = tid & 63;
    bool have = false;
    for (int it = blockIdx.x; it < 2 * 96; it += gridDim.x) {
        if (!have) { for (int e = tid; e < 4096; e += 512) { const float v = p.c[e]; cact[e] = v * sigmoidf_(v); } have = true; __syncthreads(); }
        const int l = it / 96, c0 = (it % 96) * 64;
        const float* w = p.w_ada + (size_t)l * DM * NMOD + c0 + lane;
        float a0 = 0.f, a1 = 0.f, a2 = 0.f, a3 = 0.f;
#pragma unroll 8
        for (int k = wave * 128; k < wave * 128 + 128; ++k) { const float wv = w[(size_t)k * NMOD]; a0 += cact[k] * wv; a1 += cact[1024 + k] * wv; a2 += cact[2048 + k] * wv; a3 += cact[3072 + k] * wv; }
        red[(wave * 4 + 0) * 64 + lane] = a0; red[(wave * 4 + 1) * 64 + lane] = a1; red[(wave * 4 + 2) * 64 + lane] = a2; red[(wave * 4 + 3) * 64 + lane] = a3;
        __syncthreads();
        if (tid < 256) { const int b = tid >> 6; float s = p.b_ada[l * NMOD + c0 + lane];
#pragma unroll
            for (int w8 = 0; w8 < 8; ++w8) s += red[(w8 * 4 + b) * 64 + lane];
            mod[(size_t)(l * 4 + b) * NMOD + c0 + lane] = s; }
        __syncthreads();
    }
}

DI void norm_phase(const float* xin, const float* g, const float* modl, int shift_i, int scale_i, bf16_t* hout, int gw, int ngw, int lane) {
    for (int row = gw; row < T; row += ngw) {
        const f32x4* xr = (const f32x4*)(xin + (size_t)row * DM) + lane;
        f32x4 v[4]; float s = 0.f;
#pragma unroll
        for (int j = 0; j < 4; ++j) { v[j] = xr[64 * j]; s += (v[j][0] * v[j][0] + v[j][1] * v[j][1]) + (v[j][2] * v[j][2] + v[j][3] * v[j][3]); }
        const float rstd = 1.0f / sqrtf(wave_sum(s) * (1.0f / DM) + 1e-6f);
        const float* mb = modl + (row >> 12) * NMOD;
        u32x2* o8 = (u32x2*)(hout + (size_t)row * DM) + lane;
#pragma unroll
        for (int j = 0; j < 4; ++j) { const int col = 4 * (lane + 64 * j);
            const f32x4 gg = *(const f32x4*)(g + col), sc = *(const f32x4*)(mb + scale_i * 1024 + col), sh = *(const f32x4*)(mb + shift_i * 1024 + col);
            const f32x4 y = v[j] * rstd * gg * (sc + 1.0f) + sh;
            u32x2 w; w.x = pk2(y[0], y[1]); w.y = pk2(y[2], y[3]); o8[64 * j] = w; }
    }
}
DI void final_norm_phase(float* x, const float* g, int gw, int ngw, int lane) {
    for (int row = gw; row < T; row += ngw) {
        f32x4* xr = (f32x4*)(x + (size_t)row * DM) + lane;
        f32x4 v[4]; float s = 0.f;
#pragma unroll
        for (int j = 0; j < 4; ++j) { v[j] = xr[64 * j]; s += (v[j][0] * v[j][0] + v[j][1] * v[j][1]) + (v[j][2] * v[j][2] + v[j][3] * v[j][3]); }
        const float rstd = 1.0f / sqrtf(wave_sum(s) * (1.0f / DM) + 1e-6f);
#pragma unroll
        for (int j = 0; j < 4; ++j) { const f32x4 gg = *(const f32x4*)(g + 4 * (lane + 64 * j)); xr[64 * j] = v[j] * rstd * gg; }
    }
}

DI void ret_state_item(int item, const bf16_t* kzT, const bf16_t* vT, bf16_t* rsnap, int lane) {
    const int dvt = item & 15, dkt = (item >> 4) & 7, bh = item >> 7, bl = bh >> 2, h = bh & 3, r = lane & 31, hh = lane >> 5;
    const bf16_t* ap = kzT + (((size_t)(h * 8 + dkt) * (TH / 16) + bl * (SEQ / 16)) * 2 + hh) * 256 + r * 8;
    const bf16_t* bp = vT + (((size_t)(h * 16 + dvt) * (TH / 16) + bl * (SEQ / 16)) * 2 + hh) * 256 + r * 8;
    const float dec = exp2f((float)RCH * log2gamma(h));
    f32x16 acc;
#pragma unroll
    for (int i = 0; i < 16; ++i) acc[i] = 0.f;
    for (int n = 0; n < NRCH; ++n) {
        bf16_t* sp = rsnap + (size_t)(bh * NRCH + n) * (512 * 256) + (size_t)(dvt * 16 + 2 * dkt) * 512 + r * 8 + 4 * hh;
#pragma unroll
        for (int g = 0; g < 4; ++g) { u32x2 w; w.x = pk2(acc[4 * g], acc[4 * g + 1]); w.y = pk2(acc[4 * g + 2], acc[4 * g + 3]); *(u32x2*)(sp + (g >> 1) * 512 + (g & 1) * 256) = w; }
        if (n == NRCH - 1) break;
#pragma unroll
        for (int i = 0; i < 16; ++i) acc[i] *= dec;
        const bf16_t* a = ap + (size_t)n * (RCH / 16) * 512; const bf16_t* b = bp + (size_t)n * (RCH / 16) * 512;
#pragma unroll 8
        for (int ks = 0; ks < RCH / 16; ++ks) acc = MFMA32(*(const bf16x8*)(a + ks * 512), *(const bf16x8*)(b + ks * 512), acc);
    }
}

DI void sb_item(int item, const bf16_t* sq, const bf16_t* sk, const bf16_t* svT, bf16_t* ysb, int lane) {
    const int qt = 127 - (item & 127), h = (item >> 7) & 15, bl = item >> 11, r = lane & 31, hh = lane >> 5;
    const size_t rowbase = (size_t)bl * SEQ; const int tq = qt * 32 + r;
    const int rt0 = (int)(rowbase >> 5);
    const bf16_t* qp = sq + (((size_t)(rt0 + qt) * 64 + h * 4) * 2 + hh) * 256 + r * 8;
    bf16x8 qf[4];
#pragma unroll
    for (int ks = 0; ks < 4; ++ks) qf[ks] = *(const bf16x8*)(qp + ks * 512);
    f32x16 o0, o1;
#pragma unroll
    for (int i = 0; i < 16; ++i) { o0[i] = 0.f; o1[i] = 0.f; }
    float carry = 0.f;
    for (int j = qt; j >= 0; --j) {
        const bf16_t* kp = sk + (((size_t)(rt0 + j) * 64 + h * 4) * 2 + hh) * 256 + r * 8;
        f32x16 st;
#pragma unroll
        for (int i = 0; i < 16; ++i) st[i] = 0.f;
#pragma unroll
        for (int ks = 0; ks < 4; ++ks) st = MFMA32(*(const bf16x8*)(kp + ks * 512), qf[ks], st);
        float lp[16], aw[16], gs[4], pg[4];
#pragma unroll
        for (int i = 0; i < 16; ++i) { const int key = j * 32 + crow(i, hh); const float z = st[i];
            const float spv = fmaxf(z, 0.f) + __logf(1.0f + __expf(-fabsf(z)));
            lp[i] = key < tq ? -spv : 0.f; }
#pragma unroll
        for (int g = 0; g < 4; ++g) { gs[g] = (lp[4 * g] + lp[4 * g + 1]) + (lp[4 * g + 2] + lp[4 * g + 3]); pg[g] = __shfl_xor(gs[g], 32); }
        float after = carry;
#pragma unroll
        for (int g = 3; g >= 0; --g) {
            float run = after + (hh == 0 ? pg[g] : 0.f);
#pragma unroll
            for (int e = 3; e >= 0; --e) { const int i = 4 * g + e; const int key = j * 32 + crow(i, hh);
                aw[i] = key < tq ? __expf(st[i] + lp[i] + run) : 0.f; run += lp[i]; }
            after += gs[g] + pg[g];
        }
        carry = after;
#pragma unroll
        for (int s = 0; s < 2; ++s) {
            u32x4 bw; bw.x = pk2(aw[8 * s], aw[8 * s + 1]); bw.y = pk2(aw[8 * s + 2], aw[8 * s + 3]); bw.z = pk2(aw[8 * s + 4], aw[8 * s + 5]); bw.w = pk2(aw[8 * s + 6], aw[8 * s + 7]);
            const bf16x8 bp = __builtin_bit_cast(bf16x8, bw);
            const bf16_t* vp = svT + (((size_t)(h * 2) * (TH / 16) + (rowbase >> 4) + 2 * j + s) * 2 + hh) * 256 + r * 8;
            o0 = MFMA32(*(const bf16x8*)vp, bp, o0);
            o1 = MFMA32(*(const bf16x8*)(vp + (size_t)(TH / 16) * 512), bp, o1);
        }
        if (__all(carry < SB_STOP)) break;
    }
    bf16_t* op = ysb + (rowbase + tq) * 1024 + h * 64 + 4 * hh;
#pragma unroll
    for (int g = 0; g < 4; ++g) {
        u32x2 w; w.x = pk2(o0[4 * g], o0[4 * g + 1]); w.y = pk2(o0[4 * g + 2], o0[4 * g + 3]); *(u32x2*)(op + 8 * g) = w;
        u32x2 w1; w1.x = pk2(o1[4 * g], o1[4 * g + 1]); w1.y = pk2(o1[4 * g + 2], o1[4 * g + 3]); *(u32x2*)(op + 32 + 8 * g) = w1;
    }
}

DI void ret_out_item(int item, const bf16_t* qr, const bf16_t* kn, const bf16_t* vT, const bf16_t* rsnap, bf16_t* yret, LAS float* stats, int wave, int lane) {
    const int bh = item >> 5, tg = 31 - (item & 31), bl = bh >> 2, h = bh & 3, tt = wave & 3, dh = wave >> 2, r = lane & 31, hh = lane >> 5;
    const int tok0 = tg * 128 + tt * 32, n = tok0 / RCH, tq = tok0 + r;
    const size_t rowbase = (size_t)bl * SEQ; const float l2g = log2gamma(h);
    const int rt0 = (int)(rowbase >> 5);
    const bf16_t* qp = qr + (((size_t)(rt0 + (tok0 >> 5)) * 64 + h * 16) * 2 + hh) * 256 + r * 8;
    f32x16 acc[8];
#pragma unroll
    for (int dt = 0; dt < 8; ++dt)
#pragma unroll
        for (int i = 0; i < 16; ++i) acc[dt][i] = 0.f;
    const bf16_t* rp = rsnap + (size_t)(bh * NRCH + n) * (512 * 256) + (size_t)(dh * 8 * 16) * 512 + hh * 256 + r * 8;
#pragma unroll 1
    for (int ks = 0; ks < 16; ++ks) {
        const bf16x8 bq = *(const bf16x8*)(qp + ks * 512);
#pragma unroll
        for (int dt = 0; dt < 8; ++dt) acc[dt] = MFMA32(*(const bf16x8*)(rp + (size_t)(dt * 16 + ks) * 512), bq, acc[dt]);
    }
    { const float xi = exp2f((float)((tq & (RCH - 1)) + 1) * l2g);
#pragma unroll
      for (int dt = 0; dt < 8; ++dt)
#pragma unroll
          for (int i = 0; i < 16; ++i) acc[dt][i] *= xi; }
    const bf16_t* vbase = vT + (((size_t)(h * 16 + dh * 8) * (TH / 16) + (rowbase >> 4)) * 2 + hh) * 256 + r * 8;
    for (int j = (n * RCH) >> 5; j <= (tok0 >> 5); ++j) {
        const bf16_t* kp = kn + (((size_t)(rt0 + j) * 64 + h * 16) * 2 + hh) * 256 + r * 8;
        f32x16 st;
#pragma unroll
        for (int i = 0; i < 16; ++i) st[i] = 0.f;
#pragma unroll 4
        for (int ks = 0; ks < 16; ++ks) st = MFMA32(*(const bf16x8*)(kp + ks * 512), *(const bf16x8*)(qp + ks * 512), st);
        float pw[16];
#pragma unroll
        for (int i = 0; i < 16; ++i) { const int d = tq - (j * 32 + crow(i, hh)); pw[i] = d >= 0 ? st[i] * __builtin_amdgcn_exp2f((float)d * l2g) : 0.f; }
#pragma unroll
        for (int s = 0; s < 2; ++s) {
            u32x4 bw; bw.x = pk2(pw[8 * s], pw[8 * s + 1]); bw.y = pk2(pw[8 * s + 2], pw[8 * s + 3]); bw.z = pk2(pw[8 * s + 4], pw[8 * s + 5]); bw.w = pk2(pw[8 * s + 6], pw[8 * s + 7]);
            const bf16x8 bp = __builtin_bit_cast(bf16x8, bw);
            const bf16_t* vp = vbase + (size_t)(2 * j + s) * 512;
#pragma unroll
            for (int dt = 0; dt < 8; ++dt) acc[dt] = MFMA32(*(const bf16x8*)(vp + (size_t)dt * (TH / 16) * 512), bp, acc[dt]);
        }
    }
    float s1 = 0.f, s2 = 0.f;
#pragma unroll
    for (int dt = 0; dt < 8; ++dt)
#pragma unroll
        for (int i = 0; i < 16; ++i) { const float v = acc[dt][i]; s1 += v; s2 += v * v; }
    s1 += __shfl_xor(s1, 32); s2 += __shfl_xor(s2, 32);
    if (hh == 0) { stats[(dh * 128 + tt * 32 + r) * 2] = s1; stats[(dh * 128 + tt * 32 + r) * 2 + 1] = s2; }
    __syncthreads();
    s1 += stats[((dh ^ 1) * 128 + tt * 32 + r) * 2]; s2 += stats[((dh ^ 1) * 128 + tt * 32 + r) * 2 + 1];
    const float mu = s1 * (1.0f / 512.0f), var = fmaxf(s2 * (1.0f / 512.0f) - mu * mu, 0.f), rstd = 1.0f / sqrtf(var + 1e-5f);
    bf16_t* op = yret + (rowbase + tq) * 2048 + h * 512 + dh * 256 + 4 * hh;
#pragma unroll
    for (int dt = 0; dt < 8; ++dt)
#pragma unroll
        for (int g = 0; g < 4; ++g) {
            u32x2* pp = (u32x2*)(op + dt * 32 + 8 * g); const u32x2 gv = *pp;
            u32x2 w; w.x = pk2(bflo(gv.x) * (acc[dt][4 * g] - mu) * rstd, bfhi(gv.x) * (acc[dt][4 * g + 1] - mu) * rstd);
            w.y = pk2(bflo(gv.y) * (acc[dt][4 * g + 2] - mu) * rstd, bfhi(gv.y) * (acc[dt][4 * g + 3] - mu) * rstd); *pp = w;
        }
    __syncthreads();
}

#define XB_TMO      128
#define XB_XCNT(j)  (256  + 64 * (j))
#define XB_XSUB(j)  (1280 + 64 * (j))
#define XB_XGEN(j)  (2304 + 64 * (j))
#define XB_TOP      3328
#define XB_TOPGEN   3392
#define XCD_BAR_WORDS 3456
#define XB_SPIN_CAP (1u << 18)

__device__ __forceinline__ unsigned xb_ld(unsigned* p)              { return __hip_atomic_load(p, __ATOMIC_RELAXED, __HIP_MEMORY_SCOPE_AGENT); }
__device__ __forceinline__ unsigned xb_add(unsigned* p, unsigned v) { return __hip_atomic_fetch_add(p, v, __ATOMIC_RELAXED, __HIP_MEMORY_SCOPE_AGENT); }
__device__ __forceinline__ unsigned xb_xcc_id() { return (unsigned)__builtin_amdgcn_s_getreg((3 << 11) | 20) & 0xFu; }
#define XB_SPIN(cond, bar) do { unsigned _sp = 0; while (cond) { __builtin_amdgcn_s_sleep(1); \
    if ((++_sp & 255u) == 0u) { if (xb_ld(&(bar)[XB_TMO])) break; if (_sp > XB_SPIN_CAP) { atomicAdd(&(bar)[XB_TMO], 1u); break; } } } } while (0)

struct XcdBarrier {
    unsigned* bar; unsigned x;
    volatile LAS unsigned* st;
};

__device__ __forceinline__ XcdBarrier xcd_barrier_post(unsigned* bar, volatile LAS unsigned* st) {
    XcdBarrier b; b.bar = bar; b.x = xb_xcc_id(); b.st = st;
    if (threadIdx.x == 0) (void)xb_add(&bar[XB_XCNT(b.x)], 1u);
    return b;
}
__device__ __forceinline__ void xcd_barrier_complete(unsigned* bar, unsigned x, unsigned& nloc, unsigned& nx) {
    const unsigned G = gridDim.x * gridDim.y * gridDim.z;
    unsigned sum, cnt, mine, sp = 0u;
    for (;;) {
        sum = 0u; cnt = 0u; mine = 0u;
#pragma unroll
        for (unsigned j = 0; j < 16; ++j) { const unsigned c = xb_ld(&bar[XB_XCNT(j)]); sum += c; cnt += (c > 0u) ? 1u : 0u; mine = (j == x) ? c : mine; }
        if (sum == G) break;
        __builtin_amdgcn_s_sleep(1);
        if ((++sp & 255u) == 0u) { if (xb_ld(&bar[XB_TMO])) break; if (sp > XB_SPIN_CAP) { atomicAdd(&bar[XB_TMO], 1u); break; } }
    }
    nloc = mine > 0u ? mine : 1u; nx = cnt > 0u ? cnt : 1u;
}

__device__ __forceinline__ void xcd_barrier(const XcdBarrier& b) {
    asm volatile("s_waitcnt vmcnt(0)" ::: "memory");
    __syncthreads();
    if (threadIdx.x == 0) {
        unsigned* bar = b.bar;
        __builtin_amdgcn_s_waitcnt(0);
        unsigned nloc = b.st[0], nx = b.st[1];
        if (nloc == 0u) { xcd_barrier_complete(bar, b.x, nloc, nx); b.st[0] = nloc; b.st[1] = nx; }
        const unsigned old = xb_add(&bar[XB_XSUB(b.x)], 1u);
        const unsigned gen = old / nloc;
        if (old + 1u == (gen + 1u) * nloc) {
            __builtin_amdgcn_fence(__ATOMIC_RELEASE, "agent");
            asm volatile("s_waitcnt vmcnt(0)" ::: "memory");
            const unsigned og = xb_add(&bar[XB_TOP], 1u);
            const unsigned tg = og / nx;
            if (og + 1u == (tg + 1u) * nx) xb_add(&bar[XB_TOPGEN], 1u);
            else XB_SPIN(xb_ld(&bar[XB_TOPGEN]) == tg, bar);
            __builtin_amdgcn_fence(__ATOMIC_ACQUIRE, "agent");
            xb_add(&bar[XB_XGEN(b.x)], 1u);
            asm volatile("s_waitcnt vmcnt(0)" ::: "memory");
        } else {
            XB_SPIN(xb_ld(&bar[XB_XGEN(b.x)]) == gen, bar);
            __builtin_amdgcn_fence(__ATOMIC_ACQUIRE, "agent");
            asm volatile("s_waitcnt vmcnt(0)" ::: "memory");
        }
    }
    __syncthreads();
}

__global__ void __launch_bounds__(512, 2) hybrid_fwd(Params p) {
    extern __shared__ __attribute__((aligned(16))) unsigned char lds_raw[];
    cg::grid_group grid = cg::this_grid();
    PG8_LAS unsigned char* lds = (PG8_LAS unsigned char*)lds_raw;
    LAS float* ldsf = (LAS float*)lds_raw;
#if PROBE_CLASS >= 0
    unsigned long long tacc = 0, tst = 0;
#define TSTART() (tst = __builtin_amdgcn_s_memrealtime())
#define TSTOP(c) do { if ((c) == PROBE_CLASS) tacc += __builtin_amdgcn_s_memrealtime() - tst; } while (0)
#else
#define TSTART() ((void)0)
#define TSTOP(c) ((void)0)
#endif
    volatile LAS unsigned* xst = (volatile LAS unsigned*)(lds_raw + 131072 + 64);
    if (threadIdx.x < 2) xst[threadIdx.x] = 0u;
    __syncthreads();
    const XcdBarrier xbar = xcd_barrier_post((unsigned*)(p.ws + WS_BAR), xst);
#define GBAR() xcd_barrier(xbar)
#if PROBE_CLASS == 9
#define GSYNC() do { GBAR(); TSTART(); GBAR(); TSTOP(9); } while (0)
#else
#define GSYNC() do { TSTART(); GBAR(); TSTOP(0); } while (0)
#endif
#define PH_BEGIN int tid = threadIdx.x; asm volatile("" : "+v"(tid)); int bx = blockIdx.x, G = gridDim.x; asm volatile("" : "+s"(bx), "+s"(G)); \
    unsigned char* ws = p.ws; asm volatile("" : "+s"(ws)); float* xo = p.out; asm volatile("" : "+s"(xo)); \
    const int lane = tid & 63, wave = __builtin_amdgcn_readfirstlane(tid >> 6), gw = bx * 8 + wave, ngw = G * 8; (void)lane; (void)wave; (void)gw; (void)ngw; \
    const float* modl = (const float*)(ws + WS_MOD) + (size_t)l * 4 * NMOD; (void)modl; bf16_t* H = (bf16_t*)(ws + WS_H); (void)H;
#pragma unroll 1
    for (int l = 0; l < 2; ++l) {
        TSTART(); { PH_BEGIN
          if (l == 0) { tables_and_mod(p, ldsf, tid); __syncthreads(); }
          convert_weights(p, l, ldsf, tid); } TSTOP(4);
        if (l == 0) grid.sync();
        TSTART(); { PH_BEGIN
          norm_phase(l == 0 ? p.x : xo, p.norm_mix_g + l * DM, modl, 0, 1, H, gw, ngw, lane); } TSTOP(5);
        GSYNC();
#pragma unroll 1
        for (int half = 0; half < 2; ++half) {
            TSTART(); { PH_BEGIN
              pg8::Gemm g{H + (size_t)half * TH * DM, (const bf16_t*)(ws + WS_WINA), TH, 6144, DM}; pg8::StaticOrder S; S.init(TH, 6144, G, bx);
              EpiInA E{(bf16_t*)(ws + WS_X), (bf16_t*)(ws + WS_YRET) + (size_t)half * TH * 2048, (const float*)(ws + WS_COSP), (const float*)(ws + WS_SINP)};
              pg8::gemm_phase<EpiInA, pg8::StaticOrder, true, true>(lds, g, S, E); } TSTOP(1);
            TSTART(); { PH_BEGIN
              pg8::Gemm g{(const bf16_t*)(ws + WS_WINB), H + (size_t)half * TH * DM, 4096, TH, DM}; pg8::StaticOrder S; S.init(4096, TH, G, bx);
              EpiInB E{(bf16_t*)(ws + WS_KZT), (const float*)(ws + WS_COST), (const float*)(ws + WS_SINT)};
              pg8::gemm_phase<EpiInB, pg8::StaticOrder, true, true>(lds, g, S, E); } TSTOP(1);
            GSYNC();
            TSTART(); { PH_BEGIN
              for (int s = gw; s < 2048; s += ngw) if (!(s & 1)) ret_state_item(s >> 1, (const bf16_t*)(ws + WS_KZT), (const bf16_t*)(ws + WS_VT), (bf16_t*)(ws + WS_RSNAP), lane); } TSTOP(2);
            TSTART(); { PH_BEGIN
              for (int it = gw; it < 4096; it += ngw) sb_item(it, (const bf16_t*)(ws + WS_SQ), (const bf16_t*)(ws + WS_SK), (const bf16_t*)(ws + WS_SVT), (bf16_t*)(ws + WS_YSB) + (size_t)half * TH * 1024, lane); } TSTOP(6);
            GSYNC();
            TSTART(); { PH_BEGIN
              for (int it = bx; it < 256; it += G) ret_out_item(it, (const bf16_t*)(ws + WS_QR), (const bf16_t*)(ws + WS_KN), (const bf16_t*)(ws + WS_VT), (const bf16_t*)(ws + WS_RSNAP), (bf16_t*)(ws + WS_YRET) + (size_t)half * TH * 2048, ldsf, wave, lane); } TSTOP(3);
            GSYNC();
        }
        TSTART(); { PH_BEGIN pg8::StaticOrder S; S.init(T, DM, G, bx);
          pg8::Gemm g{H, (const bf16_t*)(ws + WS_WG), T, DM, DM}; EpiEw<0> E{(bf16_t*)(ws + WS_MERGED), nullptr, DM}; pg8::gemm_phase<EpiEw<0>, pg8::StaticOrder, false, true>(lds, g, S, E); } TSTOP(7);
        TSTART(); { PH_BEGIN pg8::StaticOrder S; S.init(T, DM, G, bx);
          pg8::Gemm g{(const bf16_t*)(ws + WS_YRET), (const bf16_t*)(ws + WS_WRET), T, DM, 2048}; EpiEw<2> E{(bf16_t*)(ws + WS_MERGED), nullptr, DM}; pg8::gemm_phase<EpiEw<2>, pg8::StaticOrder, false, true>(lds, g, S, E); } TSTOP(7);
        TSTART(); { PH_BEGIN pg8::StaticOrder S; S.init(T, DM, G, bx);
          pg8::Gemm g{H, (const bf16_t*)(ws + WS_WG) + (size_t)1024 * 1024, T, DM, DM}; EpiEw<0> E{(bf16_t*)(ws + WS_TMP), nullptr, DM}; pg8::gemm_phase<EpiEw<0>, pg8::StaticOrder, false, true>(lds, g, S, E); } TSTOP(7);
        TSTART(); { PH_BEGIN pg8::StaticOrder S; S.init(T, DM, G, bx);
          pg8::Gemm g{(const bf16_t*)(ws + WS_YSB), (const bf16_t*)(ws + WS_WSB), T, DM, DM}; EpiEw<3> E{(bf16_t*)(ws + WS_MERGED), (const bf16_t*)(ws + WS_TMP), DM}; pg8::gemm_phase<EpiEw<3>, pg8::StaticOrder, false, true>(lds, g, S, E); } TSTOP(7);
        GSYNC();
        TSTART(); { PH_BEGIN pg8::StaticOrder S; S.init(T, DM, G, bx);
          pg8::Gemm g{(const bf16_t*)(ws + WS_MERGED), (const bf16_t*)(ws + WS_WMIX), T, DM, DM}; EpiRes E{l == 0 ? p.x : xo, xo, modl + 2 * 1024};
          pg8::gemm_phase<EpiRes, pg8::StaticOrder, false, true>(lds, g, S, E); } TSTOP(7);
        GSYNC();
        TSTART(); { PH_BEGIN
          norm_phase(xo, p.norm_mlp_g + l * DM, modl, 3, 4, H, gw, ngw, lane); } TSTOP(5);
        GSYNC();
        TSTART(); { PH_BEGIN pg8::StaticOrder S; S.init(T, FF, G, bx);
          pg8::Gemm g{H, (const bf16_t*)(ws + WS_WUP), T, FF, DM}; EpiEw<1> E{(bf16_t*)(ws + WS_U), nullptr, FF};
          pg8::gemm_phase<EpiEw<1>, pg8::StaticOrder, true, true>(lds, g, S, E); } TSTOP(8);
        GSYNC();
        TSTART(); { PH_BEGIN pg8::StaticOrder S; S.init(T, DM, G, bx);
          pg8::Gemm g{(const bf16_t*)(ws + WS_U), (const bf16_t*)(ws + WS_WDN), T, DM, FF}; EpiRes E{xo, xo, modl + 5 * 1024};
          pg8::gemm_phase<EpiRes, pg8::StaticOrder, false, true>(lds, g, S, E); } TSTOP(8);
        GSYNC();
    }
    TSTART(); { const int l = 0; PH_BEGIN
      final_norm_phase(xo, p.final_g, gw, ngw, lane); } TSTOP(5);
#if PROBE_CLASS >= 0
    grid.sync();
    if (blockIdx.x == 0) { const unsigned kk = (unsigned)(tacc * 4ull / 25ull);
        for (unsigned i = threadIdx.x; i < kk; i += 512) p.out[i] += 0.1f; }
#endif
#undef PH_BEGIN
}

extern "C" void kernel_launch(void* const* d_in, const int* in_sizes, int n_in, void* d_out, int out_size, void* d_ws, size_t ws_size, hipStream_t stream) {
    static int grid_blocks = 0;
    if (grid_blocks == 0) {
        if (n_in != 13 || out_size != T * DM || ws_size < WS_END) { fprintf(stderr, "kernel_launch: unexpected shapes (n_in %d out %d ws %zu need %zu)\n", n_in, out_size, ws_size, (size_t)WS_END); grid_blocks = -1; return; }
        int dev = 0, cus = 0, per_cu = 0;
        (void)hipGetDevice(&dev); (void)hipDeviceGetAttribute(&cus, hipDeviceAttributeMultiprocessorCount, dev);
        if (hipFuncSetAttribute((const void*)hybrid_fwd, hipFuncAttributeMaxDynamicSharedMemorySize, LDS_BYTES) != hipSuccess) { fprintf(stderr, "kernel_launch: hipFuncSetAttribute failed\n"); grid_blocks = -1; return; }
        if (hipOccupancyMaxActiveBlocksPerMultiprocessor(&per_cu, (const void*)hybrid_fwd, 512, LDS_BYTES) != hipSuccess || per_cu < 1) { fprintf(stderr, "kernel_launch: occupancy query gave %d\n", per_cu); per_cu = 1; (void)hipGetLastError(); }
        grid_blocks = cus * per_cu;
    }
    if (grid_blocks < 0) return;
    Params p{};
    p.x = (const float*)d_in[0]; p.c = (const float*)d_in[1]; p.norm_mix_g = (const float*)d_in[2]; p.w_in = (const float*)d_in[3]; p.w_ret_out = (const float*)d_in[4];
    p.w_sb_out = (const float*)d_in[5]; p.w_mix_out = (const float*)d_in[6]; p.norm_mlp_g = (const float*)d_in[7]; p.w_up = (const float*)d_in[8]; p.w_down = (const float*)d_in[9];
    p.w_ada = (const float*)d_in[10]; p.b_ada = (const float*)d_in[11]; p.final_g = (const float*)d_in[12];
    p.out = (float*)d_out; p.ws = (unsigned char*)d_ws;
    if (hipMemsetAsync((char*)d_ws + WS_BAR, 0, XCD_BAR_WORDS * 4, stream) != hipSuccess) { fprintf(stderr, "kernel_launch: memset failed\n"); return; }
    void* args[] = {&p};
    hipError_t e = hipLaunchCooperativeKernel((const void*)hybrid_fwd, dim3(grid_blocks), dim3(512), args, LDS_BYTES, stream);
    if (e != hipSuccess) fprintf(stderr, "kernel_launch: cooperative launch failed: %s (grid %d)\n", hipGetErrorString(e), grid_blocks);
}
```

```cpp
#include <hip/hip_runtime.h>
#include <hip/hip_cooperative_groups.h>
#include <cstdio>
#include <cstdint>
namespace cg = cooperative_groups;
#define DI __device__ __forceinline__
#define PROBE_CLASS -1
namespace pg8 {
#define PG8_LAS __attribute__((address_space(3)))
typedef unsigned short bf16_t;
typedef short bf16x8 __attribute__((ext_vector_type(8)));
typedef float f32x4 __attribute__((ext_vector_type(4)));
typedef unsigned u32x4 __attribute__((ext_vector_type(4)));
constexpr int BM = 256, BK = 64, HALF = 128, HTB = HALF * BK * 2  , STAGE_BYTES = 8 * HTB, NXCD = 8, WGM = 8;

__host__ __device__ __forceinline__ int lds_byte(int r, int c) { const int st = (r >> 4) * 2 + (c >> 5), rr = r & 15, cc = c & 31, ob = rr * 64 + cc * 2; return st * 1024 + (ob ^ (((ob >> 9) & 1) << 5)); }
__host__ __device__ __forceinline__ void stage_rc(int b, int& R, int& C) { const int st = b / 1024, sb = b % 1024, swz = sb ^ (((sb >> 9) & 1) << 5); R = (st >> 1) * 16 + swz / 64; C = (st & 1) * 32 + (swz % 64) / 2; }
__host__ __device__ __forceinline__ int perm32(int rho) { const int n = rho >> 4, i = rho & 15; return 8 * (i >> 2) + 4 * n + (i & 3); }

struct Unit { int pm, pn; };
struct Gemm { const bf16_t* A; const bf16_t* Bt; int M, N, K; };

struct StaticOrder {
    int nM, nN, nwg, G, c;
    __host__ __device__ void init(int M, int N, int G_, int c_) { nM = M / BM; nN = N / BM; nwg = nM * nN; G = G_; c = c_; }
    __host__ __device__ bool next(int i, Unit& u) const {
        const long L = (long)i * G + c; if (L >= nwg) return false;
        int wgid = (int)L; { const int q = nwg / NXCD, r = nwg % NXCD, xcd = wgid % NXCD, off = wgid / NXCD; wgid = (xcd < r ? xcd * (q + 1) : r * (q + 1) + (xcd - r) * q) + off; }
        const int nig = WGM * nN, gid = wgid / nig, fm = gid * WGM, gsz = (nM - fm) < WGM ? (nM - fm) : WGM;
        u.pm = fm + ((wgid % nig) % gsz); u.pn = (wgid % nig) / gsz; return true;
    }
    __device__ __forceinline__ void a_ready(const Unit&) const {}
    __device__ __forceinline__ void done(const Unit&) const {}
};

template <class Epi, class Sched, bool ALIGN_EPI = false, bool SP2 = false>
__device__ __forceinline__ void gemm_phase(PG8_LAS unsigned char* lds, const Gemm g, const Sched& S, const Epi& E) {
    int tid_l = threadIdx.x; asm volatile("" : "+v"(tid_l)); const int tid = tid_l, wid = __builtin_amdgcn_readfirstlane(tid >> 6), lane = tid & 63, wr = wid >> 2, wc = wid & 3, fr = lane & 15, fq = lane >> 4;
    const int K = g.K, nt = K / BK;
    unsigned voffA[2], voffB[2];
#pragma unroll
    for (int i = 0; i < 2; ++i) { int R, C; stage_rc(tid * 16 + i * 8192, R, C); const int Rb = Epi::PERM ? ((R & ~31) + perm32(R & 31)) : R;
        voffA[i] = (unsigned)(R * K + C) * 2u; voffB[i] = (unsigned)(Rb * K + C) * 2u; }
    const size_t kstep = (size_t)(BK * 2);
    const size_t hstep = (size_t)HALF * K * 2;
    const size_t tstep = 2 * hstep;
    const unsigned ldsw = (unsigned)wid * 1024u;
    const int aoff = lds_byte(wr * 64 + fr, fq * 8), boff = lds_byte(wc * 32 + fr, fq * 8);
#define PG8_SA(b, h) (((b) * 2 + (h)) * HTB)
#define PG8_SB(b, h) ((4 + (b) * 2 + (h)) * HTB)
#define PG8_STAGE(bufoff, gbase, voff) do { _Pragma("unroll") for (int _i = 0; _i < 2; ++_i) \
        __builtin_amdgcn_global_load_lds((const unsigned*)((const char*)(gbase) + (voff)[_i]), (PG8_LAS unsigned*)(lds + (bufoff) + ldsw + _i * 8192), 16, 0, 0); } while (0)
#define PG8_LDA(dst, b, h) do { _Pragma("unroll") for (int m = 0; m < 4; ++m) _Pragma("unroll") for (int k = 0; k < 2; ++k) dst[m][k] = *(const PG8_LAS bf16x8*)(lds + PG8_SA(b, h) + aoff + m * 2048 + k * 1024); } while (0)
#define PG8_LDB(dst, b, h) do { _Pragma("unroll") for (int n = 0; n < 2; ++n) _Pragma("unroll") for (int k = 0; k < 2; ++k) dst[n][k] = *(const PG8_LAS bf16x8*)(lds + PG8_SB(b, h) + boff + n * 2048 + k * 1024); } while (0)
#define PG8_MMA(ai, bj, At, Bt) do { __builtin_amdgcn_s_setprio(1); _Pragma("unroll") for (int m = 0; m < 4; ++m) _Pragma("unroll") for (int n = 0; n < 2; ++n) _Pragma("unroll") for (int k = 0; k < 2; ++k) \
        acc[ai][bj][m][n] = __builtin_amdgcn_mfma_f32_16x16x32_bf16(Bt[n][k], At[m][k], acc[ai][bj][m][n], 0, 0, 0); __builtin_amdgcn_s_setprio(0); } while (0)
#define PG8_WAIT_V(n) asm volatile("s_waitcnt vmcnt(" #n ")" ::: "memory")
#define PG8_WAIT_L(n) asm volatile("s_waitcnt lgkmcnt(" #n ")" ::: "memory")
#define PG8_BAR __builtin_amdgcn_s_barrier()
#define PG8_SCHED __builtin_amdgcn_sched_barrier(0)
    Unit cur, nxt; int ui = 0;
    if (!S.next(0, cur)) return;
    f32x4 acc[2][2][4][2];
#pragma unroll
    for (int a = 0; a < 2; ++a)
#pragma unroll
        for (int b = 0; b < 2; ++b)
#pragma unroll
            for (int m = 0; m < 4; ++m)
#pragma unroll
                for (int n = 0; n < 2; ++n) acc[a][b][m][n] = (f32x4){0.f, 0.f, 0.f, 0.f};
    bf16x8 At[4][2], B0[2][2], B1[2][2];
    const char* cA = (const char*)g.A + (size_t)cur.pm * tstep; const char* cB = (const char*)g.Bt + (size_t)cur.pn * tstep;
    S.a_ready(cur);
    if constexpr (SP2) {
        PG8_STAGE(PG8_SB(0, 0), cB, voffB); PG8_STAGE(PG8_SB(0, 1), cB + hstep, voffB); PG8_STAGE(PG8_SA(0, 0), cA, voffA); PG8_STAGE(PG8_SA(0, 1), cA + hstep, voffA);
        if (wr == 1) PG8_BAR;
        PG8_WAIT_V(2); PG8_BAR;
        PG8_STAGE(PG8_SB(1, 0), cB + kstep, voffB); PG8_STAGE(PG8_SA(1, 0), cA + kstep, voffA); PG8_STAGE(PG8_SB(1, 1), cB + hstep + kstep, voffB);
        PG8_WAIT_V(6); PG8_BAR;
    } else {
        PG8_STAGE(PG8_SB(0, 0), cB, voffB); PG8_STAGE(PG8_SA(0, 0), cA, voffA); PG8_STAGE(PG8_SB(0, 1), cB + hstep, voffB); PG8_STAGE(PG8_SA(0, 1), cA + hstep, voffA);
        if (wr == 1) PG8_BAR;
        PG8_WAIT_V(4); PG8_BAR;
        PG8_STAGE(PG8_SB(1, 0), cB + kstep, voffB); PG8_STAGE(PG8_SA(1, 0), cA + kstep, voffA); PG8_STAGE(PG8_SB(1, 1), cB + hstep + kstep, voffB);
        PG8_WAIT_V(6); PG8_BAR;
    }
    for (;;) {
        const bool has_next = S.next(ui + 1, nxt);
        const char* nA = has_next ? (const char*)g.A + (size_t)nxt.pm * tstep : cA; const char* nB = has_next ? (const char*)g.Bt + (size_t)nxt.pn * tstep : cB;
        for (int t = 0; t < nt; t += 2) {
            const bool last = (t == nt - 2);
            const char* a1 = cA + (size_t)(t + 1) * kstep;
            const char* a2 = last ? nA : cA + (size_t)(t + 2) * kstep; const char* b2 = last ? nB : cB + (size_t)(t + 2) * kstep;
            const char* a3 = a2 + kstep; const char* b3 = b2 + kstep;
            if (last && has_next) S.a_ready(nxt);
            if constexpr (SP2) {
            PG8_LDB(B0, 0, 0); PG8_LDB(B1, 0, 1); PG8_SCHED; PG8_LDA(At, 0, 0); PG8_STAGE(PG8_SA(1, 1), a1 + hstep, voffA);
            PG8_WAIT_V(8); PG8_WAIT_L(0); PG8_BAR; PG8_MMA(0, 0, At, B0); PG8_MMA(0, 1, At, B1); PG8_BAR; PG8_SCHED;
            PG8_LDA(At, 0, 1); PG8_STAGE(PG8_SB(0, 0), b2, voffB); PG8_STAGE(PG8_SB(0, 1), b2 + hstep, voffB); PG8_STAGE(PG8_SA(0, 0), a2, voffA);
            PG8_WAIT_V(8); PG8_WAIT_L(0); PG8_BAR; PG8_MMA(1, 0, At, B0); PG8_MMA(1, 1, At, B1); PG8_BAR; PG8_SCHED;
            PG8_LDB(B0, 1, 0); PG8_LDB(B1, 1, 1); PG8_SCHED; PG8_LDA(At, 1, 0); PG8_STAGE(PG8_SA(0, 1), a2 + hstep, voffA);
            PG8_WAIT_V(8); PG8_WAIT_L(0); PG8_BAR; PG8_MMA(0, 0, At, B0); PG8_MMA(0, 1, At, B1); PG8_BAR; PG8_SCHED;
            PG8_LDA(At, 1, 1); PG8_STAGE(PG8_SB(1, 0), b3, voffB); PG8_STAGE(PG8_SB(1, 1), b3 + hstep, voffB); PG8_STAGE(PG8_SA(1, 0), a3, voffA);
            PG8_WAIT_V(8); PG8_WAIT_L(0); PG8_BAR; PG8_MMA(1, 0, At, B0); PG8_MMA(1, 1, At, B1); PG8_BAR; PG8_SCHED;
            } else {
            PG8_LDB(B0, 0, 0); PG8_SCHED; PG8_LDA(At, 0, 0); PG8_STAGE(PG8_SA(1, 1), a1 + hstep, voffA);
            PG8_WAIT_L(8); PG8_BAR; PG8_WAIT_L(0); PG8_MMA(0, 0, At, B0); PG8_BAR; PG8_SCHED;
            PG8_LDB(B1, 0, 1); PG8_STAGE(PG8_SB(0, 0), b2, voffB);
            PG8_BAR; PG8_WAIT_L(0); PG8_MMA(0, 1, At, B1); PG8_BAR;
            PG8_LDA(At, 0, 1); PG8_STAGE(PG8_SA(0, 0), a2, voffA);
            PG8_BAR; PG8_WAIT_L(0); PG8_MMA(1, 0, At, B0); PG8_BAR; PG8_SCHED;
            PG8_STAGE(PG8_SB(0, 1), b2 + hstep, voffB);
            PG8_WAIT_V(6); PG8_BAR; PG8_MMA(1, 1, At, B1); PG8_BAR;
            PG8_LDB(B0, 1, 0); PG8_SCHED; PG8_LDA(At, 1, 0); PG8_STAGE(PG8_SA(0, 1), a2 + hstep, voffA);
            PG8_WAIT_L(8); PG8_BAR; PG8_WAIT_L(0); PG8_MMA(0, 0, At, B0); PG8_BAR; PG8_SCHED;
            PG8_LDB(B1, 1, 1); PG8_STAGE(PG8_SB(1, 0), b3, voffB);
            PG8_BAR; PG8_WAIT_L(0); PG8_MMA(0, 1, At, B1); PG8_BAR;
            PG8_LDA(At, 1, 1); PG8_STAGE(PG8_SA(1, 0), a3, voffA);
            PG8_BAR; PG8_WAIT_L(0); PG8_MMA(1, 0, At, B0); PG8_BAR; PG8_SCHED;
            PG8_STAGE(PG8_SB(1, 1), b3 + hstep, voffB);
            PG8_WAIT_V(6); PG8_BAR; PG8_MMA(1, 1, At, B1); PG8_BAR;
            }
        }
        if constexpr (ALIGN_EPI) { if (wr == 0) PG8_BAR; }
        if constexpr (!Epi::AFTER_DRAIN) { E(acc, cur, wr, wc, fr, fq); S.done(cur); }
        if (!has_next) break;
#pragma unroll
        for (int a = 0; a < 2; ++a)
#pragma unroll
            for (int b = 0; b < 2; ++b)
#pragma unroll
                for (int m = 0; m < 4; ++m)
#pragma unroll
                    for (int n = 0; n < 2; ++n) acc[a][b][m][n] = (f32x4){0.f, 0.f, 0.f, 0.f};
        cur = nxt; cA = nA; cB = nB; ++ui;
        if constexpr (ALIGN_EPI) { if (wr == 1) PG8_BAR; }
    }
    PG8_WAIT_V(0);
    if constexpr (!ALIGN_EPI) { if (wr == 0) PG8_BAR; }
    PG8_BAR;
    if constexpr (Epi::AFTER_DRAIN) { E.fused(acc, cur, wr, wc, fr, fq, lds, wid, lane); S.done(cur); }
#undef PG8_SA
#undef PG8_SB
#undef PG8_STAGE
#undef PG8_LDA
#undef PG8_LDB
#undef PG8_MMA
#undef PG8_WAIT_V
#undef PG8_WAIT_L
#undef PG8_BAR
#undef PG8_SCHED
}
}

using pg8::bf16_t; using pg8::bf16x8; using pg8::f32x4; using pg8::u32x4; using pg8::Unit;
typedef float f32x16 __attribute__((ext_vector_type(16)));
typedef float f32x2 __attribute__((ext_vector_type(2)));
typedef unsigned u32x2 __attribute__((ext_vector_type(2)));
typedef __bf16 bf16x2_t __attribute__((ext_vector_type(2)));
#define LAS __attribute__((address_space(3)))
#define MFMA32(a, b, c) __builtin_amdgcn_mfma_f32_32x32x16_bf16((a), (b), (c), 0, 0, 0)

constexpr int T = 16384, DM = 1024, SEQ = 4096, TH = 8192, FF = 4096, INW = 11264, NMOD = 6144;
constexpr int RCH = 512, NRCH = SEQ / RCH;
constexpr size_t MiB = 1u << 20;
constexpr size_t WS_BAR = 768 * 1024;
constexpr size_t WS_MOD = 0, WS_COSP = 1 * MiB, WS_SINP = 3 * MiB, WS_COST = 5 * MiB, WS_SINT = 7 * MiB, WS_H = 9 * MiB;
constexpr size_t WS_WINA = 41 * MiB, WS_WINB = 53 * MiB, WS_WG = 61 * MiB, WS_WRET = 65 * MiB, WS_WSB = 69 * MiB, WS_WMIX = 71 * MiB, WS_WUP = 73 * MiB, WS_WDN = 81 * MiB;
constexpr size_t WS_YRET = 89 * MiB, WS_YSB = 153 * MiB, WS_RSNAP = 185 * MiB, WS_X = 201 * MiB, WS_END = 329 * MiB;
constexpr size_t WS_QR = WS_X, WS_KN = WS_X + 16 * MiB, WS_SQ = WS_X + 32 * MiB, WS_SK = WS_X + 48 * MiB, WS_KZT = WS_X + 64 * MiB, WS_VT = WS_X + 80 * MiB, WS_SVT = WS_X + 112 * MiB;
static_assert(WS_KN == WS_QR + 16 * MiB && WS_SQ == WS_QR + 32 * MiB && WS_SK == WS_QR + 48 * MiB && WS_VT == WS_KZT + 16 * MiB && WS_SVT == WS_KZT + 48 * MiB, "epilogue pointer arithmetic");
constexpr size_t WS_MERGED = WS_X, WS_TMP = WS_X + 32 * MiB, WS_U = WS_X;
constexpr int LDS_BYTES = 147456;
constexpr float SB_STOP = -80.0f;

DI unsigned pk2(float lo, float hi) { f32x2 v = {lo, hi}; bf16x2_t b = __builtin_convertvector(v, bf16x2_t); return __builtin_bit_cast(unsigned, b); }
DI float bflo(unsigned w) { return __uint_as_float(w << 16); }
DI float bfhi(unsigned w) { return __uint_as_float(w & 0xffff0000u); }
DI u32x4 pack8(f32x4 a, f32x4 b) { u32x4 w; w.x = pk2(a[0], a[1]); w.y = pk2(a[2], a[3]); w.z = pk2(b[0], b[1]); w.w = pk2(b[2], b[3]); return w; }
DI void unpack8(u32x4 w, f32x4& a, f32x4& b) { a = (f32x4){bflo(w.x), bfhi(w.x), bflo(w.y), bfhi(w.y)}; b = (f32x4){bflo(w.z), bfhi(w.z), bflo(w.w), bfhi(w.w)}; }
DI float wave_sum(float v) {
#pragma unroll
    for (int o = 1; o < 64; o <<= 1) v += __shfl_xor(v, o);
    return v;
}
DI float log2gamma(int h) { return log2f(1.0f - exp2f(-5.0f - (float)h)); }
DI float sigmoidf_(float v) { return 1.0f / (1.0f + __expf(-v)); }
DI int crow(int reg, int hh) { return (reg & 3) + 8 * (reg >> 2) + 4 * hh; }
DI size_t nfrag(int row, int col, int C) { return ((((size_t)(row >> 5) * (C >> 4) + (col >> 4)) * 2 + ((col >> 3) & 1)) * 32 + (row & 31)) * 8 + (col & 7); }
DI size_t tfrag0(int ch, int tok0, int NTOK) { return ((((size_t)(ch >> 5) * (NTOK >> 4) + (tok0 >> 4)) * 2) * 32 + (ch & 31)) * 8 + 4 * ((tok0 >> 3) & 1); }
DI void st_tfrag(bf16_t* base, int ch, int tok0, int NTOK, f32x4 a, f32x4 b) {
    bf16_t* q = base + tfrag0(ch, tok0, NTOK); u32x2 w0, w1; w0.x = pk2(a[0], a[1]); w0.y = pk2(a[2], a[3]); w1.x = pk2(b[0], b[1]); w1.y = pk2(b[2], b[3]);
    *(u32x2*)q = w0; *(u32x2*)(q + 256) = w1; }


struct EpiInA {
    static constexpr bool PERM = true, AFTER_DRAIN = false;
    bf16_t *xb, *yret; const float *cosP, *sinP;
    DI void operator()(const f32x4 (&acc)[2][2][4][2], const Unit& u, int wr, int wc, int fr_, int fq) const {
        int fr = fr_; asm volatile("" : "+v"(fr));
        const int pn = u.pn, row0 = u.pm * 256 + wr * 64 + fr, cl = wc * 32 + 8 * fq;
        if (pn < 8) {
            bf16_t* dst = xb + (size_t)(pn >> 2) * (8u << 20); const int hc = (pn & 3) * 256 + cl;
            const float sc = pn < 4 ? 1.0f : 0.0625f;
#pragma unroll
            for (int ai = 0; ai < 2; ++ai)
#pragma unroll
                for (int m = 0; m < 4; ++m) {
                    const int row = row0 + ai * 128 + m * 16, pos = row & (SEQ - 1);
                    const f32x4* cp = (const f32x4*)(cosP + pos * 128 + cl); const f32x4* sp = (const f32x4*)(sinP + pos * 128 + cl);
                    f32x4 o1[2], o2[2];
#pragma unroll
                    for (int n = 0; n < 2; ++n) { const f32x4 c = cp[n], s = sp[n], t1 = acc[ai][0][m][n], t2 = acc[ai][1][m][n];
                        o1[n] = (t1 * c - t2 * s) * sc; o2[n] = (t1 * s + t2 * c) * sc; }
                    *(u32x4*)(dst + nfrag(row, hc, 1024)) = pack8(o1[0], o1[1]); *(u32x4*)(dst + nfrag(row, hc + 128, 1024)) = pack8(o2[0], o2[1]);
                    __builtin_amdgcn_sched_barrier(0);
                }
        } else {
            const int mode = pn < 16 ? 0 : (pn < 20 ? 1 : 2);
            const int hc = (pn < 16 ? (pn - 8) : (pn & 3)) * 256 + cl;
            bf16_t* dst = xb + (size_t)(mode + 1) * (8u << 20);
#pragma unroll
            for (int ai = 0; ai < 2; ++ai)
#pragma unroll
                for (int m = 0; m < 4; ++m) {
                    const int row = row0 + ai * 128 + m * 16;
#pragma unroll
                    for (int bj = 0; bj < 2; ++bj) {
                        f32x4 v0 = acc[ai][bj][m][0], v1 = acc[ai][bj][m][1];
                        if (mode == 0) {
#pragma unroll
                            for (int e = 0; e < 4; ++e) { v0[e] = v0[e] * sigmoidf_(v0[e]); v1[e] = v1[e] * sigmoidf_(v1[e]); }
                        } else if (mode == 1) { v0 = v0 * 0.125f; v1 = v1 * 0.125f; }
                        if (mode == 0) *(u32x4*)(yret + (size_t)row * 2048 + hc + bj * 128) = pack8(v0, v1);
                        else *(u32x4*)(dst + nfrag(row, hc + bj * 128, 1024)) = pack8(v0, v1);
                    }
                }
        }
    }
};

struct EpiInB {
    static constexpr bool PERM = true, AFTER_DRAIN = false;
    bf16_t *kzT; const float *cosT, *sinT;
    DI void operator()(const f32x4 (&acc)[2][2][4][2], const Unit& u, int wr, int wc, int fr_, int fq) const {
        int fr = fr_; asm volatile("" : "+v"(fr));
        const int pm = u.pm, tok0 = u.pn * 256 + wc * 32 + 8 * fq;
        if (pm < 4) {
            const float l2g = log2gamma(pm), ginv = __builtin_amdgcn_exp2f(-l2g);
#pragma unroll
            for (int m = 0; m < 4; ++m) {
                const int i = wr * 64 + m * 16 + fr;
#pragma unroll
                for (int bj = 0; bj < 2; ++bj) {
                    const int tok = tok0 + bj * 128, pos = tok & (SEQ - 1);
                    const f32x4* cp = (const f32x4*)(cosT + i * SEQ + pos); const f32x4* sp = (const f32x4*)(sinT + i * SEQ + pos);
                    f32x4 o1[2], o2[2];
                    float zr = __builtin_amdgcn_exp2f((float)((RCH - 1) - (pos & (RCH - 1))) * l2g) * 0.0625f;
#pragma unroll
                    for (int n = 0; n < 2; ++n) { const f32x4 c = cp[n], s = sp[n], t1 = acc[0][bj][m][n], t2 = acc[1][bj][m][n];
                        f32x4 z;
#pragma unroll
                        for (int e = 0; e < 4; ++e) { z[e] = zr; zr *= ginv; }
                        o1[n] = (t1 * c - t2 * s) * z; o2[n] = (t1 * s + t2 * c) * z; }
                    st_tfrag(kzT, pm * 256 + i, tok, TH, o1[0], o1[1]);
                    st_tfrag(kzT, pm * 256 + 128 + i, tok, TH, o2[0], o2[1]);
                    __builtin_amdgcn_sched_barrier(0);
                }
            }
        } else {
            bf16_t* dst = kzT + (size_t)(pm < 12 ? 8u << 20 : 24u << 20); const int ch0 = (pm < 12 ? (pm - 4) : (pm - 12)) * 256 + wr * 64 + fr;
#pragma unroll
            for (int ai = 0; ai < 2; ++ai)
#pragma unroll
                for (int m = 0; m < 4; ++m)
#pragma unroll
                    for (int bj = 0; bj < 2; ++bj)
                        st_tfrag(dst, ch0 + ai * 128 + m * 16, tok0 + bj * 128, TH, acc[ai][bj][m][0], acc[ai][bj][m][1]);
        }
    }
};

template <int MODE> struct EpiEw {
    static constexpr bool PERM = true, AFTER_DRAIN = false;
    bf16_t* O; const bf16_t* P; int ld;
    DI void operator()(const f32x4 (&acc)[2][2][4][2], const Unit& u, int wr, int wc, int fr_, int fq) const {
        int fr = fr_; asm volatile("" : "+v"(fr));
        const int row0 = u.pm * 256 + wr * 64 + fr, col0 = u.pn * 256 + wc * 32 + 8 * fq;
#pragma unroll
        for (int ai = 0; ai < 2; ++ai)
#pragma unroll
            for (int m = 0; m < 4; ++m)
#pragma unroll
                for (int bj = 0; bj < 2; ++bj) {
                    const size_t off = (size_t)(row0 + ai * 128 + m * 16) * ld + col0 + bj * 128;
                    f32x4 v0 = acc[ai][bj][m][0], v1 = acc[ai][bj][m][1];
                    if (MODE == 0) {
#pragma unroll
                        for (int e = 0; e < 4; ++e) { v0[e] = sigmoidf_(v0[e]); v1[e] = sigmoidf_(v1[e]); }
                    } else if (MODE == 1) {
#pragma unroll
                        for (int e = 0; e < 4; ++e) { const float a = fmaxf(v0[e], 0.f), b = fmaxf(v1[e], 0.f); v0[e] = a * a; v1[e] = b * b; }
                    } else if (MODE == 2) {
                        f32x4 a, b; unpack8(*(const u32x4*)(O + off), a, b); v0 = v0 * a; v1 = v1 * b;
                    } else {
                        f32x4 a, b, c, d; unpack8(*(const u32x4*)(O + off), a, b); unpack8(*(const u32x4*)(P + off), c, d); v0 = a + c * v0; v1 = b + d * v1;
                    }
                    *(u32x4*)(O + off) = pack8(v0, v1);
                }
    }
};

struct EpiRes {
    static constexpr bool PERM = true, AFTER_DRAIN = false;
    const float* xin; float* xout; const float* gate;
    DI void operator()(const f32x4 (&acc)[2][2][4][2], const Unit& u, int wr, int wc, int fr_, int fq) const {
        int fr = fr_; asm volatile("" : "+v"(fr));
        const int row0 = u.pm * 256 + wr * 64 + fr, col0 = u.pn * 256 + wc * 32 + 8 * fq;
#pragma unroll
        for (int ai = 0; ai < 2; ++ai)
#pragma unroll
            for (int m = 0; m < 4; ++m) {
                const int row = row0 + ai * 128 + m * 16; const float* gp = gate + (row >> 12) * NMOD;
#pragma unroll
                for (int bj = 0; bj < 2; ++bj) {
                    const int col = col0 + bj * 128; const size_t off = (size_t)row * DM + col;
                    const f32x4 g0 = *(const f32x4*)(gp + col), g1 = *(const f32x4*)(gp + col + 4);
                    const f32x4 x0 = *(const f32x4*)(xin + off), x1 = *(const f32x4*)(xin + off + 4);
                    *(f32x4*)(xout + off) = x0 + g0 * acc[ai][bj][m][0]; *(f32x4*)(xout + off + 4) = x1 + g1 * acc[ai][bj][m][1];
                }
            }
    }
};

DI void cvt_tile(const float* src, int ldsrc, int k0, int n0, bf16_t* dst1, bf16_t* dst2, int K, LAS float* tile, int tid) {
    const int kr = tid >> 4, nc = (tid & 15) * 4;
#pragma unroll
    for (int p = 0; p < 2; ++p) { const int k = kr + 32 * p; const f32x4 v = *(const f32x4*)(src + (size_t)(k0 + k) * ldsrc + n0 + nc);
        tile[k * 65 + nc] = v[0]; tile[k * 65 + nc + 1] = v[1]; tile[k * 65 + nc + 2] = v[2]; tile[k * 65 + nc + 3] = v[3]; }
    __syncthreads();
    const int n = tid >> 3, ks = (tid & 7) * 8; const LAS float* s = tile + ks * 65 + n;
    u32x4 o; o.x = pk2(s[0], s[65]); o.y = pk2(s[2 * 65], s[3 * 65]); o.z = pk2(s[4 * 65], s[5 * 65]); o.w = pk2(s[6 * 65], s[7 * 65]);
    *(u32x4*)(dst1 + (size_t)n * K + k0 + ks) = o;
    if (dst2) *(u32x4*)(dst2 + (size_t)n * K + k0 + ks) = o;
    __syncthreads();
}

struct Params {
    const float *x, *c, *norm_mix_g, *w_in, *w_ret_out, *w_sb_out, *w_mix_out, *norm_mlp_g, *w_up, *w_down, *w_ada, *b_ada, *final_g;
    float* out; unsigned char* ws;
};

DI void convert_weights(const Params& p, int l, LAS float* tile, int tid) {
    unsigned char* ws = p.ws;
    bf16_t* WinA = (bf16_t*)(ws + WS_WINA); bf16_t* WinB = (bf16_t*)(ws + WS_WINB); bf16_t* Wg = (bf16_t*)(ws + WS_WG);
    constexpr int I_IN = 16 * 176, I_RET = 32 * 16, I_SB = 16 * 16, I_MIX = 16 * 16, I_UP = 16 * 64, I_DN = 64 * 16;
    constexpr int NIT = I_IN + I_RET + I_SB + I_MIX + I_UP + I_DN;
    for (int it = blockIdx.x; it < NIT; it += gridDim.x) {
        int r = it;
        if (r < I_IN) {
            const int kb = r / 176, nb = r % 176, n0 = nb * 64; bf16_t* d1; bf16_t* d2 = nullptr;
            if (n0 < 1024) d1 = WinA + (size_t)n0 * 1024;
            else if (n0 < 2048) { d1 = WinA + (size_t)n0 * 1024; d2 = WinB + (size_t)(n0 - 1024) * 1024; }
            else if (n0 < 4096) d1 = WinB + (size_t)(n0 - 1024) * 1024;
            else if (n0 < 8192) d1 = WinA + (size_t)(n0 - 2048) * 1024;
            else if (n0 < 9216) d1 = WinB + (size_t)(n0 - 5120) * 1024;
            else d1 = Wg + (size_t)(n0 - 9216) * 1024;
            cvt_tile(p.w_in + (size_t)l * DM * INW, INW, kb * 64, n0, d1, d2, 1024, tile, tid); continue;
        }
        r -= I_IN;
        if (r < I_RET) { const int kb = r / 16, nb = r % 16; cvt_tile(p.w_ret_out + (size_t)l * 2048 * 1024, 1024, kb * 64, nb * 64, (bf16_t*)(ws + WS_WRET) + (size_t)nb * 64 * 2048, nullptr, 2048, tile, tid); continue; }
        r -= I_RET;
        if (r < I_SB) { const int kb = r / 16, nb = r % 16; cvt_tile(p.w_sb_out + (size_t)l * 1024 * 1024, 1024, kb * 64, nb * 64, (bf16_t*)(ws + WS_WSB) + (size_t)nb * 64 * 1024, nullptr, 1024, tile, tid); continue; }
        r -= I_SB;
        if (r < I_MIX) { const int kb = r / 16, nb = r % 16; cvt_tile(p.w_mix_out + (size_t)l * 1024 * 1024, 1024, kb * 64, nb * 64, (bf16_t*)(ws + WS_WMIX) + (size_t)nb * 64 * 1024, nullptr, 1024, tile, tid); continue; }
        r -= I_MIX;
        if (r < I_UP) { const int kb = r / 64, nb = r % 64; cvt_tile(p.w_up + (size_t)l * 1024 * 4096, 4096, kb * 64, nb * 64, (bf16_t*)(ws + WS_WUP) + (size_t)nb * 64 * 1024, nullptr, 1024, tile, tid); continue; }
        r -= I_UP;
        { const int kb = r / 16, nb = r % 16; cvt_tile(p.w_down + (size_t)l * 4096 * 1024, 1024, kb * 64, nb * 64, (bf16_t*)(ws + WS_WDN) + (size_t)nb * 64 * 4096, nullptr, 4096, tile, tid); }
    }
}

DI void tables_and_mod(const Params& p, LAS float* lds, int tid) {
    float* cosP = (float*)(p.ws + WS_COSP); float* sinP = (float*)(p.ws + WS_SINP); float* cosT = (float*)(p.ws + WS_COST); float* sinT = (float*)(p.ws + WS_SINT);
    for (int idx = blockIdx.x * 512 + tid; idx < SEQ * 128; idx += gridDim.x * 512) {
        const int pos = idx >> 7, i = idx & 127;
        const float inv = powf(10000.0f, -(float)i / 128.0f); const float ang = (float)pos * inv;
        const float c = cosf(ang), s = sinf(ang);
        cosP[idx] = c; sinP[idx] = s; cosT[i * SEQ + pos] = c; sinT[i * SEQ + pos] = s;
    }
    float* mod = (float*)(p.ws + WS_MOD);
    LAS float* cact = lds; LAS float* red = lds + 4096;
    const int wave = tid >> 6, lane = tid & 63;
    bool have = false;
    for (int it = blockIdx.x; it < 2 * 96; it += gridDim.x) {
        if (!have) { for (int e = tid; e < 4096; e += 512) { const float v = p.c[e]; cact[e] = v * sigmoidf_(v); } have = true; __syncthreads(); }
        const int l = it / 96, c0 = (it % 96) * 64;
        const float* w = p.w_ada + (size_t)l * DM * NMOD + c0 + lane;
        float a0 = 0.f, a1 = 0.f, a2 = 0.f, a3 = 0.f;
#pragma unroll 8
        for (int k = wave * 128; k < wave * 128 + 128; ++k) { const float wv = w[(size_t)k * NMOD]; a0 += cact[k] * wv; a1 += cact[1024 + k] * wv; a2 += cact[2048 + k] * wv; a3 += cact[3072 + k] * wv; }
        red[(wave * 4 + 0) * 64 + lane] = a0; red[(wave * 4 + 1) * 64 + lane] = a1; red[(wave * 4 + 2) * 64 + lane] = a2; red[(wave * 4 + 3) * 64 + lane] = a3;
        __syncthreads();
        if (tid < 256) { const int b = tid >> 6; float s = p.b_ada[l * NMOD + c0 + lane];
#pragma unroll
            for (int w8 = 0; w8 < 8; ++w8) s += red[(w8 * 4 + b) * 64 + lane];
            mod[(size_t)(l * 4 + b) * NMOD + c0 + lane] = s; }
        __syncthreads();
    }
}

DI void norm_phase(const float* xin, const float* g, const float* modl, int shift_i, int scale_i, bf16_t* hout, int gw, int ngw, int lane) {
    for (int row = gw; row < T; row += ngw) {
        const f32x4* xr = (const f32x4*)(xin + (size_t)row * DM) + lane;
        f32x4 v[4]; float s = 0.f;
#pragma unroll
        for (int j = 0; j < 4; ++j) { v[j] = xr[64 * j]; s += (v[j][0] * v[j][0] + v[j][1] * v[j][1]) + (v[j][2] * v[j][2] + v[j][3] * v[j][3]); }
        const float rstd = 1.0f / sqrtf(wave_sum(s) * (1.0f / DM) + 1e-6f);
        const float* mb = modl + (row >> 12) * NMOD;
        u32x2* o8 = (u32x2*)(hout + (size_t)row * DM) + lane;
#pragma unroll
        for (int j = 0; j < 4; ++j) { const int col = 4 * (lane + 64 * j);
            const f32x4 gg = *(const f32x4*)(g + col), sc = *(const f32x4*)(mb + scale_i * 1024 + col), sh = *(const f32x4*)(mb + shift_i * 1024 + col);
            const f32x4 y = v[j] * rstd * gg * (sc + 1.0f) + sh;
            u32x2 w; w.x = pk2(y[0], y[1]); w.y = pk2(y[2], y[3]); o8[64 * j] = w; }
    }
}
DI void final_norm_phase(float* x, const float* g, int gw, int ngw, int lane) {
    for (int row = gw; row < T; row += ngw) {
        f32x4* xr = (f32x4*)(x + (size_t)row * DM) + lane;
        f32x4 v[4]; float s = 0.f;
#pragma unroll
        for (int j = 0; j < 4; ++j) { v[j] = xr[64 * j]; s += (v[j][0] * v[j][0] + v[j][1] * v[j][1]) + (v[j][2] * v[j][2] + v[j][3] * v[j][3]); }
        const float rstd = 1.0f / sqrtf(wave_sum(s) * (1.0f / DM) + 1e-6f);
#pragma unroll
        for (int j = 0; j < 4; ++j) { const f32x4 gg = *(const f32x4*)(g + 4 * (lane + 64 * j)); xr[64 * j] = v[j] * rstd * gg; }
    }
}

DI void ret_state_item(int item, const bf16_t* kzT, const bf16_t* vT, bf16_t* rsnap, int lane) {
    const int dvt = item & 15, dkt = (item >> 4) & 7, bh = item >> 7, bl = bh >> 2, h = bh & 3, r = lane & 31, hh = lane >> 5;
    const bf16_t* ap = kzT + (((size_t)(h * 8 + dkt) * (TH / 16) + bl * (SEQ / 16)) * 2 + hh) * 256 + r * 8;
    const bf16_t* bp = vT + (((size_t)(h * 16 + dvt) * (TH / 16) + bl * (SEQ / 16)) * 2 + hh) * 256 + r * 8;
    const float dec = exp2f((float)RCH * log2gamma(h));
    f32x16 acc;
#pragma unroll
    for (int i = 0; i < 16; ++i) acc[i] = 0.f;
    for (int n = 0; n < NRCH; ++n) {
        bf16_t* sp = rsnap + (size_t)(bh * NRCH + n) * (512 * 256) + (size_t)(dvt * 16 + 2 * dkt) * 512 + r * 8 + 4 * hh;
#pragma unroll
        for (int g = 0; g < 4; ++g) { u32x2 w; w.x = pk2(acc[4 * g], acc[4 * g + 1]); w.y = pk2(acc[4 * g + 2], acc[4 * g + 3]); *(u32x2*)(sp + (g >> 1) * 512 + (g & 1) * 256) = w; }
        if (n == NRCH - 1) break;
#pragma unroll
        for (int i = 0; i < 16; ++i) acc[i] *= dec;
        const bf16_t* a = ap + (size_t)n * (RCH / 16) * 512; const bf16_t* b = bp + (size_t)n * (RCH / 16) * 512;
#pragma unroll 8
        for (int ks = 0; ks < RCH / 16; ++ks) acc = MFMA32(*(const bf16x8*)(a + ks * 512), *(const bf16x8*)(b + ks * 512), acc);
    }
}

DI void sb_item(int item, const bf16_t* sq, const bf16_t* sk, const bf16_t* svT, bf16_t* ysb, int lane) {
    const int qt = 127 - (item & 127), h = (item >> 7) & 15, bl = item >> 11, r = lane & 31, hh = lane >> 5;
    const size_t rowbase = (size_t)bl * SEQ; const int tq = qt * 32 + r;
    const int rt0 = (int)(rowbase >> 5);
    const bf16_t* qp = sq + (((size_t)(rt0 + qt) * 64 + h * 4) * 2 + hh) * 256 + r * 8;
    bf16x8 qf[4];
#pragma unroll
    for (int ks = 0; ks < 4; ++ks) qf[ks] = *(const bf16x8*)(qp + ks * 512);
    f32x16 o0, o1;
#pragma unroll
    for (int i = 0; i < 16; ++i) { o0[i] = 0.f; o1[i] = 0.f; }
    float carry = 0.f;
    for (int j = qt; j >= 0; --j) {
        const bf16_t* kp = sk + (((size_t)(rt0 + j) * 64 + h * 4) * 2 + hh) * 256 + r * 8;
        f32x16 st;
#pragma unroll
        for (int i = 0; i < 16; ++i) st[i] = 0.f;
#pragma unroll
        for (int ks = 0; ks < 4; ++ks) st = MFMA32(*(const bf16x8*)(kp + ks * 512), qf[ks], st);
        float lp[16], aw[16], gs[4], pg[4];
#pragma unroll
        for (int i = 0; i < 16; ++i) { const int key = j * 32 + crow(i, hh); const float z = st[i];
            const float spv = fmaxf(z, 0.f) + __logf(1.0f + __expf(-fabsf(z)));
            lp[i] = key < tq ? -spv : 0.f; }
#pragma unroll
        for (int g = 0; g < 4; ++g) { gs[g] = (lp[4 * g] + lp[4 * g + 1]) + (lp[4 * g + 2] + lp[4 * g + 3]); pg[g] = __shfl_xor(gs[g], 32); }
        float after = carry;
#pragma unroll
        for (int g = 3; g >= 0; --g) {
            float run = after + (hh == 0 ? pg[g] : 0.f);
#pragma unroll
            for (int e = 3; e >= 0; --e) { const int i = 4 * g + e; const int key = j * 32 + crow(i, hh);
                aw[i] = key < tq ? __expf(st[i] + lp[i] + run) : 0.f; run += lp[i]; }
            after += gs[g] + pg[g];
        }
        carry = after;
#pragma unroll
        for (int s = 0; s < 2; ++s) {
            u32x4 bw; bw.x = pk2(aw[8 * s], aw[8 * s + 1]); bw.y = pk2(aw[8 * s + 2], aw[8 * s + 3]); bw.z = pk2(aw[8 * s + 4], aw[8 * s + 5]); bw.w = pk2(aw[8 * s + 6], aw[8 * s + 7]);
            const bf16x8 bp = __builtin_bit_cast(bf16x8, bw);
            const bf16_t* vp = svT + (((size_t)(h * 2) * (TH / 16) + (rowbase >> 4) + 2 * j + s) * 2 + hh) * 256 + r * 8;
            o0 = MFMA32(*(const bf16x8*)vp, bp, o0);
            o1 = MFMA32(*(const bf16x8*)(vp + (size_t)(TH / 16) * 512), bp, o1);
        }
        if (__all(carry < SB_STOP)) break;
    }
    bf16_t* op = ysb + (rowbase + tq) * 1024 + h * 64 + 4 * hh;
#pragma unroll
    for (int g = 0; g < 4; ++g) {
        u32x2 w; w.x = pk2(o0[4 * g], o0[4 * g + 1]); w.y = pk2(o0[4 * g + 2], o0[4 * g + 3]); *(u32x2*)(op + 8 * g) = w;
        u32x2 w1; w1.x = pk2(o1[4 * g], o1[4 * g + 1]); w1.y = pk2(o1[4 * g + 2], o1[4 * g + 3]); *(u32x2*)(op + 32 + 8 * g) = w1;
    }
}

DI void ret_out_item(int item, const bf16_t* qr, const bf16_t* kn, const bf16_t* vT, const bf16_t* rsnap, bf16_t* yret, LAS unsigned char* lds, int wave, int lane) {
    const int bh = item >> 5, tg = 31 - (item & 31), bl = bh >> 2, h = bh & 3, r = lane & 31, hh = lane >> 5;
    const int n = tg >> 2, a = (tg & 3) * 4, tokg = tg * 128;
    const size_t rowbase = (size_t)bl * SEQ; const int rt0 = (int)(rowbase >> 5);
    const float l2g = log2gamma(h);
    LAS float* stats = (LAS float*)(lds + 131072 + 256);
    {
        const int tt = wave & 3, par = wave >> 2, tq = tokg + tt * 32 + r;
        const bf16_t* qp = qr + (((size_t)(rt0 + (tokg >> 5) + tt) * 64 + h * 16) * 2 + hh) * 256 + r * 8;
        bf16x8 qf[16];
#pragma unroll
        for (int ks = 0; ks < 16; ++ks) qf[ks] = *(const bf16x8*)(qp + ks * 512);
        for (int jk = par; jk <= a + tt; jk += 2) {
            const int keyt = n * 16 + jk;
            const bf16_t* kp = kn + (((size_t)(rt0 + keyt) * 64 + h * 16) * 2 + hh) * 256 + r * 8;
            f32x16 st;
#pragma unroll
            for (int i = 0; i < 16; ++i) st[i] = 0.f;
#pragma unroll
            for (int ks = 0; ks < 16; ++ks) st = MFMA32(*(const bf16x8*)(kp + ks * 512), qf[ks], st);
            float pw[16];
#pragma unroll
            for (int i = 0; i < 16; ++i) { const int d = tq - (keyt * 32 + crow(i, hh)); pw[i] = d >= 0 ? st[i] * __builtin_amdgcn_exp2f((float)d * l2g) : 0.f; }
#pragma unroll
            for (int s = 0; s < 2; ++s) {
                u32x4 bw; bw.x = pk2(pw[8 * s], pw[8 * s + 1]); bw.y = pk2(pw[8 * s + 2], pw[8 * s + 3]); bw.z = pk2(pw[8 * s + 4], pw[8 * s + 5]); bw.w = pk2(pw[8 * s + 6], pw[8 * s + 7]);
                *(LAS u32x4*)(lds + ((2 * jk + s) * 4 + tt) * 1024 + lane * 16) = bw;
            }
        }
    }
    __syncthreads();
    f32x16 acc[8];
#pragma unroll
    for (int q = 0; q < 8; ++q)
#pragma unroll
        for (int i = 0; i < 16; ++i) acc[q][i] = 0.f;
    {
        const bf16_t* rp = rsnap + (size_t)(bh * NRCH + n) * (512 * 256) + (size_t)(wave * 2 * 16) * 512 + hh * 256 + r * 8;
        const bf16_t* qg = qr + (((size_t)(rt0 + (tokg >> 5)) * 64 + h * 16) * 2 + hh) * 256 + r * 8;
#pragma unroll 2
        for (int ks = 0; ks < 16; ++ks) {
            const bf16x8 a0 = *(const bf16x8*)(rp + ks * 512), a1 = *(const bf16x8*)(rp + (16 + ks) * 512);
#pragma unroll
            for (int tt = 0; tt < 4; ++tt) { const bf16x8 b = *(const bf16x8*)(qg + (size_t)(tt * 64 + ks) * 512);
                acc[tt] = MFMA32(a0, b, acc[tt]); acc[4 + tt] = MFMA32(a1, b, acc[4 + tt]); }
        }
#pragma unroll
        for (int tt = 0; tt < 4; ++tt) { const float xi = __builtin_amdgcn_exp2f((float)(((tokg + tt * 32 + r) & (RCH - 1)) + 1) * l2g);
#pragma unroll
            for (int i = 0; i < 16; ++i) { acc[tt][i] *= xi; acc[4 + tt][i] *= xi; } }
    }
    {
        const bf16_t* vb = vT + (((size_t)(h * 16 + wave * 2) * (TH / 16) + (rowbase >> 4) + n * 32) * 2 + hh) * 256 + r * 8;
        const int ns = 2 * (a + 4);
#pragma unroll 2
        for (int s = 0; s < ns; ++s) {
            const bf16x8 a0 = *(const bf16x8*)(vb + (size_t)s * 512), a1 = *(const bf16x8*)(vb + (size_t)(TH / 16 + s) * 512);
            const int ttmin = (s >> 1) - a;
#pragma unroll
            for (int tt = 0; tt < 4; ++tt) if (tt >= ttmin) { const bf16x8 b = *(const LAS bf16x8*)(lds + (s * 4 + tt) * 1024 + lane * 16);
                acc[tt] = MFMA32(a0, b, acc[tt]); acc[4 + tt] = MFMA32(a1, b, acc[4 + tt]); }
        }
    }
#pragma unroll
    for (int tt = 0; tt < 4; ++tt) {
        float s1 = 0.f, s2 = 0.f;
#pragma unroll
        for (int i = 0; i < 16; ++i) { const float v0 = acc[tt][i], v1 = acc[4 + tt][i]; s1 += v0 + v1; s2 += v0 * v0 + v1 * v1; }
        s1 += __shfl_xor(s1, 32); s2 += __shfl_xor(s2, 32);
        if (hh == 0) { stats[(wave * 128 + tt * 32 + r) * 2] = s1; stats[(wave * 128 + tt * 32 + r) * 2 + 1] = s2; }
    }
    __syncthreads();
#pragma unroll
    for (int tt = 0; tt < 4; ++tt) {
        float s1 = 0.f, s2 = 0.f;
#pragma unroll
        for (int w = 0; w < 8; ++w) { s1 += stats[(w * 128 + tt * 32 + r) * 2]; s2 += stats[(w * 128 + tt * 32 + r) * 2 + 1]; }
        const float mu = s1 * (1.0f / 512.0f), var = fmaxf(s2 * (1.0f / 512.0f) - mu * mu, 0.f), rstd = 1.0f / sqrtf(var + 1e-5f);
        bf16_t* op = yret + (rowbase + tokg + tt * 32 + r) * 2048 + h * 512 + wave * 64 + 4 * hh;
#pragma unroll
        for (int dvt = 0; dvt < 2; ++dvt)
#pragma unroll
            for (int g = 0; g < 4; ++g) {
                u32x2* pp = (u32x2*)(op + dvt * 32 + 8 * g); const u32x2 gv = *pp; const f32x16& o = acc[dvt * 4 + tt];
                u32x2 w; w.x = pk2(bflo(gv.x) * (o[4 * g] - mu) * rstd, bfhi(gv.x) * (o[4 * g + 1] - mu) * rstd);
                w.y = pk2(bflo(gv.y) * (o[4 * g + 2] - mu) * rstd, bfhi(gv.y) * (o[4 * g + 3] - mu) * rstd); *pp = w;
            }
    }
    __syncthreads();
}

#define XB_TMO      128
#define XB_XCNT(j)  (256  + 64 * (j))
#define XB_XSUB(j)  (1280 + 64 * (j))
#define XB_XGEN(j)  (2304 + 64 * (j))
#define XB_TOP      3328
#define XB_TOPGEN   3392
#define XCD_BAR_WORDS 3456
#define XB_SPIN_CAP (1u << 18)

__device__ __forceinline__ unsigned xb_ld(unsigned* p)              { return __hip_atomic_load(p, __ATOMIC_RELAXED, __HIP_MEMORY_SCOPE_AGENT); }
__device__ __forceinline__ unsigned xb_add(unsigned* p, unsigned v) { return __hip_atomic_fetch_add(p, v, __ATOMIC_RELAXED, __HIP_MEMORY_SCOPE_AGENT); }
__device__ __forceinline__ unsigned xb_xcc_id() { return (unsigned)__builtin_amdgcn_s_getreg((3 << 11) | 20) & 0xFu; }
#define XB_SPIN(cond, bar) do { unsigned _sp = 0; while (cond) { __builtin_amdgcn_s_sleep(1); \
    if ((++_sp & 255u) == 0u) { if (xb_ld(&(bar)[XB_TMO])) break; if (_sp > XB_SPIN_CAP) { atomicAdd(&(bar)[XB_TMO], 1u); break; } } } } while (0)

struct XcdBarrier {
    unsigned* bar; unsigned x;
    volatile LAS unsigned* st;
};

__device__ __forceinline__ XcdBarrier xcd_barrier_post(unsigned* bar, volatile LAS unsigned* st) {
    XcdBarrier b; b.bar = bar; b.x = xb_xcc_id(); b.st = st;
    if (threadIdx.x == 0) (void)xb_add(&bar[XB_XCNT(b.x)], 1u);
    return b;
}
__device__ __forceinline__ void xcd_barrier_complete(unsigned* bar, unsigned x, unsigned& nloc, unsigned& nx) {
    const unsigned G = gridDim.x * gridDim.y * gridDim.z;
    unsigned sum, cnt, mine, sp = 0u;
    for (;;) {
        sum = 0u; cnt = 0u; mine = 0u;
#pragma unroll
        for (unsigned j = 0; j < 16; ++j) { const unsigned c = xb_ld(&bar[XB_XCNT(j)]); sum += c; cnt += (c > 0u) ? 1u : 0u; mine = (j == x) ? c : mine; }
        if (sum == G) break;
        __builtin_amdgcn_s_sleep(1);
        if ((++sp & 255u) == 0u) { if (xb_ld(&bar[XB_TMO])) break; if (sp > XB_SPIN_CAP) { atomicAdd(&bar[XB_TMO], 1u); break; } }
    }
    nloc = mine > 0u ? mine : 1u; nx = cnt > 0u ? cnt : 1u;
}

__device__ __forceinline__ void xcd_barrier(const XcdBarrier& b) {
    asm volatile("s_waitcnt vmcnt(0)" ::: "memory");
    __syncthreads();
    if (threadIdx.x == 0) {
        unsigned* bar = b.bar;
        __builtin_amdgcn_s_waitcnt(0);
        unsigned nloc = b.st[0], nx = b.st[1];
        if (nloc == 0u) { xcd_barrier_complete(bar, b.x, nloc, nx); b.st[0] = nloc; b.st[1] = nx; }
        const unsigned old = xb_add(&bar[XB_XSUB(b.x)], 1u);
        const unsigned gen = old / nloc;
        if (old + 1u == (gen + 1u) * nloc) {
            __builtin_amdgcn_fence(__ATOMIC_RELEASE, "agent");
            asm volatile("s_waitcnt vmcnt(0)" ::: "memory");
            const unsigned og = xb_add(&bar[XB_TOP], 1u);
            const unsigned tg = og / nx;
            if (og + 1u == (tg + 1u) * nx) xb_add(&bar[XB_TOPGEN], 1u);
            else XB_SPIN(xb_ld(&bar[XB_TOPGEN]) == tg, bar);
            __builtin_amdgcn_fence(__ATOMIC_ACQUIRE, "agent");
            xb_add(&bar[XB_XGEN(b.x)], 1u);
            asm volatile("s_waitcnt vmcnt(0)" ::: "memory");
        } else {
            XB_SPIN(xb_ld(&bar[XB_XGEN(b.x)]) == gen, bar);
            __builtin_amdgcn_fence(__ATOMIC_ACQUIRE, "agent");
            asm volatile("s_waitcnt vmcnt(0)" ::: "memory");
        }
    }
    __syncthreads();
}

__global__ void __launch_bounds__(512, 2) hybrid_fwd(Params p) {
    extern __shared__ __attribute__((aligned(16))) unsigned char lds_raw[];
    cg::grid_group grid = cg::this_grid();
    PG8_LAS unsigned char* lds = (PG8_LAS unsigned char*)lds_raw;
    LAS float* ldsf = (LAS float*)lds_raw;
#if PROBE_CLASS >= 0
    unsigned long long tacc = 0, tst = 0;
#define TSTART() (tst = __builtin_amdgcn_s_memrealtime())
#define TSTOP(c) do { if ((c) == PROBE_CLASS) tacc += __builtin_amdgcn_s_memrealtime() - tst; } while (0)
#else
#define TSTART() ((void)0)
#define TSTOP(c) ((void)0)
#endif
    volatile LAS unsigned* xst = (volatile LAS unsigned*)(lds_raw + 131072 + 64);
    if (threadIdx.x < 2) xst[threadIdx.x] = 0u;
    __syncthreads();
    const XcdBarrier xbar = xcd_barrier_post((unsigned*)(p.ws + WS_BAR), xst);
#define GBAR() xcd_barrier(xbar)
#if PROBE_CLASS == 9
#define GSYNC() do { GBAR(); TSTART(); GBAR(); TSTOP(9); } while (0)
#else
#define GSYNC() do { TSTART(); GBAR(); TSTOP(0); } while (0)
#endif
#define PH_BEGIN int tid = threadIdx.x; asm volatile("" : "+v"(tid)); int bx = blockIdx.x, G = gridDim.x; asm volatile("" : "+s"(bx), "+s"(G)); \
    unsigned char* ws = p.ws; asm volatile("" : "+s"(ws)); float* xo = p.out; asm volatile("" : "+s"(xo)); \
    const int lane = tid & 63, wave = __builtin_amdgcn_readfirstlane(tid >> 6), gw = bx * 8 + wave, ngw = G * 8; (void)lane; (void)wave; (void)gw; (void)ngw; \
    const float* modl = (const float*)(ws + WS_MOD) + (size_t)l * 4 * NMOD; (void)modl; bf16_t* H = (bf16_t*)(ws + WS_H); (void)H;
#pragma unroll 1
    for (int l = 0; l < 2; ++l) {
        TSTART(); { PH_BEGIN
          if (l == 0) { tables_and_mod(p, ldsf, tid); __syncthreads(); }
          convert_weights(p, l, ldsf, tid); } TSTOP(4);
        if (l == 0) grid.sync();
        TSTART(); { PH_BEGIN
          norm_phase(l == 0 ? p.x : xo, p.norm_mix_g + l * DM, modl, 0, 1, H, gw, ngw, lane); } TSTOP(5);
        GSYNC();
#pragma unroll 1
        for (int half = 0; half < 2; ++half) {
            TSTART(); { PH_BEGIN
              pg8::Gemm g{H + (size_t)half * TH * DM, (const bf16_t*)(ws + WS_WINA), TH, 6144, DM}; pg8::StaticOrder S; S.init(TH, 6144, G, bx);
              EpiInA E{(bf16_t*)(ws + WS_X), (bf16_t*)(ws + WS_YRET) + (size_t)half * TH * 2048, (const float*)(ws + WS_COSP), (const float*)(ws + WS_SINP)};
              pg8::gemm_phase<EpiInA, pg8::StaticOrder, true, true>(lds, g, S, E); } TSTOP(1);
            TSTART(); { PH_BEGIN
              pg8::Gemm g{(const bf16_t*)(ws + WS_WINB), H + (size_t)half * TH * DM, 4096, TH, DM}; pg8::StaticOrder S; S.init(4096, TH, G, bx);
              EpiInB E{(bf16_t*)(ws + WS_KZT), (const float*)(ws + WS_COST), (const float*)(ws + WS_SINT)};
              pg8::gemm_phase<EpiInB, pg8::StaticOrder, true, true>(lds, g, S, E); } TSTOP(1);
            GSYNC();
            TSTART(); { PH_BEGIN
              for (int s = gw; s < 2048; s += ngw) if (!(s & 1)) ret_state_item(s >> 1, (const bf16_t*)(ws + WS_KZT), (const bf16_t*)(ws + WS_VT), (bf16_t*)(ws + WS_RSNAP), lane); } TSTOP(2);
            TSTART(); { PH_BEGIN
              for (int it = gw; it < 4096; it += ngw) sb_item(it, (const bf16_t*)(ws + WS_SQ), (const bf16_t*)(ws + WS_SK), (const bf16_t*)(ws + WS_SVT), (bf16_t*)(ws + WS_YSB) + (size_t)half * TH * 1024, lane); } TSTOP(6);
            GSYNC();
            TSTART(); { PH_BEGIN
              for (int it = bx; it < 256; it += G) ret_out_item(it, (const bf16_t*)(ws + WS_QR), (const bf16_t*)(ws + WS_KN), (const bf16_t*)(ws + WS_VT), (const bf16_t*)(ws + WS_RSNAP), (bf16_t*)(ws + WS_YRET) + (size_t)half * TH * 2048, (LAS unsigned char*)lds_raw, wave, lane); } TSTOP(3);
            GSYNC();
        }
        TSTART(); { PH_BEGIN pg8::StaticOrder S; S.init(T, DM, G, bx);
          pg8::Gemm g{H, (const bf16_t*)(ws + WS_WG), T, DM, DM}; EpiEw<0> E{(bf16_t*)(ws + WS_MERGED), nullptr, DM}; pg8::gemm_phase<EpiEw<0>, pg8::StaticOrder, false, true>(lds, g, S, E); } TSTOP(7);
        TSTART(); { PH_BEGIN pg8::StaticOrder S; S.init(T, DM, G, bx);
          pg8::Gemm g{(const bf16_t*)(ws + WS_YRET), (const bf16_t*)(ws + WS_WRET), T, DM, 2048}; EpiEw<2> E{(bf16_t*)(ws + WS_MERGED), nullptr, DM}; pg8::gemm_phase<EpiEw<2>, pg8::StaticOrder, false, true>(lds, g, S, E); } TSTOP(7);
        TSTART(); { PH_BEGIN pg8::StaticOrder S; S.init(T, DM, G, bx);
          pg8::Gemm g{H, (const bf16_t*)(ws + WS_WG) + (size_t)1024 * 1024, T, DM, DM}; EpiEw<0> E{(bf16_t*)(ws + WS_TMP), nullptr, DM}; pg8::gemm_phase<EpiEw<0>, pg8::StaticOrder, false, true>(lds, g, S, E); } TSTOP(7);
        TSTART(); { PH_BEGIN pg8::StaticOrder S; S.init(T, DM, G, bx);
          pg8::Gemm g{(const bf16_t*)(ws + WS_YSB), (const bf16_t*)(ws + WS_WSB), T, DM, DM}; EpiEw<3> E{(bf16_t*)(ws + WS_MERGED), (const bf16_t*)(ws + WS_TMP), DM}; pg8::gemm_phase<EpiEw<3>, pg8::StaticOrder, false, true>(lds, g, S, E); } TSTOP(7);
        GSYNC();
        TSTART(); { PH_BEGIN pg8::StaticOrder S; S.init(T, DM, G, bx);
          pg8::Gemm g{(const bf16_t*)(ws + WS_MERGED), (const bf16_t*)(ws + WS_WMIX), T, DM, DM}; EpiRes E{l == 0 ? p.x : xo, xo, modl + 2 * 1024};
          pg8::gemm_phase<EpiRes, pg8::StaticOrder, false, true>(lds, g, S, E); } TSTOP(7);
        GSYNC();
        TSTART(); { PH_BEGIN
          norm_phase(xo, p.norm_mlp_g + l * DM, modl, 3, 4, H, gw, ngw, lane); } TSTOP(5);
        GSYNC();
        TSTART(); { PH_BEGIN pg8::StaticOrder S; S.init(T, FF, G, bx);
          pg8::Gemm g{H, (const bf16_t*)(ws + WS_WUP), T, FF, DM}; EpiEw<1> E{(bf16_t*)(ws + WS_U), nullptr, FF};
          pg8::gemm_phase<EpiEw<1>, pg8::StaticOrder, true, true>(lds, g, S, E); } TSTOP(8);
        GSYNC();
        TSTART(); { PH_BEGIN pg8::StaticOrder S; S.init(T, DM, G, bx);
          pg8::Gemm g{(const bf16_t*)(ws + WS_U), (const bf16_t*)(ws + WS_WDN), T, DM, FF}; EpiRes E{xo, xo, modl + 5 * 1024};
          pg8::gemm_phase<EpiRes, pg8::StaticOrder, false, true>(lds, g, S, E); } TSTOP(8);
        GSYNC();
    }
    TSTART(); { const int l = 0; PH_BEGIN
      final_norm_phase(xo, p.final_g, gw, ngw, lane); } TSTOP(5);
#if PROBE_CLASS >= 0
    grid.sync();
    if (blockIdx.x == 0) { const unsigned kk = (unsigned)(tacc * 4ull / 25ull);
        for (unsigned i = threadIdx.x; i < kk; i += 512) p.out[i] += 0.1f; }
#endif
#undef PH_BEGIN
}

extern "C" void kernel_launch(void* const* d_in, const int* in_sizes, int n_in, void* d_out, int out_size, void* d_ws, size_t ws_size, hipStream_t stream) {
    static int grid_blocks = 0;
    if (grid_blocks == 0) {
        if (n_in != 13 || out_size != T * DM || ws_size < WS_END) { fprintf(stderr, "kernel_launch: unexpected shapes (n_in %d out %d ws %zu need %zu)\n", n_in, out_size, ws_size, (size_t)WS_END); grid_blocks = -1; return; }
        int dev = 0, cus = 0, per_cu = 0;
        (void)hipGetDevice(&dev); (void)hipDeviceGetAttribute(&cus, hipDeviceAttributeMultiprocessorCount, dev);
        if (hipFuncSetAttribute((const void*)hybrid_fwd, hipFuncAttributeMaxDynamicSharedMemorySize, LDS_BYTES) != hipSuccess) { fprintf(stderr, "kernel_launch: hipFuncSetAttribute failed\n"); grid_blocks = -1; return; }
        if (hipOccupancyMaxActiveBlocksPerMultiprocessor(&per_cu, (const void*)hybrid_fwd, 512, LDS_BYTES) != hipSuccess || per_cu < 1) { fprintf(stderr, "kernel_launch: occupancy query gave %d\n", per_cu); per_cu = 1; (void)hipGetLastError(); }
        grid_blocks = cus * per_cu;
    }
    if (grid_blocks < 0) return;
    Params p{};
    p.x = (const float*)d_in[0]; p.c = (const float*)d_in[1]; p.norm_mix_g = (const float*)d_in[2]; p.w_in = (const float*)d_in[3]; p.w_ret_out = (const float*)d_in[4];
    p.w_sb_out = (const float*)d_in[5]; p.w_mix_out = (const float*)d_in[6]; p.norm_mlp_g = (const float*)d_in[7]; p.w_up = (const float*)d_in[8]; p.w_down = (const float*)d_in[9];
    p.w_ada = (const float*)d_in[10]; p.b_ada = (const float*)d_in[11]; p.final_g = (const float*)d_in[12];
    p.out = (float*)d_out; p.ws = (unsigned char*)d_ws;
    if (hipMemsetAsync((char*)d_ws + WS_BAR, 0, XCD_BAR_WORDS * 4, stream) != hipSuccess) { fprintf(stderr, "kernel_launch: memset failed\n"); return; }
    void* args[] = {&p};
    hipError_t e = hipLaunchCooperativeKernel((const void*)hybrid_fwd, dim3(grid_blocks), dim3(512), args, LDS_BYTES, stream);
    if (e != hipSuccess) fprintf(stderr, "kernel_launch: cooperative launch failed: %s (grid %d)\n", hipGetErrorString(e), grid_blocks);
}
```

```cpp
#include <hip/hip_runtime.h>
#include <hip/hip_cooperative_groups.h>
#include <cstdio>
#include <cstdint>
namespace cg = cooperative_groups;
#define DI __device__ __forceinline__
#define PROBE_CLASS -1
#define PROBE_SITEMASK 0xFFFF
namespace pg8 {
#define PG8_LAS __attribute__((address_space(3)))
typedef unsigned short bf16_t;
typedef short bf16x8 __attribute__((ext_vector_type(8)));
typedef float f32x4 __attribute__((ext_vector_type(4)));
typedef unsigned u32x4 __attribute__((ext_vector_type(4)));
constexpr int BM = 256, BK = 64, HALF = 128, HTB = HALF * BK * 2  , STAGE_BYTES = 8 * HTB, NXCD = 8, WGM = 8;

__host__ __device__ __forceinline__ int lds_byte(int r, int c) { const int st = (r >> 4) * 2 + (c >> 5), rr = r & 15, cc = c & 31, ob = rr * 64 + cc * 2; return st * 1024 + (ob ^ (((ob >> 9) & 1) << 5)); }
__host__ __device__ __forceinline__ void stage_rc(int b, int& R, int& C) { const int st = b / 1024, sb = b % 1024, swz = sb ^ (((sb >> 9) & 1) << 5); R = (st >> 1) * 16 + swz / 64; C = (st & 1) * 32 + (swz % 64) / 2; }
__host__ __device__ __forceinline__ int perm32(int rho) { const int n = rho >> 4, i = rho & 15; return 8 * (i >> 2) + 4 * n + (i & 3); }

struct Unit { int pm, pn; };
struct Gemm { const bf16_t* A; const bf16_t* Bt; int M, N, K; };

struct StaticOrder {
    int nM, nN, nwg, G, c;
    __host__ __device__ void init(int M, int N, int G_, int c_) { nM = M / BM; nN = N / BM; nwg = nM * nN; G = G_; c = c_; }
    __host__ __device__ bool next(int i, Unit& u) const {
        const long L = (long)i * G + c; if (L >= nwg) return false;
        int wgid = (int)L; { const int q = nwg / NXCD, r = nwg % NXCD, xcd = wgid % NXCD, off = wgid / NXCD; wgid = (xcd < r ? xcd * (q + 1) : r * (q + 1) + (xcd - r) * q) + off; }
        const int nig = WGM * nN, gid = wgid / nig, fm = gid * WGM, gsz = (nM - fm) < WGM ? (nM - fm) : WGM;
        u.pm = fm + ((wgid % nig) % gsz); u.pn = (wgid % nig) / gsz; return true;
    }
    __device__ __forceinline__ void a_ready(const Unit&) const {}
    __device__ __forceinline__ void done(const Unit&) const {}
};

template <class Epi, class Sched, bool ALIGN_EPI = false, bool SP2 = false>
__device__ __forceinline__ void gemm_phase(PG8_LAS unsigned char* lds, const Gemm g, const Sched& S, const Epi& E) {
    int tid_l = threadIdx.x; asm volatile("" : "+v"(tid_l)); const int tid = tid_l, wid = __builtin_amdgcn_readfirstlane(tid >> 6), lane = tid & 63, wr = wid >> 2, wc = wid & 3, fr = lane & 15, fq = lane >> 4;
    const int K = g.K, nt = K / BK;
    unsigned voffA[2], voffB[2];
#pragma unroll
    for (int i = 0; i < 2; ++i) { int R, C; stage_rc(tid * 16 + i * 8192, R, C); const int Rb = Epi::PERM ? ((R & ~31) + perm32(R & 31)) : R;
        voffA[i] = (unsigned)(R * K + C) * 2u; voffB[i] = (unsigned)(Rb * K + C) * 2u; }
    const size_t kstep = (size_t)(BK * 2);
    const size_t hstep = (size_t)HALF * K * 2;
    const size_t tstep = 2 * hstep;
    const unsigned ldsw = (unsigned)wid * 1024u;
    const int aoff = lds_byte(wr * 64 + fr, fq * 8), boff = lds_byte(wc * 32 + fr, fq * 8);
#define PG8_SA(b, h) (((b) * 2 + (h)) * HTB)
#define PG8_SB(b, h) ((4 + (b) * 2 + (h)) * HTB)
#define PG8_STAGE(bufoff, gbase, voff) do { _Pragma("unroll") for (int _i = 0; _i < 2; ++_i) \
        __builtin_amdgcn_global_load_lds((const unsigned*)((const char*)(gbase) + (voff)[_i]), (PG8_LAS unsigned*)(lds + (bufoff) + ldsw + _i * 8192), 16, 0, 0); } while (0)
#define PG8_LDA(dst, b, h) do { _Pragma("unroll") for (int m = 0; m < 4; ++m) _Pragma("unroll") for (int k = 0; k < 2; ++k) dst[m][k] = *(const PG8_LAS bf16x8*)(lds + PG8_SA(b, h) + aoff + m * 2048 + k * 1024); } while (0)
#define PG8_LDB(dst, b, h) do { _Pragma("unroll") for (int n = 0; n < 2; ++n) _Pragma("unroll") for (int k = 0; k < 2; ++k) dst[n][k] = *(const PG8_LAS bf16x8*)(lds + PG8_SB(b, h) + boff + n * 2048 + k * 1024); } while (0)
#define PG8_MMA(ai, bj, At, Bt) do { __builtin_amdgcn_s_setprio(1); _Pragma("unroll") for (int m = 0; m < 4; ++m) _Pragma("unroll") for (int n = 0; n < 2; ++n) _Pragma("unroll") for (int k = 0; k < 2; ++k) \
        acc[ai][bj][m][n] = __builtin_amdgcn_mfma_f32_16x16x32_bf16(Bt[n][k], At[m][k], acc[ai][bj][m][n], 0, 0, 0); __builtin_amdgcn_s_setprio(0); } while (0)
#define PG8_WAIT_V(n) asm volatile("s_waitcnt vmcnt(" #n ")" ::: "memory")
#define PG8_WAIT_L(n) asm volatile("s_waitcnt lgkmcnt(" #n ")" ::: "memory")
#define PG8_BAR __builtin_amdgcn_s_barrier()
#define PG8_SCHED __builtin_amdgcn_sched_barrier(0)
    Unit cur, nxt; int ui = 0;
    if (!S.next(0, cur)) return;
    f32x4 acc[2][2][4][2];
#pragma unroll
    for (int a = 0; a < 2; ++a)
#pragma unroll
        for (int b = 0; b < 2; ++b)
#pragma unroll
            for (int m = 0; m < 4; ++m)
#pragma unroll
                for (int n = 0; n < 2; ++n) acc[a][b][m][n] = (f32x4){0.f, 0.f, 0.f, 0.f};
    bf16x8 At[4][2], B0[2][2], B1[2][2];
    const char* cA = (const char*)g.A + (size_t)cur.pm * tstep; const char* cB = (const char*)g.Bt + (size_t)cur.pn * tstep;
    S.a_ready(cur);
    if constexpr (SP2) {
        PG8_STAGE(PG8_SB(0, 0), cB, voffB); PG8_STAGE(PG8_SB(0, 1), cB + hstep, voffB); PG8_STAGE(PG8_SA(0, 0), cA, voffA); PG8_STAGE(PG8_SA(0, 1), cA + hstep, voffA);
        if (wr == 1) PG8_BAR;
        PG8_WAIT_V(2); PG8_BAR;
        PG8_STAGE(PG8_SB(1, 0), cB + kstep, voffB); PG8_STAGE(PG8_SA(1, 0), cA + kstep, voffA); PG8_STAGE(PG8_SB(1, 1), cB + hstep + kstep, voffB);
        PG8_WAIT_V(6); PG8_BAR;
    } else {
        PG8_STAGE(PG8_SB(0, 0), cB, voffB); PG8_STAGE(PG8_SA(0, 0), cA, voffA); PG8_STAGE(PG8_SB(0, 1), cB + hstep, voffB); PG8_STAGE(PG8_SA(0, 1), cA + hstep, voffA);
        if (wr == 1) PG8_BAR;
        PG8_WAIT_V(4); PG8_BAR;
        PG8_STAGE(PG8_SB(1, 0), cB + kstep, voffB); PG8_STAGE(PG8_SA(1, 0), cA + kstep, voffA); PG8_STAGE(PG8_SB(1, 1), cB + hstep + kstep, voffB);
        PG8_WAIT_V(6); PG8_BAR;
    }
    for (;;) {
        const bool has_next = S.next(ui + 1, nxt);
        const char* nA = has_next ? (const char*)g.A + (size_t)nxt.pm * tstep : cA; const char* nB = has_next ? (const char*)g.Bt + (size_t)nxt.pn * tstep : cB;
        for (int t = 0; t < nt; t += 2) {
            const bool last = (t == nt - 2);
            const char* a1 = cA + (size_t)(t + 1) * kstep;
            const char* a2 = last ? nA : cA + (size_t)(t + 2) * kstep; const char* b2 = last ? nB : cB + (size_t)(t + 2) * kstep;
            const char* a3 = a2 + kstep; const char* b3 = b2 + kstep;
            if (last && has_next) S.a_ready(nxt);
            if constexpr (SP2) {
            PG8_LDB(B0, 0, 0); PG8_LDB(B1, 0, 1); PG8_SCHED; PG8_LDA(At, 0, 0); PG8_STAGE(PG8_SA(1, 1), a1 + hstep, voffA);
            PG8_WAIT_V(8); PG8_WAIT_L(0); PG8_BAR; PG8_MMA(0, 0, At, B0); PG8_MMA(0, 1, At, B1); PG8_BAR; PG8_SCHED;
            PG8_LDA(At, 0, 1); PG8_STAGE(PG8_SB(0, 0), b2, voffB); PG8_STAGE(PG8_SB(0, 1), b2 + hstep, voffB); PG8_STAGE(PG8_SA(0, 0), a2, voffA);
            PG8_WAIT_V(8); PG8_WAIT_L(0); PG8_BAR; PG8_MMA(1, 0, At, B0); PG8_MMA(1, 1, At, B1); PG8_BAR; PG8_SCHED;
            PG8_LDB(B0, 1, 0); PG8_LDB(B1, 1, 1); PG8_SCHED; PG8_LDA(At, 1, 0); PG8_STAGE(PG8_SA(0, 1), a2 + hstep, voffA);
            PG8_WAIT_V(8); PG8_WAIT_L(0); PG8_BAR; PG8_MMA(0, 0, At, B0); PG8_MMA(0, 1, At, B1); PG8_BAR; PG8_SCHED;
            PG8_LDA(At, 1, 1); PG8_STAGE(PG8_SB(1, 0), b3, voffB); PG8_STAGE(PG8_SB(1, 1), b3 + hstep, voffB); PG8_STAGE(PG8_SA(1, 0), a3, voffA);
            PG8_WAIT_V(8); PG8_WAIT_L(0); PG8_BAR; PG8_MMA(1, 0, At, B0); PG8_MMA(1, 1, At, B1); PG8_BAR; PG8_SCHED;
            } else {
            PG8_LDB(B0, 0, 0); PG8_SCHED; PG8_LDA(At, 0, 0); PG8_STAGE(PG8_SA(1, 1), a1 + hstep, voffA);
            PG8_WAIT_L(8); PG8_BAR; PG8_WAIT_L(0); PG8_MMA(0, 0, At, B0); PG8_BAR; PG8_SCHED;
            PG8_LDB(B1, 0, 1); PG8_STAGE(PG8_SB(0, 0), b2, voffB);
            PG8_BAR; PG8_WAIT_L(0); PG8_MMA(0, 1, At, B1); PG8_BAR;
            PG8_LDA(At, 0, 1); PG8_STAGE(PG8_SA(0, 0), a2, voffA);
            PG8_BAR; PG8_WAIT_L(0); PG8_MMA(1, 0, At, B0); PG8_BAR; PG8_SCHED;
            PG8_STAGE(PG8_SB(0, 1), b2 + hstep, voffB);
            PG8_WAIT_V(6); PG8_BAR; PG8_MMA(1, 1, At, B1); PG8_BAR;
            PG8_LDB(B0, 1, 0); PG8_SCHED; PG8_LDA(At, 1, 0); PG8_STAGE(PG8_SA(0, 1), a2 + hstep, voffA);
            PG8_WAIT_L(8); PG8_BAR; PG8_WAIT_L(0); PG8_MMA(0, 0, At, B0); PG8_BAR; PG8_SCHED;
            PG8_LDB(B1, 1, 1); PG8_STAGE(PG8_SB(1, 0), b3, voffB);
            PG8_BAR; PG8_WAIT_L(0); PG8_MMA(0, 1, At, B1); PG8_BAR;
            PG8_LDA(At, 1, 1); PG8_STAGE(PG8_SA(1, 0), a3, voffA);
            PG8_BAR; PG8_WAIT_L(0); PG8_MMA(1, 0, At, B0); PG8_BAR; PG8_SCHED;
            PG8_STAGE(PG8_SB(1, 1), b3 + hstep, voffB);
            PG8_WAIT_V(6); PG8_BAR; PG8_MMA(1, 1, At, B1); PG8_BAR;
            }
        }
        if constexpr (ALIGN_EPI) { if (wr == 0) PG8_BAR; }
        if constexpr (!Epi::AFTER_DRAIN) { E(acc, cur, wr, wc, fr, fq); S.done(cur); }
        if (!has_next) break;
#pragma unroll
        for (int a = 0; a < 2; ++a)
#pragma unroll
            for (int b = 0; b < 2; ++b)
#pragma unroll
                for (int m = 0; m < 4; ++m)
#pragma unroll
                    for (int n = 0; n < 2; ++n) acc[a][b][m][n] = (f32x4){0.f, 0.f, 0.f, 0.f};
        cur = nxt; cA = nA; cB = nB; ++ui;
        if constexpr (ALIGN_EPI) { if (wr == 1) PG8_BAR; }
    }
    PG8_WAIT_V(0);
    if constexpr (!ALIGN_EPI) { if (wr == 0) PG8_BAR; }
    PG8_BAR;
    if constexpr (Epi::AFTER_DRAIN) { E.fused(acc, cur, wr, wc, fr, fq, lds, wid, lane); S.done(cur); }
#undef PG8_SA
#undef PG8_SB
#undef PG8_STAGE
#undef PG8_LDA
#undef PG8_LDB
#undef PG8_MMA
#undef PG8_WAIT_V
#undef PG8_WAIT_L
#undef PG8_BAR
#undef PG8_SCHED
}
}

using pg8::bf16_t; using pg8::bf16x8; using pg8::f32x4; using pg8::u32x4; using pg8::Unit;
typedef float f32x16 __attribute__((ext_vector_type(16)));
typedef float f32x2 __attribute__((ext_vector_type(2)));
typedef unsigned u32x2 __attribute__((ext_vector_type(2)));
typedef __bf16 bf16x2_t __attribute__((ext_vector_type(2)));
#define LAS __attribute__((address_space(3)))
#define MFMA32(a, b, c) __builtin_amdgcn_mfma_f32_32x32x16_bf16((a), (b), (c), 0, 0, 0)

constexpr int T = 16384, DM = 1024, SEQ = 4096, TH = 8192, FF = 4096, INW = 11264, NMOD = 6144;
constexpr int RCH = 512, NRCH = SEQ / RCH;
constexpr size_t MiB = 1u << 20;
constexpr size_t WS_BAR = 768 * 1024;
constexpr size_t WS_MOD = 0, WS_COSP = 1 * MiB, WS_SINP = 3 * MiB, WS_COST = 5 * MiB, WS_SINT = 7 * MiB, WS_H = 9 * MiB;
constexpr size_t WS_WINA = 41 * MiB, WS_WINB = 53 * MiB, WS_WG = 61 * MiB, WS_WRET = 65 * MiB, WS_WSB = 69 * MiB, WS_WMIX = 71 * MiB, WS_WUP = 73 * MiB, WS_WDN = 81 * MiB;
constexpr size_t WS_YRET = 89 * MiB, WS_YSB = 153 * MiB, WS_RSNAP = 185 * MiB, WS_X = 201 * MiB, WS_END = 329 * MiB;
constexpr size_t WS_QR = WS_X, WS_KN = WS_X + 16 * MiB, WS_SQ = WS_X + 32 * MiB, WS_SK = WS_X + 48 * MiB, WS_KZT = WS_X + 64 * MiB, WS_VT = WS_X + 80 * MiB, WS_SVT = WS_X + 112 * MiB;
static_assert(WS_KN == WS_QR + 16 * MiB && WS_SQ == WS_QR + 32 * MiB && WS_SK == WS_QR + 48 * MiB && WS_VT == WS_KZT + 16 * MiB && WS_SVT == WS_KZT + 48 * MiB, "epilogue pointer arithmetic");
constexpr size_t WS_MERGED = WS_X, WS_TMP = WS_X + 32 * MiB, WS_U = WS_X;
constexpr int LDS_BYTES = 147456;
constexpr unsigned NSTATE = 1024;
constexpr float SB_STOP = -40.0f * 1.44269504f;

DI unsigned pk2(float lo, float hi) { f32x2 v = {lo, hi}; bf16x2_t b = __builtin_convertvector(v, bf16x2_t); return __builtin_bit_cast(unsigned, b); }
DI float bflo(unsigned w) { return __uint_as_float(w << 16); }
DI float bfhi(unsigned w) { return __uint_as_float(w & 0xffff0000u); }
DI u32x4 pack8(f32x4 a, f32x4 b) { u32x4 w; w.x = pk2(a[0], a[1]); w.y = pk2(a[2], a[3]); w.z = pk2(b[0], b[1]); w.w = pk2(b[2], b[3]); return w; }
DI void unpack8(u32x4 w, f32x4& a, f32x4& b) { a = (f32x4){bflo(w.x), bfhi(w.x), bflo(w.y), bfhi(w.y)}; b = (f32x4){bflo(w.z), bfhi(w.z), bflo(w.w), bfhi(w.w)}; }
DI float wave_sum(float v) {
#pragma unroll
    for (int o = 1; o < 64; o <<= 1) v += __shfl_xor(v, o);
    return v;
}
DI float log2gamma(int h) { return log2f(1.0f - exp2f(-5.0f - (float)h)); }
DI float sigmoidf_(float v) { return 1.0f / (1.0f + __expf(-v)); }
DI int crow(int reg, int hh) { return (reg & 3) + 8 * (reg >> 2) + 4 * hh; }
DI size_t nfrag(int row, int col, int C) { return ((((size_t)(row >> 5) * (C >> 4) + (col >> 4)) * 2 + ((col >> 3) & 1)) * 32 + (row & 31)) * 8 + (col & 7); }
DI size_t tfrag0(int ch, int tok0, int NTOK) { return ((((size_t)(ch >> 5) * (NTOK >> 4) + (tok0 >> 4)) * 2) * 32 + (ch & 31)) * 8 + 4 * ((tok0 >> 3) & 1); }
DI void st_tfrag(bf16_t* base, int ch, int tok0, int NTOK, f32x4 a, f32x4 b) {
    bf16_t* q = base + tfrag0(ch, tok0, NTOK); u32x2 w0, w1; w0.x = pk2(a[0], a[1]); w0.y = pk2(a[2], a[3]); w1.x = pk2(b[0], b[1]); w1.y = pk2(b[2], b[3]);
    *(u32x2*)q = w0; *(u32x2*)(q + 256) = w1; }


struct EpiInA {
    static constexpr bool PERM = true, AFTER_DRAIN = false;
    bf16_t *xb, *yret; const float *cosP, *sinP;
    DI void operator()(const f32x4 (&acc)[2][2][4][2], const Unit& u, int wr, int wc, int fr_, int fq) const {
        int fr = fr_; asm volatile("" : "+v"(fr));
        const int pn = u.pn, row0 = u.pm * 256 + wr * 64 + fr, cl = wc * 32 + 8 * fq;
        if (pn < 8) {
            bf16_t* dst = xb + (size_t)(pn >> 2) * (8u << 20); const int hc = (pn & 3) * 256 + cl;
            const float sc = pn < 4 ? 1.0f : 0.0625f;
#pragma unroll
            for (int ai = 0; ai < 2; ++ai)
#pragma unroll
                for (int m = 0; m < 4; ++m) {
                    const int row = row0 + ai * 128 + m * 16, pos = row & (SEQ - 1);
                    const f32x4* cp = (const f32x4*)(cosP + pos * 128 + cl); const f32x4* sp = (const f32x4*)(sinP + pos * 128 + cl);
                    f32x4 o1[2], o2[2];
#pragma unroll
                    for (int n = 0; n < 2; ++n) { const f32x4 c = cp[n], s = sp[n], t1 = acc[ai][0][m][n], t2 = acc[ai][1][m][n];
                        o1[n] = (t1 * c - t2 * s) * sc; o2[n] = (t1 * s + t2 * c) * sc; }
                    *(u32x4*)(dst + nfrag(row, hc, 1024)) = pack8(o1[0], o1[1]); *(u32x4*)(dst + nfrag(row, hc + 128, 1024)) = pack8(o2[0], o2[1]);
                    __builtin_amdgcn_sched_barrier(0);
                }
        } else {
            const int mode = pn < 16 ? 0 : (pn < 20 ? 1 : 2);
            const int hc = (pn < 16 ? (pn - 8) : (pn & 3)) * 256 + cl;
            bf16_t* dst = xb + (size_t)(mode + 1) * (8u << 20);
#pragma unroll
            for (int ai = 0; ai < 2; ++ai)
#pragma unroll
                for (int m = 0; m < 4; ++m) {
                    const int row = row0 + ai * 128 + m * 16;
#pragma unroll
                    for (int bj = 0; bj < 2; ++bj) {
                        f32x4 v0 = acc[ai][bj][m][0], v1 = acc[ai][bj][m][1];
                        if (mode == 0) {
#pragma unroll
                            for (int e = 0; e < 4; ++e) { v0[e] = v0[e] * sigmoidf_(v0[e]); v1[e] = v1[e] * sigmoidf_(v1[e]); }
                        } else if (mode == 1) { v0 = v0 * (0.125f * 1.44269504f); v1 = v1 * (0.125f * 1.44269504f); }
                        if (mode == 0) *(u32x4*)(yret + (size_t)row * 2048 + hc + bj * 128) = pack8(v0, v1);
                        else *(u32x4*)(dst + nfrag(row, hc + bj * 128, 1024)) = pack8(v0, v1);
                    }
                }
        }
    }
};

struct EpiInB {
    static constexpr bool PERM = true, AFTER_DRAIN = false;
    bf16_t *kzT; const float *cosT, *sinT;
    DI void operator()(const f32x4 (&acc)[2][2][4][2], const Unit& u, int wr, int wc, int fr_, int fq) const {
        int fr = fr_; asm volatile("" : "+v"(fr));
        const int pm = u.pm, tok0 = u.pn * 256 + wc * 32 + 8 * fq;
        if (pm < 4) {
            const float l2g = log2gamma(pm), ginv = __builtin_amdgcn_exp2f(-l2g);
#pragma unroll
            for (int m = 0; m < 4; ++m) {
                const int i = wr * 64 + m * 16 + fr;
#pragma unroll
                for (int bj = 0; bj < 2; ++bj) {
                    const int tok = tok0 + bj * 128, pos = tok & (SEQ - 1);
                    const f32x4* cp = (const f32x4*)(cosT + i * SEQ + pos); const f32x4* sp = (const f32x4*)(sinT + i * SEQ + pos);
                    f32x4 o1[2], o2[2];
                    float zr = __builtin_amdgcn_exp2f((float)((RCH - 1) - (pos & (RCH - 1))) * l2g) * 0.0625f;
#pragma unroll
                    for (int n = 0; n < 2; ++n) { const f32x4 c = cp[n], s = sp[n], t1 = acc[0][bj][m][n], t2 = acc[1][bj][m][n];
                        f32x4 z;
#pragma unroll
                        for (int e = 0; e < 4; ++e) { z[e] = zr; zr *= ginv; }
                        o1[n] = (t1 * c - t2 * s) * z; o2[n] = (t1 * s + t2 * c) * z; }
                    st_tfrag(kzT, pm * 256 + i, tok, TH, o1[0], o1[1]);
                    st_tfrag(kzT, pm * 256 + 128 + i, tok, TH, o2[0], o2[1]);
                    __builtin_amdgcn_sched_barrier(0);
                }
            }
        } else {
            bf16_t* dst = kzT + (size_t)(pm < 12 ? 8u << 20 : 24u << 20); const int ch0 = (pm < 12 ? (pm - 4) : (pm - 12)) * 256 + wr * 64 + fr;
#pragma unroll
            for (int ai = 0; ai < 2; ++ai)
#pragma unroll
                for (int m = 0; m < 4; ++m)
#pragma unroll
                    for (int bj = 0; bj < 2; ++bj)
                        st_tfrag(dst, ch0 + ai * 128 + m * 16, tok0 + bj * 128, TH, acc[ai][bj][m][0], acc[ai][bj][m][1]);
        }
    }
};

template <int MODE> struct EpiEw {
    static constexpr bool PERM = true, AFTER_DRAIN = false;
    bf16_t* O; const bf16_t* P; int ld;
    DI void operator()(const f32x4 (&acc)[2][2][4][2], const Unit& u, int wr, int wc, int fr_, int fq) const {
        int fr = fr_; asm volatile("" : "+v"(fr));
        const int row0 = u.pm * 256 + wr * 64 + fr, col0 = u.pn * 256 + wc * 32 + 8 * fq;
#pragma unroll
        for (int ai = 0; ai < 2; ++ai)
#pragma unroll
            for (int m = 0; m < 4; ++m)
#pragma unroll
                for (int bj = 0; bj < 2; ++bj) {
                    const size_t off = (size_t)(row0 + ai * 128 + m * 16) * ld + col0 + bj * 128;
                    f32x4 v0 = acc[ai][bj][m][0], v1 = acc[ai][bj][m][1];
                    if (MODE == 0) {
#pragma unroll
                        for (int e = 0; e < 4; ++e) { v0[e] = sigmoidf_(v0[e]); v1[e] = sigmoidf_(v1[e]); }
                    } else if (MODE == 1) {
#pragma unroll
                        for (int e = 0; e < 4; ++e) { const float a = fmaxf(v0[e], 0.f), b = fmaxf(v1[e], 0.f); v0[e] = a * a; v1[e] = b * b; }
                    } else if (MODE == 2) {
                        f32x4 a, b; unpack8(*(const u32x4*)(O + off), a, b); v0 = v0 * a; v1 = v1 * b;
                    } else {
                        f32x4 a, b, c, d; unpack8(*(const u32x4*)(O + off), a, b); unpack8(*(const u32x4*)(P + off), c, d); v0 = a + c * v0; v1 = b + d * v1;
                    }
                    *(u32x4*)(O + off) = pack8(v0, v1);
                }
    }
};

struct EpiRes {
    static constexpr bool PERM = true, AFTER_DRAIN = false;
    const float* xin; float* xout; const float* gate;
    DI void operator()(const f32x4 (&acc)[2][2][4][2], const Unit& u, int wr, int wc, int fr_, int fq) const {
        int fr = fr_; asm volatile("" : "+v"(fr));
        const int row0 = u.pm * 256 + wr * 64 + fr, col0 = u.pn * 256 + wc * 32 + 8 * fq;
#pragma unroll
        for (int ai = 0; ai < 2; ++ai)
#pragma unroll
            for (int m = 0; m < 4; ++m) {
                const int row = row0 + ai * 128 + m * 16; const float* gp = gate + (row >> 12) * NMOD;
#pragma unroll
                for (int bj = 0; bj < 2; ++bj) {
                    const int col = col0 + bj * 128; const size_t off = (size_t)row * DM + col;
                    const f32x4 g0 = *(const f32x4*)(gp + col), g1 = *(const f32x4*)(gp + col + 4);
                    const f32x4 x0 = *(const f32x4*)(xin + off), x1 = *(const f32x4*)(xin + off + 4);
                    *(f32x4*)(xout + off) = x0 + g0 * acc[ai][bj][m][0]; *(f32x4*)(xout + off + 4) = x1 + g1 * acc[ai][bj][m][1];
                }
            }
    }
};

DI void cvt_tile(const float* src, int ldsrc, int k0, int n0, bf16_t* dst1, bf16_t* dst2, int K, LAS float* tile, int tid) {
    const int kr = tid >> 4, nc = (tid & 15) * 4;
#pragma unroll
    for (int p = 0; p < 2; ++p) { const int k = kr + 32 * p; const f32x4 v = *(const f32x4*)(src + (size_t)(k0 + k) * ldsrc + n0 + nc);
        tile[k * 65 + nc] = v[0]; tile[k * 65 + nc + 1] = v[1]; tile[k * 65 + nc + 2] = v[2]; tile[k * 65 + nc + 3] = v[3]; }
    __syncthreads();
    const int n = tid >> 3, ks = (tid & 7) * 8; const LAS float* s = tile + ks * 65 + n;
    u32x4 o; o.x = pk2(s[0], s[65]); o.y = pk2(s[2 * 65], s[3 * 65]); o.z = pk2(s[4 * 65], s[5 * 65]); o.w = pk2(s[6 * 65], s[7 * 65]);
    *(u32x4*)(dst1 + (size_t)n * K + k0 + ks) = o;
    if (dst2) *(u32x4*)(dst2 + (size_t)n * K + k0 + ks) = o;
    __syncthreads();
}

struct Params {
    const float *x, *c, *norm_mix_g, *w_in, *w_ret_out, *w_sb_out, *w_mix_out, *norm_mlp_g, *w_up, *w_down, *w_ada, *b_ada, *final_g;
    float* out; unsigned char* ws;
};

DI void convert_weights(const Params& p, int l, LAS float* tile, int tid) {
    unsigned char* ws = p.ws;
    bf16_t* WinA = (bf16_t*)(ws + WS_WINA); bf16_t* WinB = (bf16_t*)(ws + WS_WINB); bf16_t* Wg = (bf16_t*)(ws + WS_WG);
    constexpr int I_IN = 16 * 176, I_RET = 32 * 16, I_SB = 16 * 16, I_MIX = 16 * 16, I_UP = 16 * 64, I_DN = 64 * 16;
    constexpr int NIT = I_IN + I_RET + I_SB + I_MIX + I_UP + I_DN;
    for (int it = blockIdx.x; it < NIT; it += gridDim.x) {
        int r = it;
        if (r < I_IN) {
            const int kb = r / 176, nb = r % 176, n0 = nb * 64; bf16_t* d1; bf16_t* d2 = nullptr;
            if (n0 < 1024) d1 = WinA + (size_t)n0 * 1024;
            else if (n0 < 2048) { d1 = WinA + (size_t)n0 * 1024; d2 = WinB + (size_t)(n0 - 1024) * 1024; }
            else if (n0 < 4096) d1 = WinB + (size_t)(n0 - 1024) * 1024;
            else if (n0 < 8192) d1 = WinA + (size_t)(n0 - 2048) * 1024;
            else if (n0 < 9216) d1 = WinB + (size_t)(n0 - 5120) * 1024;
            else d1 = Wg + (size_t)(n0 - 9216) * 1024;
            cvt_tile(p.w_in + (size_t)l * DM * INW, INW, kb * 64, n0, d1, d2, 1024, tile, tid); continue;
        }
        r -= I_IN;
        if (r < I_RET) { const int kb = r / 16, nb = r % 16; cvt_tile(p.w_ret_out + (size_t)l * 2048 * 1024, 1024, kb * 64, nb * 64, (bf16_t*)(ws + WS_WRET) + (size_t)nb * 64 * 2048, nullptr, 2048, tile, tid); continue; }
        r -= I_RET;
        if (r < I_SB) { const int kb = r / 16, nb = r % 16; cvt_tile(p.w_sb_out + (size_t)l * 1024 * 1024, 1024, kb * 64, nb * 64, (bf16_t*)(ws + WS_WSB) + (size_t)nb * 64 * 1024, nullptr, 1024, tile, tid); continue; }
        r -= I_SB;
        if (r < I_MIX) { const int kb = r / 16, nb = r % 16; cvt_tile(p.w_mix_out + (size_t)l * 1024 * 1024, 1024, kb * 64, nb * 64, (bf16_t*)(ws + WS_WMIX) + (size_t)nb * 64 * 1024, nullptr, 1024, tile, tid); continue; }
        r -= I_MIX;
        if (r < I_UP) { const int kb = r / 64, nb = r % 64; cvt_tile(p.w_up + (size_t)l * 1024 * 4096, 4096, kb * 64, nb * 64, (bf16_t*)(ws + WS_WUP) + (size_t)nb * 64 * 1024, nullptr, 1024, tile, tid); continue; }
        r -= I_UP;
        { const int kb = r / 16, nb = r % 16; cvt_tile(p.w_down + (size_t)l * 4096 * 1024, 1024, kb * 64, nb * 64, (bf16_t*)(ws + WS_WDN) + (size_t)nb * 64 * 4096, nullptr, 4096, tile, tid); }
    }
}

DI void tables_and_mod(const Params& p, LAS float* lds, int tid) {
    float* cosP = (float*)(p.ws + WS_COSP); float* sinP = (float*)(p.ws + WS_SINP); float* cosT = (float*)(p.ws + WS_COST); float* sinT = (float*)(p.ws + WS_SINT);
    for (int idx = blockIdx.x * 512 + tid; idx < SEQ * 128; idx += gridDim.x * 512) {
        const int pos = idx >> 7, i = idx & 127;
        const float inv = powf(10000.0f, -(float)i / 128.0f); const float ang = (float)pos * inv;
        const float c = cosf(ang), s = sinf(ang);
        cosP[idx] = c; sinP[idx] = s; cosT[i * SEQ + pos] = c; sinT[i * SEQ + pos] = s;
    }
    float* mod = (float*)(p.ws + WS_MOD);
    LAS float* cact = lds; LAS float* red = lds + 4096;
    const int wave = tid >> 6, lane = tid & 63;
    bool have = false;
    for (int it = blockIdx.x; it < 2 * 96; it += gridDim.x) {
        if (!have) { for (int e = tid; e < 4096; e += 512) { const float v = p.c[e]; cact[e] = v * sigmoidf_(v); } have = true; __syncthreads(); }
        const int l = it / 96, c0 = (it % 96) * 64;
        const float* w = p.w_ada + (size_t)l * DM * NMOD + c0 + lane;
        float a0 = 0.f, a1 = 0.f, a2 = 0.f, a3 = 0.f;
#pragma unroll 8
        for (int k = wave * 128; k < wave * 128 + 128; ++k) { const float wv = w[(size_t)k * NMOD]; a0 += cact[k] * wv; a1 += cact[1024 + k] * wv; a2 += cact[2048 + k] * wv; a3 += cact[3072 + k] * wv; }
        red[(wave * 4 + 0) * 64 + lane] = a0; red[(wave * 4 + 1) * 64 + lane] = a1; red[(wave * 4 + 2) * 64 + lane] = a2; red[(wave * 4 + 3) * 64 + lane] = a3;
        __syncthreads();
        if (tid < 256) { const int b = tid >> 6; float s = p.b_ada[l * NMOD + c0 + lane];
#pragma unroll
            for (int w8 = 0; w8 < 8; ++w8) s += red[(w8 * 4 + b) * 64 + lane];
            mod[(size_t)(l * 4 + b) * NMOD + c0 + lane] = s; }
        __syncthreads();
    }
}

DI void norm_phase(const float* xin, const float* g, const float* modl, int shift_i, int scale_i, bf16_t* hout, int gw, int ngw, int lane) {
    for (int row = gw; row < T; row += ngw) {
        const f32x4* xr = (const f32x4*)(xin + (size_t)row * DM) + lane;
        f32x4 v[4]; float s = 0.f;
#pragma unroll
        for (int j = 0; j < 4; ++j) { v[j] = xr[64 * j]; s += (v[j][0] * v[j][0] + v[j][1] * v[j][1]) + (v[j][2] * v[j][2] + v[j][3] * v[j][3]); }
        const float rstd = 1.0f / sqrtf(wave_sum(s) * (1.0f / DM) + 1e-6f);
        const float* mb = modl + (row >> 12) * NMOD;
        u32x2* o8 = (u32x2*)(hout + (size_t)row * DM) + lane;
#pragma unroll
        for (int j = 0; j < 4; ++j) { const int col = 4 * (lane + 64 * j);
            const f32x4 gg = *(const f32x4*)(g + col), sc = *(const f32x4*)(mb + scale_i * 1024 + col), sh = *(const f32x4*)(mb + shift_i * 1024 + col);
            const f32x4 y = v[j] * rstd * gg * (sc + 1.0f) + sh;
            u32x2 w; w.x = pk2(y[0], y[1]); w.y = pk2(y[2], y[3]); o8[64 * j] = w; }
    }
}
DI void final_norm_phase(float* x, const float* g, int gw, int ngw, int lane) {
    for (int row = gw; row < T; row += ngw) {
        f32x4* xr = (f32x4*)(x + (size_t)row * DM) + lane;
        f32x4 v[4]; float s = 0.f;
#pragma unroll
        for (int j = 0; j < 4; ++j) { v[j] = xr[64 * j]; s += (v[j][0] * v[j][0] + v[j][1] * v[j][1]) + (v[j][2] * v[j][2] + v[j][3] * v[j][3]); }
        const float rstd = 1.0f / sqrtf(wave_sum(s) * (1.0f / DM) + 1e-6f);
#pragma unroll
        for (int j = 0; j < 4; ++j) { const f32x4 gg = *(const f32x4*)(g + 4 * (lane + 64 * j)); xr[64 * j] = v[j] * rstd * gg; }
    }
}

DI void ret_state_item(int item, const bf16_t* kzT, const bf16_t* vT, bf16_t* rsnap, int lane) {
    const int dvt = item & 15, dkt = (item >> 4) & 7, bh = item >> 7, bl = bh >> 2, h = bh & 3, r = lane & 31, hh = lane >> 5;
    const bf16_t* ap = kzT + (((size_t)(h * 8 + dkt) * (TH / 16) + bl * (SEQ / 16)) * 2 + hh) * 256 + r * 8;
    const bf16_t* bp = vT + (((size_t)(h * 16 + dvt) * (TH / 16) + bl * (SEQ / 16)) * 2 + hh) * 256 + r * 8;
    const float dec = exp2f((float)RCH * log2gamma(h));
    f32x16 acc;
#pragma unroll
    for (int i = 0; i < 16; ++i) acc[i] = 0.f;
    for (int n = 0; n < NRCH; ++n) {
        bf16_t* sp = rsnap + (size_t)(bh * NRCH + n) * (512 * 256) + (size_t)(dvt * 16 + 2 * dkt) * 512 + r * 8 + 4 * hh;
#pragma unroll
        for (int g = 0; g < 4; ++g) { u32x2 w; w.x = pk2(acc[4 * g], acc[4 * g + 1]); w.y = pk2(acc[4 * g + 2], acc[4 * g + 3]); *(u32x2*)(sp + (g >> 1) * 512 + (g & 1) * 256) = w; }
        if (n == NRCH - 1) break;
#pragma unroll
        for (int i = 0; i < 16; ++i) acc[i] *= dec;
        const bf16_t* a = ap + (size_t)n * (RCH / 16) * 512; const bf16_t* b = bp + (size_t)n * (RCH / 16) * 512;
#pragma unroll 8
        for (int ks = 0; ks < RCH / 16; ++ks) acc = MFMA32(*(const bf16x8*)(a + ks * 512), *(const bf16x8*)(b + ks * 512), acc);
    }
}

template <bool DIAG> DI void sb_tile(const f32x16& st, int j, int tq, int hh, float& carry, float (&aw)[16]) {
    float lp[16], gs[4], pg[4];
#pragma unroll
    for (int i = 0; i < 16; ++i) { const float z = st[i];
        const float spv = fmaxf(z, 0.f) + __builtin_amdgcn_logf(1.0f + __builtin_amdgcn_exp2f(-fabsf(z)));
        lp[i] = (!DIAG || (j * 32 + crow(i, hh)) < tq) ? -spv : 0.f; }
#pragma unroll
    for (int g = 0; g < 4; ++g) { gs[g] = (lp[4 * g] + lp[4 * g + 1]) + (lp[4 * g + 2] + lp[4 * g + 3]); pg[g] = __shfl_xor(gs[g], 32); }
    float after = carry;
#pragma unroll
    for (int g = 3; g >= 0; --g) {
        float run = after + (hh == 0 ? pg[g] : 0.f);
#pragma unroll
        for (int e = 3; e >= 0; --e) { const int i = 4 * g + e;
            const float w = __builtin_amdgcn_exp2f(st[i] + lp[i] + run);
            aw[i] = (!DIAG || (j * 32 + crow(i, hh)) < tq) ? w : 0.f; run += lp[i]; }
        after += gs[g] + pg[g];
    }
    carry = after;
}
DI void sb_item(int item, const bf16_t* sq, const bf16_t* sk, const bf16_t* svT, bf16_t* ysb, int lane) {
    const int qt = 127 - (item >> 5), h = (item >> 1) & 15, bl = item & 1, r = lane & 31, hh = lane >> 5;
    const size_t rowbase = (size_t)bl * SEQ; const int tq = qt * 32 + r;
    const int rt0 = (int)(rowbase >> 5);
    const bf16_t* qp = sq + (((size_t)(rt0 + qt) * 64 + h * 4) * 2 + hh) * 256 + r * 8;
    bf16x8 qf[4];
#pragma unroll
    for (int ks = 0; ks < 4; ++ks) qf[ks] = *(const bf16x8*)(qp + ks * 512);
    f32x16 o0, o1;
#pragma unroll
    for (int i = 0; i < 16; ++i) { o0[i] = 0.f; o1[i] = 0.f; }
    float carry = 0.f;
    for (int j = qt; j >= 0; --j) {
        const bf16_t* kp = sk + (((size_t)(rt0 + j) * 64 + h * 4) * 2 + hh) * 256 + r * 8;
        const bf16_t* vp = svT + (((size_t)(h * 2) * (TH / 16) + (rowbase >> 4) + 2 * j) * 2 + hh) * 256 + r * 8;
        const bf16x8 k0 = *(const bf16x8*)kp, k1 = *(const bf16x8*)(kp + 512), k2 = *(const bf16x8*)(kp + 1024), k3 = *(const bf16x8*)(kp + 1536);
        const bf16x8 v00 = *(const bf16x8*)vp, v01 = *(const bf16x8*)(vp + 512), v10 = *(const bf16x8*)(vp + (size_t)(TH / 16) * 512), v11 = *(const bf16x8*)(vp + (size_t)(TH / 16) * 512 + 512);
        f32x16 st;
#pragma unroll
        for (int i = 0; i < 16; ++i) st[i] = 0.f;
        st = MFMA32(k0, qf[0], st); st = MFMA32(k1, qf[1], st); st = MFMA32(k2, qf[2], st); st = MFMA32(k3, qf[3], st);
        float aw[16];
        if (j == qt) sb_tile<true>(st, j, tq, hh, carry, aw); else sb_tile<false>(st, j, tq, hh, carry, aw);
        {
            u32x4 bw; bw.x = pk2(aw[0], aw[1]); bw.y = pk2(aw[2], aw[3]); bw.z = pk2(aw[4], aw[5]); bw.w = pk2(aw[6], aw[7]);
            const bf16x8 b0 = __builtin_bit_cast(bf16x8, bw);
            bw.x = pk2(aw[8], aw[9]); bw.y = pk2(aw[10], aw[11]); bw.z = pk2(aw[12], aw[13]); bw.w = pk2(aw[14], aw[15]);
            const bf16x8 b1 = __builtin_bit_cast(bf16x8, bw);
            o0 = MFMA32(v00, b0, o0); o1 = MFMA32(v10, b0, o1); o0 = MFMA32(v01, b1, o0); o1 = MFMA32(v11, b1, o1);
        }
        if (__all(carry < SB_STOP)) break;
    }
    bf16_t* op = ysb + (rowbase + tq) * 1024 + h * 64 + 4 * hh;
#pragma unroll
    for (int g = 0; g < 4; ++g) {
        u32x2 w; w.x = pk2(o0[4 * g], o0[4 * g + 1]); w.y = pk2(o0[4 * g + 2], o0[4 * g + 3]); *(u32x2*)(op + 8 * g) = w;
        u32x2 w1; w1.x = pk2(o1[4 * g], o1[4 * g + 1]); w1.y = pk2(o1[4 * g + 2], o1[4 * g + 3]); *(u32x2*)(op + 32 + 8 * g) = w1;
    }
}

DI void ret_out_item(int item, const bf16_t* qr, const bf16_t* kn, const bf16_t* vT, const bf16_t* rsnap, bf16_t* yret, LAS unsigned char* lds, int wave, int lane) {
    const int bh = item >> 5, tg = 31 - (item & 31), bl = bh >> 2, h = bh & 3, r = lane & 31, hh = lane >> 5;
    const int n = tg >> 2, a = (tg & 3) * 4, tokg = tg * 128;
    const size_t rowbase = (size_t)bl * SEQ; const int rt0 = (int)(rowbase >> 5);
    const float l2g = log2gamma(h);
    LAS float* stats = (LAS float*)(lds + 131072 + 256);
    {
        const int tt = wave & 3, par = wave >> 2, tq = tokg + tt * 32 + r;
        const bf16_t* qp = qr + (((size_t)(rt0 + (tokg >> 5) + tt) * 64 + h * 16) * 2 + hh) * 256 + r * 8;
        bf16x8 qf[16];
#pragma unroll
        for (int ks = 0; ks < 16; ++ks) qf[ks] = *(const bf16x8*)(qp + ks * 512);
        for (int jk = par; jk <= a + tt; jk += 2) {
            const int keyt = n * 16 + jk;
            const bf16_t* kp = kn + (((size_t)(rt0 + keyt) * 64 + h * 16) * 2 + hh) * 256 + r * 8;
            f32x16 st;
#pragma unroll
            for (int i = 0; i < 16; ++i) st[i] = 0.f;
#pragma unroll
            for (int ks = 0; ks < 16; ++ks) st = MFMA32(*(const bf16x8*)(kp + ks * 512), qf[ks], st);
            float pw[16];
#pragma unroll
            for (int i = 0; i < 16; ++i) { const int d = tq - (keyt * 32 + crow(i, hh)); pw[i] = d >= 0 ? st[i] * __builtin_amdgcn_exp2f((float)d * l2g) : 0.f; }
#pragma unroll
            for (int s = 0; s < 2; ++s) {
                u32x4 bw; bw.x = pk2(pw[8 * s], pw[8 * s + 1]); bw.y = pk2(pw[8 * s + 2], pw[8 * s + 3]); bw.z = pk2(pw[8 * s + 4], pw[8 * s + 5]); bw.w = pk2(pw[8 * s + 6], pw[8 * s + 7]);
                *(LAS u32x4*)(lds + ((2 * jk + s) * 4 + tt) * 1024 + lane * 16) = bw;
            }
        }
    }
    __syncthreads();
    f32x16 acc[8];
#pragma unroll
    for (int q = 0; q < 8; ++q)
#pragma unroll
        for (int i = 0; i < 16; ++i) acc[q][i] = 0.f;
    {
        const bf16_t* rp = rsnap + (size_t)(bh * NRCH + n) * (512 * 256) + (size_t)(wave * 2 * 16) * 512 + hh * 256 + r * 8;
        const bf16_t* qg = qr + (((size_t)(rt0 + (tokg >> 5)) * 64 + h * 16) * 2 + hh) * 256 + r * 8;
#pragma unroll 2
        for (int ks = 0; ks < 16; ++ks) {
            const bf16x8 a0 = *(const bf16x8*)(rp + ks * 512), a1 = *(const bf16x8*)(rp + (16 + ks) * 512);
#pragma unroll
            for (int tt = 0; tt < 4; ++tt) { const bf16x8 b = *(const bf16x8*)(qg + (size_t)(tt * 64 + ks) * 512);
                acc[tt] = MFMA32(a0, b, acc[tt]); acc[4 + tt] = MFMA32(a1, b, acc[4 + tt]); }
        }
#pragma unroll
        for (int tt = 0; tt < 4; ++tt) { const float xi = __builtin_amdgcn_exp2f((float)(((tokg + tt * 32 + r) & (RCH - 1)) + 1) * l2g);
#pragma unroll
            for (int i = 0; i < 16; ++i) { acc[tt][i] *= xi; acc[4 + tt][i] *= xi; } }
    }
    {
        const bf16_t* vb = vT + (((size_t)(h * 16 + wave * 2) * (TH / 16) + (rowbase >> 4) + n * 32) * 2 + hh) * 256 + r * 8;
        const int ns = 2 * (a + 4);
#pragma unroll 2
        for (int s = 0; s < ns; ++s) {
            const bf16x8 a0 = *(const bf16x8*)(vb + (size_t)s * 512), a1 = *(const bf16x8*)(vb + (size_t)(TH / 16 + s) * 512);
            const int ttmin = (s >> 1) - a;
#pragma unroll
            for (int tt = 0; tt < 4; ++tt) if (tt >= ttmin) { const bf16x8 b = *(const LAS bf16x8*)(lds + (s * 4 + tt) * 1024 + lane * 16);
                acc[tt] = MFMA32(a0, b, acc[tt]); acc[4 + tt] = MFMA32(a1, b, acc[4 + tt]); }
        }
    }
#pragma unroll
    for (int tt = 0; tt < 4; ++tt) {
        float s1 = 0.f, s2 = 0.f;
#pragma unroll
        for (int i = 0; i < 16; ++i) { const float v0 = acc[tt][i], v1 = acc[4 + tt][i]; s1 += v0 + v1; s2 += v0 * v0 + v1 * v1; }
        s1 += __shfl_xor(s1, 32); s2 += __shfl_xor(s2, 32);
        if (hh == 0) { stats[(wave * 128 + tt * 32 + r) * 2] = s1; stats[(wave * 128 + tt * 32 + r) * 2 + 1] = s2; }
    }
    __syncthreads();
#pragma unroll
    for (int tt = 0; tt < 4; ++tt) {
        float s1 = 0.f, s2 = 0.f;
#pragma unroll
        for (int w = 0; w < 8; ++w) { s1 += stats[(w * 128 + tt * 32 + r) * 2]; s2 += stats[(w * 128 + tt * 32 + r) * 2 + 1]; }
        const float mu = s1 * (1.0f / 512.0f), var = fmaxf(s2 * (1.0f / 512.0f) - mu * mu, 0.f), rstd = 1.0f / sqrtf(var + 1e-5f);
        bf16_t* op = yret + (rowbase + tokg + tt * 32 + r) * 2048 + h * 512 + wave * 64 + 4 * hh;
#pragma unroll
        for (int dvt = 0; dvt < 2; ++dvt)
#pragma unroll
            for (int g = 0; g < 4; ++g) {
                u32x2* pp = (u32x2*)(op + dvt * 32 + 8 * g); const u32x2 gv = *pp; const f32x16& o = acc[dvt * 4 + tt];
                u32x2 w; w.x = pk2(bflo(gv.x) * (o[4 * g] - mu) * rstd, bfhi(gv.x) * (o[4 * g + 1] - mu) * rstd);
                w.y = pk2(bflo(gv.y) * (o[4 * g + 2] - mu) * rstd, bfhi(gv.y) * (o[4 * g + 3] - mu) * rstd); *pp = w;
            }
    }
    __syncthreads();
}

#define XB_TMO      128
#define XB_XCNT(j)  (256  + 64 * (j))
#define XB_XSUB(j)  (1280 + 64 * (j))
#define XB_XGEN(j)  (2304 + 64 * (j))
#define XB_TOP      3328
#define XB_TOPGEN   3392
#define XCD_BAR_WORDS 3456
#define XB_SPIN_CAP (1u << 18)

__device__ __forceinline__ unsigned xb_ld(unsigned* p)              { return __hip_atomic_load(p, __ATOMIC_RELAXED, __HIP_MEMORY_SCOPE_AGENT); }
__device__ __forceinline__ unsigned xb_add(unsigned* p, unsigned v) { return __hip_atomic_fetch_add(p, v, __ATOMIC_RELAXED, __HIP_MEMORY_SCOPE_AGENT); }
__device__ __forceinline__ unsigned xb_xcc_id() { return (unsigned)__builtin_amdgcn_s_getreg((3 << 11) | 20) & 0xFu; }
#define XB_SPIN(cond, bar) do { unsigned _sp = 0; while (cond) { __builtin_amdgcn_s_sleep(1); \
    if ((++_sp & 255u) == 0u) { if (xb_ld(&(bar)[XB_TMO])) break; if (_sp > XB_SPIN_CAP) { atomicAdd(&(bar)[XB_TMO], 1u); break; } } } } while (0)

struct XcdBarrier {
    unsigned* bar; unsigned x;
    volatile LAS unsigned* st;
};

__device__ __forceinline__ XcdBarrier xcd_barrier_post(unsigned* bar, volatile LAS unsigned* st) {
    XcdBarrier b; b.bar = bar; b.x = xb_xcc_id(); b.st = st;
    if (threadIdx.x == 0) (void)xb_add(&bar[XB_XCNT(b.x)], 1u);
    return b;
}
__device__ __forceinline__ void xcd_barrier_complete(unsigned* bar, unsigned x, unsigned& nloc, unsigned& nx) {
    const unsigned G = gridDim.x * gridDim.y * gridDim.z;
    unsigned sum, cnt, mine, sp = 0u;
    for (;;) {
        sum = 0u; cnt = 0u; mine = 0u;
#pragma unroll
        for (unsigned j = 0; j < 16; ++j) { const unsigned c = xb_ld(&bar[XB_XCNT(j)]); sum += c; cnt += (c > 0u) ? 1u : 0u; mine = (j == x) ? c : mine; }
        if (sum == G) break;
        __builtin_amdgcn_s_sleep(1);
        if ((++sp & 255u) == 0u) { if (xb_ld(&bar[XB_TMO])) break; if (sp > XB_SPIN_CAP) { atomicAdd(&bar[XB_TMO], 1u); break; } }
    }
    nloc = mine > 0u ? mine : 1u; nx = cnt > 0u ? cnt : 1u;
}

__device__ __forceinline__ void xcd_barrier(const XcdBarrier& b) {
    asm volatile("s_waitcnt vmcnt(0)" ::: "memory");
    __syncthreads();
    if (threadIdx.x == 0) {
        unsigned* bar = b.bar;
        __builtin_amdgcn_s_waitcnt(0);
        unsigned nloc = b.st[0], nx = b.st[1];
        if (nloc == 0u) { xcd_barrier_complete(bar, b.x, nloc, nx); b.st[0] = nloc; b.st[1] = nx; }
        const unsigned old = xb_add(&bar[XB_XSUB(b.x)], 1u);
        const unsigned gen = old / nloc;
        if (old + 1u == (gen + 1u) * nloc) {
            __builtin_amdgcn_fence(__ATOMIC_RELEASE, "agent");
            asm volatile("s_waitcnt vmcnt(0)" ::: "memory");
            const unsigned og = xb_add(&bar[XB_TOP], 1u);
            const unsigned tg = og / nx;
            if (og + 1u == (tg + 1u) * nx) xb_add(&bar[XB_TOPGEN], 1u);
            else XB_SPIN(xb_ld(&bar[XB_TOPGEN]) == tg, bar);
            __builtin_amdgcn_fence(__ATOMIC_ACQUIRE, "agent");
            xb_add(&bar[XB_XGEN(b.x)], 1u);
            asm volatile("s_waitcnt vmcnt(0)" ::: "memory");
        } else {
            XB_SPIN(xb_ld(&bar[XB_XGEN(b.x)]) == gen, bar);
            __builtin_amdgcn_fence(__ATOMIC_ACQUIRE, "agent");
            asm volatile("s_waitcnt vmcnt(0)" ::: "memory");
        }
    }
    __syncthreads();
}

__global__ void __launch_bounds__(512, 2) hybrid_fwd(Params p) {
    extern __shared__ __attribute__((aligned(16))) unsigned char lds_raw[];
    cg::grid_group grid = cg::this_grid();
    PG8_LAS unsigned char* lds = (PG8_LAS unsigned char*)lds_raw;
    LAS float* ldsf = (LAS float*)lds_raw;
#if PROBE_CLASS >= 0
    unsigned long long tacc = 0, tst = 0;
#define TSTART() (tst = __builtin_amdgcn_s_memrealtime())
#define TSTOP(c) do { if ((c) == PROBE_CLASS) tacc += __builtin_amdgcn_s_memrealtime() - tst; } while (0)
#else
#define TSTART() ((void)0)
#define TSTOP(c) ((void)0)
#endif
    volatile LAS unsigned* xst = (volatile LAS unsigned*)(lds_raw + 131072 + 64);
    if (threadIdx.x < 2) xst[threadIdx.x] = 0u;
    __syncthreads();
    const XcdBarrier xbar = xcd_barrier_post((unsigned*)(p.ws + WS_BAR), xst);
#define GBAR() xcd_barrier(xbar)
#if PROBE_CLASS == 9
#define GSYNC(site) do { GBAR(); TSTART(); GBAR(); TSTOP(9); } while (0)
#else
#define GSYNC(site) do { TSTART(); GBAR(); if ((PROBE_SITEMASK >> (site)) & 1) TSTOP(0); } while (0)
#endif
#define PH_BEGIN int tid = threadIdx.x; asm volatile("" : "+v"(tid)); int bx = blockIdx.x, G = gridDim.x; asm volatile("" : "+s"(bx), "+s"(G)); \
    unsigned char* ws = p.ws; asm volatile("" : "+s"(ws)); float* xo = p.out; asm volatile("" : "+s"(xo)); \
    const int lane = tid & 63, wave = __builtin_amdgcn_readfirstlane(tid >> 6), gw = bx * 8 + wave, ngw = G * 8; (void)lane; (void)wave; (void)gw; (void)ngw; \
    const float* modl = (const float*)(ws + WS_MOD) + (size_t)l * 4 * NMOD; (void)modl; bf16_t* H = (bf16_t*)(ws + WS_H); (void)H;
#pragma unroll 1
    for (int l = 0; l < 2; ++l) {
        TSTART(); { PH_BEGIN
          if (l == 0) { tables_and_mod(p, ldsf, tid); __syncthreads(); }
          convert_weights(p, l, ldsf, tid); } TSTOP(4);
        if (l == 0) grid.sync();
        TSTART(); { PH_BEGIN
          norm_phase(l == 0 ? p.x : xo, p.norm_mix_g + l * DM, modl, 0, 1, H, gw, ngw, lane); } TSTOP(5);
        GSYNC(1);
#pragma unroll 1
        for (int half = 0; half < 2; ++half) {
            TSTART(); { PH_BEGIN
              pg8::Gemm g{H + (size_t)half * TH * DM, (const bf16_t*)(ws + WS_WINA), TH, 6144, DM}; pg8::StaticOrder S; S.init(TH, 6144, G, bx);
              EpiInA E{(bf16_t*)(ws + WS_X), (bf16_t*)(ws + WS_YRET) + (size_t)half * TH * 2048, (const float*)(ws + WS_COSP), (const float*)(ws + WS_SINP)};
              pg8::gemm_phase<EpiInA, pg8::StaticOrder, true, true>(lds, g, S, E); } TSTOP(1);
            TSTART(); { PH_BEGIN
              pg8::Gemm g{(const bf16_t*)(ws + WS_WINB), H + (size_t)half * TH * DM, 4096, TH, DM}; pg8::StaticOrder S; S.init(4096, TH, G, bx);
              EpiInB E{(bf16_t*)(ws + WS_KZT), (const float*)(ws + WS_COST), (const float*)(ws + WS_SINT)};
              pg8::gemm_phase<EpiInB, pg8::StaticOrder, true, true>(lds, g, S, E); } TSTOP(1);
            GSYNC(2);
            TSTART(); { PH_BEGIN
              unsigned* qctr = (unsigned*)(ws + WS_BAR) + (l * 2 + half) * 16;
              for (;;) {
                  unsigned it = 0; if (lane == 0) it = __hip_atomic_fetch_add(qctr, 1u, __ATOMIC_RELAXED, __HIP_MEMORY_SCOPE_AGENT);
                  it = __builtin_amdgcn_readfirstlane(it);
                  if (it >= 4096u + NSTATE) break;
                  if (it < 4096u) sb_item((int)it, (const bf16_t*)(ws + WS_SQ), (const bf16_t*)(ws + WS_SK), (const bf16_t*)(ws + WS_SVT), (bf16_t*)(ws + WS_YSB) + (size_t)half * TH * 1024, lane);
                  else ret_state_item((int)(it - 4096u), (const bf16_t*)(ws + WS_KZT), (const bf16_t*)(ws + WS_VT), (bf16_t*)(ws + WS_RSNAP), lane);
              } } TSTOP(2);
            GSYNC(3);
            TSTART(); { PH_BEGIN
              for (int it = bx; it < 256; it += G) ret_out_item(it, (const bf16_t*)(ws + WS_QR), (const bf16_t*)(ws + WS_KN), (const bf16_t*)(ws + WS_VT), (const bf16_t*)(ws + WS_RSNAP), (bf16_t*)(ws + WS_YRET) + (size_t)half * TH * 2048, (LAS unsigned char*)lds_raw, wave, lane); } TSTOP(3);
            GSYNC(4);
        }
        TSTART(); { PH_BEGIN pg8::StaticOrder S; S.init(T, DM, G, bx);
          pg8::Gemm g{H, (const bf16_t*)(ws + WS_WG), T, DM, DM}; EpiEw<0> E{(bf16_t*)(ws + WS_MERGED), nullptr, DM}; pg8::gemm_phase<EpiEw<0>, pg8::StaticOrder, false, true>(lds, g, S, E); } TSTOP(7);
        TSTART(); { PH_BEGIN pg8::StaticOrder S; S.init(T, DM, G, bx);
          pg8::Gemm g{(const bf16_t*)(ws + WS_YRET), (const bf16_t*)(ws + WS_WRET), T, DM, 2048}; EpiEw<2> E{(bf16_t*)(ws + WS_MERGED), nullptr, DM}; pg8::gemm_phase<EpiEw<2>, pg8::StaticOrder, false, true>(lds, g, S, E); } TSTOP(7);
        TSTART(); { PH_BEGIN pg8::StaticOrder S; S.init(T, DM, G, bx);
          pg8::Gemm g{H, (const bf16_t*)(ws + WS_WG) + (size_t)1024 * 1024, T, DM, DM}; EpiEw<0> E{(bf16_t*)(ws + WS_TMP), nullptr, DM}; pg8::gemm_phase<EpiEw<0>, pg8::StaticOrder, false, true>(lds, g, S, E); } TSTOP(7);
        TSTART(); { PH_BEGIN pg8::StaticOrder S; S.init(T, DM, G, bx);
          pg8::Gemm g{(const bf16_t*)(ws + WS_YSB), (const bf16_t*)(ws + WS_WSB), T, DM, DM}; EpiEw<3> E{(bf16_t*)(ws + WS_MERGED), (const bf16_t*)(ws + WS_TMP), DM}; pg8::gemm_phase<EpiEw<3>, pg8::StaticOrder, false, true>(lds, g, S, E); } TSTOP(7);
        GSYNC(5);
        TSTART(); { PH_BEGIN pg8::StaticOrder S; S.init(T, DM, G, bx);
          pg8::Gemm g{(const bf16_t*)(ws + WS_MERGED), (const bf16_t*)(ws + WS_WMIX), T, DM, DM}; EpiRes E{l == 0 ? p.x : xo, xo, modl + 2 * 1024};
          pg8::gemm_phase<EpiRes, pg8::StaticOrder, false, true>(lds, g, S, E); } TSTOP(7);
        GSYNC(6);
        TSTART(); { PH_BEGIN
          norm_phase(xo, p.norm_mlp_g + l * DM, modl, 3, 4, H, gw, ngw, lane); } TSTOP(5);
        GSYNC(7);
        TSTART(); { PH_BEGIN pg8::StaticOrder S; S.init(T, FF, G, bx);
          pg8::Gemm g{H, (const bf16_t*)(ws + WS_WUP), T, FF, DM}; EpiEw<1> E{(bf16_t*)(ws + WS_U), nullptr, FF};
          pg8::gemm_phase<EpiEw<1>, pg8::StaticOrder, true, true>(lds, g, S, E); } TSTOP(8);
        GSYNC(8);
        TSTART(); { PH_BEGIN pg8::StaticOrder S; S.init(T, DM, G, bx);
          pg8::Gemm g{(const bf16_t*)(ws + WS_U), (const bf16_t*)(ws + WS_WDN), T, DM, FF}; EpiRes E{xo, xo, modl + 5 * 1024};
          pg8::gemm_phase<EpiRes, pg8::StaticOrder, false, true>(lds, g, S, E); } TSTOP(8);
        GSYNC(9);
    }
    TSTART(); { const int l = 0; PH_BEGIN
      final_norm_phase(xo, p.final_g, gw, ngw, lane); } TSTOP(5);
#if PROBE_CLASS >= 0
    grid.sync();
    if (blockIdx.x == 0) { const unsigned kk = (unsigned)(tacc * 4ull / 25ull);
        for (unsigned i = threadIdx.x; i < kk; i += 512) p.out[i] += 0.1f; }
#endif
#undef PH_BEGIN
}

extern "C" void kernel_launch(void* const* d_in, const int* in_sizes, int n_in, void* d_out, int out_size, void* d_ws, size_t ws_size, hipStream_t stream) {
    static int grid_blocks = 0;
    if (grid_blocks == 0) {
        if (n_in != 13 || out_size != T * DM || ws_size < WS_END) { fprintf(stderr, "kernel_launch: unexpected shapes (n_in %d out %d ws %zu need %zu)\n", n_in, out_size, ws_size, (size_t)WS_END); grid_blocks = -1; return; }
        int dev = 0, cus = 0, per_cu = 0;
        (void)hipGetDevice(&dev); (void)hipDeviceGetAttribute(&cus, hipDeviceAttributeMultiprocessorCount, dev);
        if (hipFuncSetAttribute((const void*)hybrid_fwd, hipFuncAttributeMaxDynamicSharedMemorySize, LDS_BYTES) != hipSuccess) { fprintf(stderr, "kernel_launch: hipFuncSetAttribute failed\n"); grid_blocks = -1; return; }
        if (hipOccupancyMaxActiveBlocksPerMultiprocessor(&per_cu, (const void*)hybrid_fwd, 512, LDS_BYTES) != hipSuccess || per_cu < 1) { fprintf(stderr, "kernel_launch: occupancy query gave %d\n", per_cu); per_cu = 1; (void)hipGetLastError(); }
        grid_blocks = cus * per_cu;
    }
    if (grid_blocks < 0) return;
    Params p{};
    p.x = (const float*)d_in[0]; p.c = (const float*)d_in[1]; p.norm_mix_g = (const float*)d_in[2]; p.w_in = (const float*)d_in[3]; p.w_ret_out = (const float*)d_in[4];
    p.w_sb_out = (const float*)d_in[5]; p.w_mix_out = (const float*)d_in[6]; p.norm_mlp_g = (const float*)d_in[7]; p.w_up = (const float*)d_in[8]; p.w_down = (const float*)d_in[9];
    p.w_ada = (const float*)d_in[10]; p.b_ada = (const float*)d_in[11]; p.final_g = (const float*)d_in[12];
    p.out = (float*)d_out; p.ws = (unsigned char*)d_ws;
    if (hipMemsetAsync((char*)d_ws + WS_BAR, 0, XCD_BAR_WORDS * 4, stream) != hipSuccess) { fprintf(stderr, "kernel_launch: memset failed\n"); return; }
    void* args[] = {&p};
    hipError_t e = hipLaunchCooperativeKernel((const void*)hybrid_fwd, dim3(grid_blocks), dim3(512), args, LDS_BYTES, stream);
    if (e != hipSuccess) fprintf(stderr, "kernel_launch: cooperative launch failed: %s (grid %d)\n", hipGetErrorString(e), grid_blocks);
}
```

```cpp
#include <hip/hip_runtime.h>
#include <hip/hip_cooperative_groups.h>
#include <cstdio>
#include <cstdint>
namespace cg = cooperative_groups;
#define DI __device__ __forceinline__
#define PROBE_CLASS -1
#define PROBE_SITEMASK 0xFFFF
namespace pg8 {
#define PG8_LAS __attribute__((address_space(3)))
typedef unsigned short bf16_t;
typedef short bf16x8 __attribute__((ext_vector_type(8)));
typedef float f32x4 __attribute__((ext_vector_type(4)));
typedef unsigned u32x4 __attribute__((ext_vector_type(4)));
constexpr int BM = 256, BK = 64, HALF = 128, HTB = HALF * BK * 2  , STAGE_BYTES = 8 * HTB, NXCD = 8, WGM = 8;

__host__ __device__ __forceinline__ int lds_byte(int r, int c) { const int st = (r >> 4) * 2 + (c >> 5), rr = r & 15, cc = c & 31, ob = rr * 64 + cc * 2; return st * 1024 + (ob ^ (((ob >> 9) & 1) << 5)); }
__host__ __device__ __forceinline__ void stage_rc(int b, int& R, int& C) { const int st = b / 1024, sb = b % 1024, swz = sb ^ (((sb >> 9) & 1) << 5); R = (st >> 1) * 16 + swz / 64; C = (st & 1) * 32 + (swz % 64) / 2; }
__host__ __device__ __forceinline__ int perm32(int rho) { const int n = rho >> 4, i = rho & 15; return 8 * (i >> 2) + 4 * n + (i & 3); }

struct Unit { int pm, pn; };
struct Gemm { const bf16_t* A; const bf16_t* Bt; int M, N, K; int frag, ns; };

struct StaticOrder {
    int nM, nN, nwg, G, c;
    __host__ __device__ void init(int M, int N, int G_, int c_) { nM = M / BM; nN = N / BM; nwg = nM * nN; G = G_; c = c_; }
    __host__ __device__ bool next(int i, Unit& u) const {
        const long L = (long)i * G + c; if (L >= nwg) return false;
        int wgid = (int)L; { const int q = nwg / NXCD, r = nwg % NXCD, xcd = wgid % NXCD, off = wgid / NXCD; wgid = (xcd < r ? xcd * (q + 1) : r * (q + 1) + (xcd - r) * q) + off; }
        const int nig = WGM * nN, gid = wgid / nig, fm = gid * WGM, gsz = (nM - fm) < WGM ? (nM - fm) : WGM;
        u.pm = fm + ((wgid % nig) % gsz); u.pn = (wgid % nig) / gsz; return true;
    }
    __device__ __forceinline__ void a_ready(const Unit&) const {}
    __device__ __forceinline__ void done(const Unit&) const {}
    __device__ __forceinline__ const char* aptr(const Gemm& g, const Unit& u, size_t tstep) const { return (const char*)g.A + (size_t)u.pm * tstep; }
    __device__ __forceinline__ const char* bptr(const Gemm& g, const Unit& u, size_t tstep) const { return (const char*)g.Bt + (size_t)u.pn * tstep; }
};

template <class Epi, class Sched, bool ALIGN_EPI = false, bool SP2 = false>
__device__ __forceinline__ void gemm_phase(PG8_LAS unsigned char* lds, const Gemm g, const Sched& S, const Epi& E) {
    int tid_l = threadIdx.x; asm volatile("" : "+v"(tid_l)); const int tid = tid_l, wid = __builtin_amdgcn_readfirstlane(tid >> 6), lane = tid & 63, wr = wid >> 2, wc = wid & 3, fr = lane & 15, fq = lane >> 4;
    const int K = g.K, nt = K / BK;
    unsigned voffA[2], voffB[2];
#pragma unroll
    for (int i = 0; i < 2; ++i) { int R, C; stage_rc(tid * 16 + i * 8192, R, C); const int Rb = Epi::PERM ? ((R & ~31) + perm32(R & 31)) : R;
        if (g.frag) { const unsigned rtile = (unsigned)g.ns * 1024u, kc = (unsigned)((C >> 4) * 1024 + ((C >> 3) & 1) * 512);
            voffA[i] = (unsigned)(R >> 5) * rtile + kc + (unsigned)(R & 31) * 16u; voffB[i] = (unsigned)(Rb >> 5) * rtile + kc + (unsigned)(Rb & 31) * 16u; }
        else { voffA[i] = (unsigned)(R * K + C) * 2u; voffB[i] = (unsigned)(Rb * K + C) * 2u; } }
    const size_t kstep = g.frag ? (size_t)4096 : (size_t)(BK * 2);
    const size_t hstep = g.frag ? (size_t)4 * g.ns * 1024 : (size_t)HALF * K * 2;
    const size_t tstep = 2 * hstep;
    const unsigned ldsw = (unsigned)wid * 1024u;
    const int aoff = lds_byte(wr * 64 + fr, fq * 8), boff = lds_byte(wc * 32 + fr, fq * 8);
#define PG8_SA(b, h) (((b) * 2 + (h)) * HTB)
#define PG8_SB(b, h) ((4 + (b) * 2 + (h)) * HTB)
#define PG8_STAGE(bufoff, gbase, voff) do { _Pragma("unroll") for (int _i = 0; _i < 2; ++_i) \
        __builtin_amdgcn_global_load_lds((const unsigned*)((const char*)(gbase) + (voff)[_i]), (PG8_LAS unsigned*)(lds + (bufoff) + ldsw + _i * 8192), 16, 0, 0); } while (0)
#define PG8_LDA(dst, b, h) do { _Pragma("unroll") for (int m = 0; m < 4; ++m) _Pragma("unroll") for (int k = 0; k < 2; ++k) dst[m][k] = *(const PG8_LAS bf16x8*)(lds + PG8_SA(b, h) + aoff + m * 2048 + k * 1024); } while (0)
#define PG8_LDB(dst, b, h) do { _Pragma("unroll") for (int n = 0; n < 2; ++n) _Pragma("unroll") for (int k = 0; k < 2; ++k) dst[n][k] = *(const PG8_LAS bf16x8*)(lds + PG8_SB(b, h) + boff + n * 2048 + k * 1024); } while (0)
#define PG8_MMA(ai, bj, At, Bt) do { __builtin_amdgcn_s_setprio(1); _Pragma("unroll") for (int m = 0; m < 4; ++m) _Pragma("unroll") for (int n = 0; n < 2; ++n) _Pragma("unroll") for (int k = 0; k < 2; ++k) \
        acc[ai][bj][m][n] = __builtin_amdgcn_mfma_f32_16x16x32_bf16(Bt[n][k], At[m][k], acc[ai][bj][m][n], 0, 0, 0); __builtin_amdgcn_s_setprio(0); } while (0)
#define PG8_WAIT_V(n) asm volatile("s_waitcnt vmcnt(" #n ")" ::: "memory")
#define PG8_WAIT_L(n) asm volatile("s_waitcnt lgkmcnt(" #n ")" ::: "memory")
#define PG8_BAR __builtin_amdgcn_s_barrier()
#define PG8_SCHED __builtin_amdgcn_sched_barrier(0)
    Unit cur, nxt; int ui = 0;
    if (!S.next(0, cur)) return;
    f32x4 acc[2][2][4][2];
#pragma unroll
    for (int a = 0; a < 2; ++a)
#pragma unroll
        for (int b = 0; b < 2; ++b)
#pragma unroll
            for (int m = 0; m < 4; ++m)
#pragma unroll
                for (int n = 0; n < 2; ++n) acc[a][b][m][n] = (f32x4){0.f, 0.f, 0.f, 0.f};
    bf16x8 At[4][2], B0[2][2], B1[2][2];
    const char* cA = S.aptr(g, cur, tstep); const char* cB = S.bptr(g, cur, tstep);
    S.a_ready(cur);
    if constexpr (SP2) {
        PG8_STAGE(PG8_SB(0, 0), cB, voffB); PG8_STAGE(PG8_SB(0, 1), cB + hstep, voffB); PG8_STAGE(PG8_SA(0, 0), cA, voffA); PG8_STAGE(PG8_SA(0, 1), cA + hstep, voffA);
        if (wr == 1) PG8_BAR;
        PG8_WAIT_V(2); PG8_BAR;
        PG8_STAGE(PG8_SB(1, 0), cB + kstep, voffB); PG8_STAGE(PG8_SA(1, 0), cA + kstep, voffA); PG8_STAGE(PG8_SB(1, 1), cB + hstep + kstep, voffB);
        PG8_WAIT_V(6); PG8_BAR;
    } else {
        PG8_STAGE(PG8_SB(0, 0), cB, voffB); PG8_STAGE(PG8_SA(0, 0), cA, voffA); PG8_STAGE(PG8_SB(0, 1), cB + hstep, voffB); PG8_STAGE(PG8_SA(0, 1), cA + hstep, voffA);
        if (wr == 1) PG8_BAR;
        PG8_WAIT_V(4); PG8_BAR;
        PG8_STAGE(PG8_SB(1, 0), cB + kstep, voffB); PG8_STAGE(PG8_SA(1, 0), cA + kstep, voffA); PG8_STAGE(PG8_SB(1, 1), cB + hstep + kstep, voffB);
        PG8_WAIT_V(6); PG8_BAR;
    }
    for (;;) {
        const bool has_next = S.next(ui + 1, nxt);
        const char* nA = has_next ? S.aptr(g, nxt, tstep) : cA; const char* nB = has_next ? S.bptr(g, nxt, tstep) : cB;
        for (int t = 0; t < nt; t += 2) {
            const bool last = (t == nt - 2);
            const char* a1 = cA + (size_t)(t + 1) * kstep;
            const char* a2 = last ? nA : cA + (size_t)(t + 2) * kstep; const char* b2 = last ? nB : cB + (size_t)(t + 2) * kstep;
            const char* a3 = a2 + kstep; const char* b3 = b2 + kstep;
            if (last && has_next) S.a_ready(nxt);
            if constexpr (SP2) {
            PG8_LDB(B0, 0, 0); PG8_LDB(B1, 0, 1); PG8_SCHED; PG8_LDA(At, 0, 0); PG8_STAGE(PG8_SA(1, 1), a1 + hstep, voffA);
            PG8_WAIT_V(8); PG8_WAIT_L(0); PG8_BAR; PG8_MMA(0, 0, At, B0); PG8_MMA(0, 1, At, B1); PG8_BAR; PG8_SCHED;
            PG8_LDA(At, 0, 1); PG8_STAGE(PG8_SB(0, 0), b2, voffB); PG8_STAGE(PG8_SB(0, 1), b2 + hstep, voffB); PG8_STAGE(PG8_SA(0, 0), a2, voffA);
            PG8_WAIT_V(8); PG8_WAIT_L(0); PG8_BAR; PG8_MMA(1, 0, At, B0); PG8_MMA(1, 1, At, B1); PG8_BAR; PG8_SCHED;
            PG8_LDB(B0, 1, 0); PG8_LDB(B1, 1, 1); PG8_SCHED; PG8_LDA(At, 1, 0); PG8_STAGE(PG8_SA(0, 1), a2 + hstep, voffA);
            PG8_WAIT_V(8); PG8_WAIT_L(0); PG8_BAR; PG8_MMA(0, 0, At, B0); PG8_MMA(0, 1, At, B1); PG8_BAR; PG8_SCHED;
            PG8_LDA(At, 1, 1); PG8_STAGE(PG8_SB(1, 0), b3, voffB); PG8_STAGE(PG8_SB(1, 1), b3 + hstep, voffB); PG8_STAGE(PG8_SA(1, 0), a3, voffA);
            PG8_WAIT_V(8); PG8_WAIT_L(0); PG8_BAR; PG8_MMA(1, 0, At, B0); PG8_MMA(1, 1, At, B1); PG8_BAR; PG8_SCHED;
            } else {
            PG8_LDB(B0, 0, 0); PG8_SCHED; PG8_LDA(At, 0, 0); PG8_STAGE(PG8_SA(1, 1), a1 + hstep, voffA);
            PG8_WAIT_L(8); PG8_BAR; PG8_WAIT_L(0); PG8_MMA(0, 0, At, B0); PG8_BAR; PG8_SCHED;
            PG8_LDB(B1, 0, 1); PG8_STAGE(PG8_SB(0, 0), b2, voffB);
            PG8_BAR; PG8_WAIT_L(0); PG8_MMA(0, 1, At, B1); PG8_BAR;
            PG8_LDA(At, 0, 1); PG8_STAGE(PG8_SA(0, 0), a2, voffA);
            PG8_BAR; PG8_WAIT_L(0); PG8_MMA(1, 0, At, B0); PG8_BAR; PG8_SCHED;
            PG8_STAGE(PG8_SB(0, 1), b2 + hstep, voffB);
            PG8_WAIT_V(6); PG8_BAR; PG8_MMA(1, 1, At, B1); PG8_BAR;
            PG8_LDB(B0, 1, 0); PG8_SCHED; PG8_LDA(At, 1, 0); PG8_STAGE(PG8_SA(0, 1), a2 + hstep, voffA);
            PG8_WAIT_L(8); PG8_BAR; PG8_WAIT_L(0); PG8_MMA(0, 0, At, B0); PG8_BAR; PG8_SCHED;
            PG8_LDB(B1, 1, 1); PG8_STAGE(PG8_SB(1, 0), b3, voffB);
            PG8_BAR; PG8_WAIT_L(0); PG8_MMA(0, 1, At, B1); PG8_BAR;
            PG8_LDA(At, 1, 1); PG8_STAGE(PG8_SA(1, 0), a3, voffA);
            PG8_BAR; PG8_WAIT_L(0); PG8_MMA(1, 0, At, B0); PG8_BAR; PG8_SCHED;
            PG8_STAGE(PG8_SB(1, 1), b3 + hstep, voffB);
            PG8_WAIT_V(6); PG8_BAR; PG8_MMA(1, 1, At, B1); PG8_BAR;
            }
        }
        if constexpr (ALIGN_EPI) { if (wr == 0) PG8_BAR; }
        if constexpr (!Epi::AFTER_DRAIN) { E(acc, cur, wr, wc, fr, fq); S.done(cur); }
        if (!has_next) break;
#pragma unroll
        for (int a = 0; a < 2; ++a)
#pragma unroll
            for (int b = 0; b < 2; ++b)
#pragma unroll
                for (int m = 0; m < 4; ++m)
#pragma unroll
                    for (int n = 0; n < 2; ++n) acc[a][b][m][n] = (f32x4){0.f, 0.f, 0.f, 0.f};
        cur = nxt; cA = nA; cB = nB; ++ui;
        if constexpr (ALIGN_EPI) { if (wr == 1) PG8_BAR; }
    }
    PG8_WAIT_V(0);
    if constexpr (!ALIGN_EPI) { if (wr == 0) PG8_BAR; }
    PG8_BAR;
    if constexpr (Epi::AFTER_DRAIN) { E.fused(acc, cur, wr, wc, fr, fq, lds, wid, lane); S.done(cur); }
#undef PG8_SA
#undef PG8_SB
#undef PG8_STAGE
#undef PG8_LDA
#undef PG8_LDB
#undef PG8_MMA
#undef PG8_WAIT_V
#undef PG8_WAIT_L
#undef PG8_BAR
#undef PG8_SCHED
}
}

using pg8::bf16_t; using pg8::bf16x8; using pg8::f32x4; using pg8::u32x4; using pg8::Unit;
typedef float f32x16 __attribute__((ext_vector_type(16)));
typedef float f32x2 __attribute__((ext_vector_type(2)));
typedef unsigned u32x2 __attribute__((ext_vector_type(2)));
typedef __bf16 bf16x2_t __attribute__((ext_vector_type(2)));
#define LAS __attribute__((address_space(3)))
#define MFMA32(a, b, c) __builtin_amdgcn_mfma_f32_32x32x16_bf16((a), (b), (c), 0, 0, 0)

constexpr int T = 16384, DM = 1024, SEQ = 4096, TH = 8192, FF = 4096, INW = 11264, NMOD = 6144;
constexpr int RCH = 256, NRCH = SEQ / RCH, CPG = RCH / 128;
constexpr size_t MiB = 1u << 20;
constexpr size_t WS_BAR = 768 * 1024;
constexpr size_t WS_MOD = 0, WS_COSP = 1 * MiB, WS_SINP = 3 * MiB, WS_COST = 5 * MiB, WS_SINT = 7 * MiB, WS_H = 9 * MiB;
constexpr size_t WS_WINA = 41 * MiB, WS_WINB = 53 * MiB, WS_WG = 61 * MiB, WS_WRET = 65 * MiB, WS_WSB = 69 * MiB, WS_WMIX = 71 * MiB, WS_WUP = 73 * MiB, WS_WDN = 81 * MiB;
constexpr size_t WS_YRET = 89 * MiB, WS_YSB = 153 * MiB, WS_RSNAP = 185 * MiB, WS_X = 217 * MiB, WS_END = 345 * MiB;
constexpr size_t WS_QR = WS_X, WS_KN = WS_X + 16 * MiB, WS_SQ = WS_X + 32 * MiB, WS_SK = WS_X + 48 * MiB, WS_KZT = WS_X + 64 * MiB, WS_VT = WS_X + 80 * MiB, WS_SVT = WS_X + 112 * MiB;
static_assert(WS_KN == WS_QR + 16 * MiB && WS_SQ == WS_QR + 32 * MiB && WS_SK == WS_QR + 48 * MiB && WS_VT == WS_KZT + 16 * MiB && WS_SVT == WS_KZT + 48 * MiB, "epilogue pointer arithmetic");
constexpr size_t WS_MERGED = WS_X, WS_TMP = WS_X + 32 * MiB, WS_U = WS_X;
constexpr int LDS_BYTES = 147456;
constexpr float SB_STOP = -40.0f * 1.44269504f;

DI unsigned pk2(float lo, float hi) { f32x2 v = {lo, hi}; bf16x2_t b = __builtin_convertvector(v, bf16x2_t); return __builtin_bit_cast(unsigned, b); }
DI float bflo(unsigned w) { return __uint_as_float(w << 16); }
DI float bfhi(unsigned w) { return __uint_as_float(w & 0xffff0000u); }
DI u32x4 pack8(f32x4 a, f32x4 b) { u32x4 w; w.x = pk2(a[0], a[1]); w.y = pk2(a[2], a[3]); w.z = pk2(b[0], b[1]); w.w = pk2(b[2], b[3]); return w; }
DI void unpack8(u32x4 w, f32x4& a, f32x4& b) { a = (f32x4){bflo(w.x), bfhi(w.x), bflo(w.y), bfhi(w.y)}; b = (f32x4){bflo(w.z), bfhi(w.z), bflo(w.w), bfhi(w.w)}; }
DI float wave_sum(float v) {
#pragma unroll
    for (int o = 1; o < 64; o <<= 1) v += __shfl_xor(v, o);
    return v;
}
DI float log2gamma(int h) { return log2f(1.0f - exp2f(-5.0f - (float)h)); }
DI float sigmoidf_(float v) { return 1.0f / (1.0f + __expf(-v)); }
DI int crow(int reg, int hh) { return (reg & 3) + 8 * (reg >> 2) + 4 * hh; }
DI size_t nfrag(int row, int col, int C) { return ((((size_t)(row >> 5) * (C >> 4) + (col >> 4)) * 2 + ((col >> 3) & 1)) * 32 + (row & 31)) * 8 + (col & 7); }
DI size_t tfrag0(int ch, int tok0, int NTOK) { return ((((size_t)(ch >> 5) * (NTOK >> 4) + (tok0 >> 4)) * 2) * 32 + (ch & 31)) * 8 + 4 * ((tok0 >> 3) & 1); }
DI void st_tfrag(bf16_t* base, int ch, int tok0, int NTOK, f32x4 a, f32x4 b) {
    bf16_t* q = base + tfrag0(ch, tok0, NTOK); u32x2 w0, w1; w0.x = pk2(a[0], a[1]); w0.y = pk2(a[2], a[3]); w1.x = pk2(b[0], b[1]); w1.y = pk2(b[2], b[3]);
    *(u32x2*)q = w0; *(u32x2*)(q + 256) = w1; }


struct EpiInA {
    static constexpr bool PERM = true, AFTER_DRAIN = false;
    bf16_t *xb, *yret; const float *cosP, *sinP;
    DI void operator()(const f32x4 (&acc)[2][2][4][2], const Unit& u, int wr, int wc, int fr_, int fq) const {
        int fr = fr_; asm volatile("" : "+v"(fr));
        const int pn = u.pn, row0 = u.pm * 256 + wr * 64 + fr, cl = wc * 32 + 8 * fq;
        if (pn < 8) {
            bf16_t* dst = xb + (size_t)(pn >> 2) * (8u << 20); const int hc = (pn & 3) * 256 + cl;
            const float sc = pn < 4 ? 1.0f : 0.0625f;
#pragma unroll
            for (int ai = 0; ai < 2; ++ai)
#pragma unroll
                for (int m = 0; m < 4; ++m) {
                    const int row = row0 + ai * 128 + m * 16, pos = row & (SEQ - 1);
                    const f32x4* cp = (const f32x4*)(cosP + pos * 128 + cl); const f32x4* sp = (const f32x4*)(sinP + pos * 128 + cl);
                    f32x4 o1[2], o2[2];
#pragma unroll
                    for (int n = 0; n < 2; ++n) { const f32x4 c = cp[n], s = sp[n], t1 = acc[ai][0][m][n], t2 = acc[ai][1][m][n];
                        o1[n] = (t1 * c - t2 * s) * sc; o2[n] = (t1 * s + t2 * c) * sc; }
                    *(u32x4*)(dst + nfrag(row, hc, 1024)) = pack8(o1[0], o1[1]); *(u32x4*)(dst + nfrag(row, hc + 128, 1024)) = pack8(o2[0], o2[1]);
                    __builtin_amdgcn_sched_barrier(0);
                }
        } else {
            const int mode = pn < 16 ? 0 : (pn < 20 ? 1 : 2);
            const int hc = (pn < 16 ? (pn - 8) : (pn & 3)) * 256 + cl;
            bf16_t* dst = xb + (size_t)(mode + 1) * (8u << 20);
#pragma unroll
            for (int ai = 0; ai < 2; ++ai)
#pragma unroll
                for (int m = 0; m < 4; ++m) {
                    const int row = row0 + ai * 128 + m * 16;
#pragma unroll
                    for (int bj = 0; bj < 2; ++bj) {
                        f32x4 v0 = acc[ai][bj][m][0], v1 = acc[ai][bj][m][1];
                        if (mode == 0) {
#pragma unroll
                            for (int e = 0; e < 4; ++e) { v0[e] = v0[e] * sigmoidf_(v0[e]); v1[e] = v1[e] * sigmoidf_(v1[e]); }
                        } else if (mode == 1) { v0 = v0 * (0.125f * 1.44269504f); v1 = v1 * (0.125f * 1.44269504f); }
                        if (mode == 0) *(u32x4*)(yret + (size_t)row * 2048 + hc + bj * 128) = pack8(v0, v1);
                        else *(u32x4*)(dst + nfrag(row, hc + bj * 128, 1024)) = pack8(v0, v1);
                    }
                }
        }
    }
};

struct EpiInB {
    static constexpr bool PERM = true, AFTER_DRAIN = false;
    bf16_t *kzT; const float *cosT, *sinT;
    DI void operator()(const f32x4 (&acc)[2][2][4][2], const Unit& u, int wr, int wc, int fr_, int fq) const {
        int fr = fr_; asm volatile("" : "+v"(fr));
        const int pm = u.pm, tok0 = u.pn * 256 + wc * 32 + 8 * fq;
        if (pm < 4) {
            const float l2g = log2gamma(pm), ginv = __builtin_amdgcn_exp2f(-l2g);
#pragma unroll
            for (int m = 0; m < 4; ++m) {
                const int i = wr * 64 + m * 16 + fr;
#pragma unroll
                for (int bj = 0; bj < 2; ++bj) {
                    const int tok = tok0 + bj * 128, pos = tok & (SEQ - 1);
                    const f32x4* cp = (const f32x4*)(cosT + i * SEQ + pos); const f32x4* sp = (const f32x4*)(sinT + i * SEQ + pos);
                    f32x4 o1[2], o2[2];
                    float zr = __builtin_amdgcn_exp2f((float)((RCH - 1) - (pos & (RCH - 1))) * l2g) * 0.0625f;
#pragma unroll
                    for (int n = 0; n < 2; ++n) { const f32x4 c = cp[n], s = sp[n], t1 = acc[0][bj][m][n], t2 = acc[1][bj][m][n];
                        f32x4 z;
#pragma unroll
                        for (int e = 0; e < 4; ++e) { z[e] = zr; zr *= ginv; }
                        o1[n] = (t1 * c - t2 * s) * z; o2[n] = (t1 * s + t2 * c) * z; }
                    st_tfrag(kzT, pm * 256 + i, tok, TH, o1[0], o1[1]);
                    st_tfrag(kzT, pm * 256 + 128 + i, tok, TH, o2[0], o2[1]);
                    __builtin_amdgcn_sched_barrier(0);
                }
            }
        } else {
            bf16_t* dst = kzT + (size_t)(pm < 12 ? 8u << 20 : 24u << 20); const int ch0 = (pm < 12 ? (pm - 4) : (pm - 12)) * 256 + wr * 64 + fr;
#pragma unroll
            for (int ai = 0; ai < 2; ++ai)
#pragma unroll
                for (int m = 0; m < 4; ++m)
#pragma unroll
                    for (int bj = 0; bj < 2; ++bj)
                        st_tfrag(dst, ch0 + ai * 128 + m * 16, tok0 + bj * 128, TH, acc[ai][bj][m][0], acc[ai][bj][m][1]);
        }
    }
};

template <int MODE> struct EpiEw {
    static constexpr bool PERM = true, AFTER_DRAIN = false;
    bf16_t* O; const bf16_t* P; int ld;
    DI void operator()(const f32x4 (&acc)[2][2][4][2], const Unit& u, int wr, int wc, int fr_, int fq) const {
        int fr = fr_; asm volatile("" : "+v"(fr));
        const int row0 = u.pm * 256 + wr * 64 + fr, col0 = u.pn * 256 + wc * 32 + 8 * fq;
#pragma unroll
        for (int ai = 0; ai < 2; ++ai)
#pragma unroll
            for (int m = 0; m < 4; ++m)
#pragma unroll
                for (int bj = 0; bj < 2; ++bj) {
                    const size_t off = (size_t)(row0 + ai * 128 + m * 16) * ld + col0 + bj * 128;
                    f32x4 v0 = acc[ai][bj][m][0], v1 = acc[ai][bj][m][1];
                    if (MODE == 0) {
#pragma unroll
                        for (int e = 0; e < 4; ++e) { v0[e] = sigmoidf_(v0[e]); v1[e] = sigmoidf_(v1[e]); }
                    } else if (MODE == 1) {
#pragma unroll
                        for (int e = 0; e < 4; ++e) { const float a = fmaxf(v0[e], 0.f), b = fmaxf(v1[e], 0.f); v0[e] = a * a; v1[e] = b * b; }
                    } else if (MODE == 2) {
                        f32x4 a, b; unpack8(*(const u32x4*)(O + off), a, b); v0 = v0 * a; v1 = v1 * b;
                    } else {
                        f32x4 a, b, c, d; unpack8(*(const u32x4*)(O + off), a, b); unpack8(*(const u32x4*)(P + off), c, d); v0 = a + c * v0; v1 = b + d * v1;
                    }
                    *(u32x4*)(O + off) = pack8(v0, v1);
                }
    }
};

struct EpiRes {
    static constexpr bool PERM = true, AFTER_DRAIN = false;
    const float* xin; float* xout; const float* gate;
    DI void operator()(const f32x4 (&acc)[2][2][4][2], const Unit& u, int wr, int wc, int fr_, int fq) const {
        int fr = fr_; asm volatile("" : "+v"(fr));
        const int row0 = u.pm * 256 + wr * 64 + fr, col0 = u.pn * 256 + wc * 32 + 8 * fq;
#pragma unroll
        for (int ai = 0; ai < 2; ++ai)
#pragma unroll
            for (int m = 0; m < 4; ++m) {
                const int row = row0 + ai * 128 + m * 16; const float* gp = gate + (row >> 12) * NMOD;
#pragma unroll
                for (int bj = 0; bj < 2; ++bj) {
                    const int col = col0 + bj * 128; const size_t off = (size_t)row * DM + col;
                    const f32x4 g0 = *(const f32x4*)(gp + col), g1 = *(const f32x4*)(gp + col + 4);
                    const f32x4 x0 = *(const f32x4*)(xin + off), x1 = *(const f32x4*)(xin + off + 4);
                    *(f32x4*)(xout + off) = x0 + g0 * acc[ai][bj][m][0]; *(f32x4*)(xout + off + 4) = x1 + g1 * acc[ai][bj][m][1];
                }
            }
    }
};

DI void cvt_tile(const float* src, int ldsrc, int k0, int n0, bf16_t* dst1, bf16_t* dst2, int K, LAS float* tile, int tid) {
    const int kr = tid >> 4, nc = (tid & 15) * 4;
#pragma unroll
    for (int p = 0; p < 2; ++p) { const int k = kr + 32 * p; const f32x4 v = *(const f32x4*)(src + (size_t)(k0 + k) * ldsrc + n0 + nc);
        tile[k * 65 + nc] = v[0]; tile[k * 65 + nc + 1] = v[1]; tile[k * 65 + nc + 2] = v[2]; tile[k * 65 + nc + 3] = v[3]; }
    __syncthreads();
    const int n = tid >> 3, ks = (tid & 7) * 8; const LAS float* s = tile + ks * 65 + n;
    u32x4 o; o.x = pk2(s[0], s[65]); o.y = pk2(s[2 * 65], s[3 * 65]); o.z = pk2(s[4 * 65], s[5 * 65]); o.w = pk2(s[6 * 65], s[7 * 65]);
    *(u32x4*)(dst1 + (size_t)n * K + k0 + ks) = o;
    if (dst2) *(u32x4*)(dst2 + (size_t)n * K + k0 + ks) = o;
    __syncthreads();
}

struct Params {
    const float *x, *c, *norm_mix_g, *w_in, *w_ret_out, *w_sb_out, *w_mix_out, *norm_mlp_g, *w_up, *w_down, *w_ada, *b_ada, *final_g;
    float* out; unsigned char* ws;
};

DI void convert_weights(const Params& p, int l, LAS float* tile, int tid) {
    unsigned char* ws = p.ws;
    bf16_t* WinA = (bf16_t*)(ws + WS_WINA); bf16_t* WinB = (bf16_t*)(ws + WS_WINB); bf16_t* Wg = (bf16_t*)(ws + WS_WG);
    constexpr int I_IN = 16 * 176, I_RET = 32 * 16, I_SB = 16 * 16, I_MIX = 16 * 16, I_UP = 16 * 64, I_DN = 64 * 16;
    constexpr int NIT = I_IN + I_RET + I_SB + I_MIX + I_UP + I_DN;
    for (int it = blockIdx.x; it < NIT; it += gridDim.x) {
        int r = it;
        if (r < I_IN) {
            const int kb = r / 176, nb = r % 176, n0 = nb * 64; bf16_t* d1; bf16_t* d2 = nullptr;
            if (n0 < 1024) d1 = WinA + (size_t)n0 * 1024;
            else if (n0 < 2048) { d1 = WinA + (size_t)n0 * 1024; d2 = WinB + (size_t)(n0 - 1024) * 1024; }
            else if (n0 < 4096) d1 = WinB + (size_t)(n0 - 1024) * 1024;
            else if (n0 < 8192) d1 = WinA + (size_t)(n0 - 2048) * 1024;
            else if (n0 < 9216) d1 = WinB + (size_t)(n0 - 5120) * 1024;
            else d1 = Wg + (size_t)(n0 - 9216) * 1024;
            cvt_tile(p.w_in + (size_t)l * DM * INW, INW, kb * 64, n0, d1, d2, 1024, tile, tid); continue;
        }
        r -= I_IN;
        if (r < I_RET) { const int kb = r / 16, nb = r % 16; cvt_tile(p.w_ret_out + (size_t)l * 2048 * 1024, 1024, kb * 64, nb * 64, (bf16_t*)(ws + WS_WRET) + (size_t)nb * 64 * 2048, nullptr, 2048, tile, tid); continue; }
        r -= I_RET;
        if (r < I_SB) { const int kb = r / 16, nb = r % 16; cvt_tile(p.w_sb_out + (size_t)l * 1024 * 1024, 1024, kb * 64, nb * 64, (bf16_t*)(ws + WS_WSB) + (size_t)nb * 64 * 1024, nullptr, 1024, tile, tid); continue; }
        r -= I_SB;
        if (r < I_MIX) { const int kb = r / 16, nb = r % 16; cvt_tile(p.w_mix_out + (size_t)l * 1024 * 1024, 1024, kb * 64, nb * 64, (bf16_t*)(ws + WS_WMIX) + (size_t)nb * 64 * 1024, nullptr, 1024, tile, tid); continue; }
        r -= I_MIX;
        if (r < I_UP) { const int kb = r / 64, nb = r % 64; cvt_tile(p.w_up + (size_t)l * 1024 * 4096, 4096, kb * 64, nb * 64, (bf16_t*)(ws + WS_WUP) + (size_t)nb * 64 * 1024, nullptr, 1024, tile, tid); continue; }
        r -= I_UP;
        { const int kb = r / 16, nb = r % 16; cvt_tile(p.w_down + (size_t)l * 4096 * 1024, 1024, kb * 64, nb * 64, (bf16_t*)(ws + WS_WDN) + (size_t)nb * 64 * 4096, nullptr, 4096, tile, tid); }
    }
}

DI void tables_and_mod(const Params& p, LAS float* lds, int tid) {
    float* cosP = (float*)(p.ws + WS_COSP); float* sinP = (float*)(p.ws + WS_SINP); float* cosT = (float*)(p.ws + WS_COST); float* sinT = (float*)(p.ws + WS_SINT);
    for (int idx = blockIdx.x * 512 + tid; idx < SEQ * 128; idx += gridDim.x * 512) {
        const int pos = idx >> 7, i = idx & 127;
        const float inv = powf(10000.0f, -(float)i / 128.0f); const float ang = (float)pos * inv;
        const float c = cosf(ang), s = sinf(ang);
        cosP[idx] = c; sinP[idx] = s; cosT[i * SEQ + pos] = c; sinT[i * SEQ + pos] = s;
    }
    float* mod = (float*)(p.ws + WS_MOD);
    LAS float* cact = lds; LAS float* red = lds + 4096;
    const int wave = tid >> 6, lane = tid & 63;
    bool have = false;
    for (int it = blockIdx.x; it < 2 * 96; it += gridDim.x) {
        if (!have) { for (int e = tid; e < 4096; e += 512) { const float v = p.c[e]; cact[e] = v * sigmoidf_(v); } have = true; __syncthreads(); }
        const int l = it / 96, c0 = (it % 96) * 64;
        const float* w = p.w_ada + (size_t)l * DM * NMOD + c0 + lane;
        float a0 = 0.f, a1 = 0.f, a2 = 0.f, a3 = 0.f;
#pragma unroll 8
        for (int k = wave * 128; k < wave * 128 + 128; ++k) { const float wv = w[(size_t)k * NMOD]; a0 += cact[k] * wv; a1 += cact[1024 + k] * wv; a2 += cact[2048 + k] * wv; a3 += cact[3072 + k] * wv; }
        red[(wave * 4 + 0) * 64 + lane] = a0; red[(wave * 4 + 1) * 64 + lane] = a1; red[(wave * 4 + 2) * 64 + lane] = a2; red[(wave * 4 + 3) * 64 + lane] = a3;
        __syncthreads();
        if (tid < 256) { const int b = tid >> 6; float s = p.b_ada[l * NMOD + c0 + lane];
#pragma unroll
            for (int w8 = 0; w8 < 8; ++w8) s += red[(w8 * 4 + b) * 64 + lane];
            mod[(size_t)(l * 4 + b) * NMOD + c0 + lane] = s; }
        __syncthreads();
    }
}

DI void norm_phase(const float* xin, const float* g, const float* modl, int shift_i, int scale_i, bf16_t* hout, int gw, int ngw, int lane) {
    for (int row = gw; row < T; row += ngw) {
        const f32x4* xr = (const f32x4*)(xin + (size_t)row * DM) + lane;
        f32x4 v[4]; float s = 0.f;
#pragma unroll
        for (int j = 0; j < 4; ++j) { v[j] = xr[64 * j]; s += (v[j][0] * v[j][0] + v[j][1] * v[j][1]) + (v[j][2] * v[j][2] + v[j][3] * v[j][3]); }
        const float rstd = 1.0f / sqrtf(wave_sum(s) * (1.0f / DM) + 1e-6f);
        const float* mb = modl + (row >> 12) * NMOD;
        u32x2* o8 = (u32x2*)(hout + (size_t)row * DM) + lane;
#pragma unroll
        for (int j = 0; j < 4; ++j) { const int col = 4 * (lane + 64 * j);
            const f32x4 gg = *(const f32x4*)(g + col), sc = *(const f32x4*)(mb + scale_i * 1024 + col), sh = *(const f32x4*)(mb + shift_i * 1024 + col);
            const f32x4 y = v[j] * rstd * gg * (sc + 1.0f) + sh;
            u32x2 w; w.x = pk2(y[0], y[1]); w.y = pk2(y[2], y[3]); o8[64 * j] = w; }
    }
}
DI void final_norm_phase(float* x, const float* g, int gw, int ngw, int lane) {
    for (int row = gw; row < T; row += ngw) {
        f32x4* xr = (f32x4*)(x + (size_t)row * DM) + lane;
        f32x4 v[4]; float s = 0.f;
#pragma unroll
        for (int j = 0; j < 4; ++j) { v[j] = xr[64 * j]; s += (v[j][0] * v[j][0] + v[j][1] * v[j][1]) + (v[j][2] * v[j][2] + v[j][3] * v[j][3]); }
        const float rstd = 1.0f / sqrtf(wave_sum(s) * (1.0f / DM) + 1e-6f);
#pragma unroll
        for (int j = 0; j < 4; ++j) { const f32x4 gg = *(const f32x4*)(g + 4 * (lane + 64 * j)); xr[64 * j] = v[j] * rstd * gg; }
    }
}

struct StateOrder {
    int G, c;
    __device__ __forceinline__ bool next(int i, Unit& u) const { const long L = (long)i * G + c; if (L >= 256) return false; u.pm = (int)L; u.pn = 0; return true; }
    __device__ __forceinline__ void a_ready(const Unit&) const {}
    __device__ __forceinline__ void done(const Unit&) const {}
    __device__ __forceinline__ const char* aptr(const pg8::Gemm& g, const Unit& u, size_t) const { const int bh = u.pm >> 5, n = (u.pm >> 1) & 15, dvh = u.pm & 1, bl = bh >> 2, h = bh & 3;
        return (const char*)g.A + ((size_t)(h * 16 + dvh * 8) * g.ns + bl * (SEQ / 16) + n * (RCH / 16)) * 1024; }
    __device__ __forceinline__ const char* bptr(const pg8::Gemm& g, const Unit& u, size_t) const { const int bh = u.pm >> 5, n = (u.pm >> 1) & 15, bl = bh >> 2, h = bh & 3;
        return (const char*)g.Bt + ((size_t)(h * 8) * g.ns + bl * (SEQ / 16) + n * (RCH / 16)) * 1024; }
};
static_assert(NRCH == 16 && RCH == 256, "StateOrder unit decoding");
struct EpiU {
    static constexpr bool PERM = true, AFTER_DRAIN = false;
    bf16_t* U;
    DI void operator()(const f32x4 (&acc)[2][2][4][2], const Unit& u, int wr, int wc, int fr_, int fq) const {
        int fr = fr_; asm volatile("" : "+v"(fr));
        const int bh = u.pm >> 5, n = (u.pm >> 1) & 15, dvh = u.pm & 1;
        bf16_t* base = U + (size_t)(bh * NRCH + n) * (512 * 256);
#pragma unroll
        for (int ai = 0; ai < 2; ++ai)
#pragma unroll
            for (int m = 0; m < 4; ++m) { const int dv = dvh * 256 + ai * 128 + wr * 64 + m * 16 + fr;
#pragma unroll
                for (int bj = 0; bj < 2; ++bj) { const int dk0 = bj * 128 + wc * 32 + 8 * fq;
                    *(u32x4*)(base + (size_t)((dv >> 5) * 16 + (dk0 >> 4)) * 512 + ((dk0 >> 3) & 1) * 256 + (dv & 31) * 8) = pack8(acc[ai][bj][m][0], acc[ai][bj][m][1]); } }
    }
};
DI void ret_scan(bf16_t* rs, int gtid, int nthreads) {
    for (int e = gtid; e < 8 * 16384; e += nthreads) {
        const int bh = e >> 14, piece = e & 16383; const float dec = __builtin_amdgcn_exp2f((float)RCH * log2gamma(bh & 3));
        u32x4* p = (u32x4*)(rs + (size_t)bh * NRCH * (512 * 256) + (size_t)piece * 8);
        u32x4 uv[NRCH];
#pragma unroll
        for (int n = 0; n < NRCH; ++n) uv[n] = p[(size_t)n * (512 * 256 / 8)];
        f32x4 r0 = {0.f, 0.f, 0.f, 0.f}, r1 = {0.f, 0.f, 0.f, 0.f};
#pragma unroll
        for (int n = 0; n < NRCH; ++n) { p[(size_t)n * (512 * 256 / 8)] = pack8(r0, r1); f32x4 a, b; unpack8(uv[n], a, b); r0 = r0 * dec + a; r1 = r1 * dec + b; }
    }
}

template <bool DIAG> DI void sb_tile(const f32x16& st, int j, int tq, int hh, float& carry, float (&aw)[16]) {
    float lp[16], gs[4], pg[4];
#pragma unroll
    for (int i = 0; i < 16; ++i) { const float z = st[i];
        const float spv = fmaxf(z, 0.f) + __builtin_amdgcn_logf(1.0f + __builtin_amdgcn_exp2f(-fabsf(z)));
        lp[i] = (!DIAG || (j * 32 + crow(i, hh)) < tq) ? -spv : 0.f; }
#pragma unroll
    for (int g = 0; g < 4; ++g) { gs[g] = (lp[4 * g] + lp[4 * g + 1]) + (lp[4 * g + 2] + lp[4 * g + 3]); pg[g] = __shfl_xor(gs[g], 32); }
    float after = carry;
#pragma unroll
    for (int g = 3; g >= 0; --g) {
        float run = after + (hh == 0 ? pg[g] : 0.f);
#pragma unroll
        for (int e = 3; e >= 0; --e) { const int i = 4 * g + e;
            const float w = __builtin_amdgcn_exp2f(st[i] + lp[i] + run);
            aw[i] = (!DIAG || (j * 32 + crow(i, hh)) < tq) ? w : 0.f; run += lp[i]; }
        after += gs[g] + pg[g];
    }
    carry = after;
}
DI void sb_item(int item, const bf16_t* sq, const bf16_t* sk, const bf16_t* svT, bf16_t* ysb, int lane) {
    const int qt = 127 - (item >> 5), h = (item >> 1) & 15, bl = item & 1, r = lane & 31, hh = lane >> 5;
    const size_t rowbase = (size_t)bl * SEQ; const int tq = qt * 32 + r;
    const int rt0 = (int)(rowbase >> 5);
    const bf16_t* qp = sq + (((size_t)(rt0 + qt) * 64 + h * 4) * 2 + hh) * 256 + r * 8;
    bf16x8 qf[4];
#pragma unroll
    for (int ks = 0; ks < 4; ++ks) qf[ks] = *(const bf16x8*)(qp + ks * 512);
    f32x16 o0, o1;
#pragma unroll
    for (int i = 0; i < 16; ++i) { o0[i] = 0.f; o1[i] = 0.f; }
    float carry = 0.f;
    for (int j = qt; j >= 0; --j) {
        const bf16_t* kp = sk + (((size_t)(rt0 + j) * 64 + h * 4) * 2 + hh) * 256 + r * 8;
        const bf16_t* vp = svT + (((size_t)(h * 2) * (TH / 16) + (rowbase >> 4) + 2 * j) * 2 + hh) * 256 + r * 8;
        const bf16x8 k0 = *(const bf16x8*)kp, k1 = *(const bf16x8*)(kp + 512), k2 = *(const bf16x8*)(kp + 1024), k3 = *(const bf16x8*)(kp + 1536);
        const bf16x8 v00 = *(const bf16x8*)vp, v01 = *(const bf16x8*)(vp + 512), v10 = *(const bf16x8*)(vp + (size_t)(TH / 16) * 512), v11 = *(const bf16x8*)(vp + (size_t)(TH / 16) * 512 + 512);
        f32x16 st;
#pragma unroll
        for (int i = 0; i < 16; ++i) st[i] = 0.f;
        st = MFMA32(k0, qf[0], st); st = MFMA32(k1, qf[1], st); st = MFMA32(k2, qf[2], st); st = MFMA32(k3, qf[3], st);
        float aw[16];
        if (j == qt) sb_tile<true>(st, j, tq, hh, carry, aw); else sb_tile<false>(st, j, tq, hh, carry, aw);
        {
            u32x4 bw; bw.x = pk2(aw[0], aw[1]); bw.y = pk2(aw[2], aw[3]); bw.z = pk2(aw[4], aw[5]); bw.w = pk2(aw[6], aw[7]);
            const bf16x8 b0 = __builtin_bit_cast(bf16x8, bw);
            bw.x = pk2(aw[8], aw[9]); bw.y = pk2(aw[10], aw[11]); bw.z = pk2(aw[12], aw[13]); bw.w = pk2(aw[14], aw[15]);
            const bf16x8 b1 = __builtin_bit_cast(bf16x8, bw);
            o0 = MFMA32(v00, b0, o0); o1 = MFMA32(v10, b0, o1); o0 = MFMA32(v01, b1, o0); o1 = MFMA32(v11, b1, o1);
        }
        if (__all(carry < SB_STOP)) break;
    }
    bf16_t* op = ysb + (rowbase + tq) * 1024 + h * 64 + 4 * hh;
#pragma unroll
    for (int g = 0; g < 4; ++g) {
        u32x2 w; w.x = pk2(o0[4 * g], o0[4 * g + 1]); w.y = pk2(o0[4 * g + 2], o0[4 * g + 3]); *(u32x2*)(op + 8 * g) = w;
        u32x2 w1; w1.x = pk2(o1[4 * g], o1[4 * g + 1]); w1.y = pk2(o1[4 * g + 2], o1[4 * g + 3]); *(u32x2*)(op + 32 + 8 * g) = w1;
    }
}

DI void ret_out_item(int item, const bf16_t* qr, const bf16_t* kn, const bf16_t* vT, const bf16_t* rsnap, bf16_t* yret, LAS unsigned char* lds, int wave, int lane) {
    const int bh = item >> 5, c = (item >> 3) & 1, n = ((item >> 4) & 1) * 8 + (item & 7), tg = n * CPG + c, bl = bh >> 2, h = bh & 3, r = lane & 31, hh = lane >> 5;
    const int a = c * 4, tokg = tg * 128;
    static_assert(CPG == 2, "item decoding above assumes two 128-token groups per retention chunk");
    const size_t rowbase = (size_t)bl * SEQ; const int rt0 = (int)(rowbase >> 5);
    const float l2g = log2gamma(h);
    LAS float* stats = (LAS float*)(lds + 131072 + 256);
    {
        const int tt = wave & 3, par = wave >> 2, tq = tokg + tt * 32 + r;
        const bf16_t* qp = qr + (((size_t)(rt0 + (tokg >> 5) + tt) * 64 + h * 16) * 2 + hh) * 256 + r * 8;
        bf16x8 qf[16];
#pragma unroll
        for (int ks = 0; ks < 16; ++ks) qf[ks] = *(const bf16x8*)(qp + ks * 512);
        for (int jk = par; jk <= a + tt; jk += 2) {
            const int keyt = n * (RCH / 32) + jk;
            const bf16_t* kp = kn + (((size_t)(rt0 + keyt) * 64 + h * 16) * 2 + hh) * 256 + r * 8;
            f32x16 st;
#pragma unroll
            for (int i = 0; i < 16; ++i) st[i] = 0.f;
#pragma unroll
            for (int ks = 0; ks < 16; ++ks) st = MFMA32(*(const bf16x8*)(kp + ks * 512), qf[ks], st);
            float pw[16];
#pragma unroll
            for (int i = 0; i < 16; ++i) { const int d = tq - (keyt * 32 + crow(i, hh)); pw[i] = d >= 0 ? st[i] * __builtin_amdgcn_exp2f((float)d * l2g) : 0.f; }
#pragma unroll
            for (int s = 0; s < 2; ++s) {
                u32x4 bw; bw.x = pk2(pw[8 * s], pw[8 * s + 1]); bw.y = pk2(pw[8 * s + 2], pw[8 * s + 3]); bw.z = pk2(pw[8 * s + 4], pw[8 * s + 5]); bw.w = pk2(pw[8 * s + 6], pw[8 * s + 7]);
                *(LAS u32x4*)(lds + ((2 * jk + s) * 4 + tt) * 1024 + lane * 16) = bw;
            }
        }
    }
    __syncthreads();
    f32x16 acc[8];
#pragma unroll
    for (int q = 0; q < 8; ++q)
#pragma unroll
        for (int i = 0; i < 16; ++i) acc[q][i] = 0.f;
    {
        const bf16_t* rp = rsnap + (size_t)(bh * NRCH + n) * (512 * 256) + (size_t)(wave * 2 * 16) * 512 + hh * 256 + r * 8;
        const bf16_t* qg = qr + (((size_t)(rt0 + (tokg >> 5)) * 64 + h * 16) * 2 + hh) * 256 + r * 8;
#pragma unroll 2
        for (int ks = 0; ks < 16; ++ks) {
            const bf16x8 a0 = *(const bf16x8*)(rp + ks * 512), a1 = *(const bf16x8*)(rp + (16 + ks) * 512);
#pragma unroll
            for (int tt = 0; tt < 4; ++tt) { const bf16x8 b = *(const bf16x8*)(qg + (size_t)(tt * 64 + ks) * 512);
                acc[tt] = MFMA32(a0, b, acc[tt]); acc[4 + tt] = MFMA32(a1, b, acc[4 + tt]); }
        }
#pragma unroll
        for (int tt = 0; tt < 4; ++tt) { const float xi = __builtin_amdgcn_exp2f((float)(((tokg + tt * 32 + r) & (RCH - 1)) + 1) * l2g);
#pragma unroll
            for (int i = 0; i < 16; ++i) { acc[tt][i] *= xi; acc[4 + tt][i] *= xi; } }
    }
    {
        const bf16_t* vb = vT + (((size_t)(h * 16 + wave * 2) * (TH / 16) + (rowbase >> 4) + n * (RCH / 16)) * 2 + hh) * 256 + r * 8;
        const int ns = 2 * (a + 4);
#pragma unroll 2
        for (int s = 0; s < ns; ++s) {
            const bf16x8 a0 = *(const bf16x8*)(vb + (size_t)s * 512), a1 = *(const bf16x8*)(vb + (size_t)(TH / 16 + s) * 512);
            const int ttmin = (s >> 1) - a;
#pragma unroll
            for (int tt = 0; tt < 4; ++tt) if (tt >= ttmin) { const bf16x8 b = *(const LAS bf16x8*)(lds + (s * 4 + tt) * 1024 + lane * 16);
                acc[tt] = MFMA32(a0, b, acc[tt]); acc[4 + tt] = MFMA32(a1, b, acc[4 + tt]); }
        }
    }
#pragma unroll
    for (int tt = 0; tt < 4; ++tt) {
        float s1 = 0.f, s2 = 0.f;
#pragma unroll
        for (int i = 0; i < 16; ++i) { const float v0 = acc[tt][i], v1 = acc[4 + tt][i]; s1 += v0 + v1; s2 += v0 * v0 + v1 * v1; }
        s1 += __shfl_xor(s1, 32); s2 += __shfl_xor(s2, 32);
        if (hh == 0) { stats[(wave * 128 + tt * 32 + r) * 2] = s1; stats[(wave * 128 + tt * 32 + r) * 2 + 1] = s2; }
    }
    __syncthreads();
#pragma unroll
    for (int tt = 0; tt < 4; ++tt) {
        float s1 = 0.f, s2 = 0.f;
#pragma unroll
        for (int w = 0; w < 8; ++w) { s1 += stats[(w * 128 + tt * 32 + r) * 2]; s2 += stats[(w * 128 + tt * 32 + r) * 2 + 1]; }
        const float mu = s1 * (1.0f / 512.0f), var = fmaxf(s2 * (1.0f / 512.0f) - mu * mu, 0.f), rstd = 1.0f / sqrtf(var + 1e-5f);
        bf16_t* op = yret + (rowbase + tokg + tt * 32 + r) * 2048 + h * 512 + wave * 64 + 4 * hh;
#pragma unroll
        for (int dvt = 0; dvt < 2; ++dvt)
#pragma unroll
            for (int g = 0; g < 4; ++g) {
                u32x2* pp = (u32x2*)(op + dvt * 32 + 8 * g); const u32x2 gv = *pp; const f32x16& o = acc[dvt * 4 + tt];
                u32x2 w; w.x = pk2(bflo(gv.x) * (o[4 * g] - mu) * rstd, bfhi(gv.x) * (o[4 * g + 1] - mu) * rstd);
                w.y = pk2(bflo(gv.y) * (o[4 * g + 2] - mu) * rstd, bfhi(gv.y) * (o[4 * g + 3] - mu) * rstd); *pp = w;
            }
    }
    __syncthreads();
}

#define XB_TMO      128
#define XB_XCNT(j)  (256  + 64 * (j))
#define XB_XSUB(j)  (1280 + 64 * (j))
#define XB_XGEN(j)  (2304 + 64 * (j))
#define XB_TOP      3328
#define XB_TOPGEN   3392
#define XCD_BAR_WORDS 3456
#define XB_SPIN_CAP (1u << 18)

__device__ __forceinline__ unsigned xb_ld(unsigned* p)              { return __hip_atomic_load(p, __ATOMIC_RELAXED, __HIP_MEMORY_SCOPE_AGENT); }
__device__ __forceinline__ unsigned xb_add(unsigned* p, unsigned v) { return __hip_atomic_fetch_add(p, v, __ATOMIC_RELAXED, __HIP_MEMORY_SCOPE_AGENT); }
__device__ __forceinline__ unsigned xb_xcc_id() { return (unsigned)__builtin_amdgcn_s_getreg((3 << 11) | 20) & 0xFu; }
#define XB_SPIN(cond, bar) do { unsigned _sp = 0; while (cond) { __builtin_amdgcn_s_sleep(1); \
    if ((++_sp & 255u) == 0u) { if (xb_ld(&(bar)[XB_TMO])) break; if (_sp > XB_SPIN_CAP) { atomicAdd(&(bar)[XB_TMO], 1u); break; } } } } while (0)

struct XcdBarrier {
    unsigned* bar; unsigned x;
    volatile LAS unsigned* st;
};

__device__ __forceinline__ XcdBarrier xcd_barrier_post(unsigned* bar, volatile LAS unsigned* st) {
    XcdBarrier b; b.bar = bar; b.x = xb_xcc_id(); b.st = st;
    if (threadIdx.x == 0) (void)xb_add(&bar[XB_XCNT(b.x)], 1u);
    return b;
}
__device__ __forceinline__ void xcd_barrier_complete(unsigned* bar, unsigned x, unsigned& nloc, unsigned& nx) {
    const unsigned G = gridDim.x * gridDim.y * gridDim.z;
    unsigned sum, cnt, mine, sp = 0u;
    for (;;) {
        sum = 0u; cnt = 0u; mine = 0u;
#pragma unroll
        for (unsigned j = 0; j < 16; ++j) { const unsigned c = xb_ld(&bar[XB_XCNT(j)]); sum += c; cnt += (c > 0u) ? 1u : 0u; mine = (j == x) ? c : mine; }
        if (sum == G) break;
        __builtin_amdgcn_s_sleep(1);
        if ((++sp & 255u) == 0u) { if (xb_ld(&bar[XB_TMO])) break; if (sp > XB_SPIN_CAP) { atomicAdd(&bar[XB_TMO], 1u); break; } }
    }
    nloc = mine > 0u ? mine : 1u; nx = cnt > 0u ? cnt : 1u;
}

__device__ __forceinline__ void xcd_barrier(const XcdBarrier& b) {
    asm volatile("s_waitcnt vmcnt(0)" ::: "memory");
    __syncthreads();
    if (threadIdx.x == 0) {
        unsigned* bar = b.bar;
        __builtin_amdgcn_s_waitcnt(0);
        unsigned nloc = b.st[0], nx = b.st[1];
        if (nloc == 0u) { xcd_barrier_complete(bar, b.x, nloc, nx); b.st[0] = nloc; b.st[1] = nx; }
        const unsigned old = xb_add(&bar[XB_XSUB(b.x)], 1u);
        const unsigned gen = old / nloc;
        if (old + 1u == (gen + 1u) * nloc) {
            __builtin_amdgcn_fence(__ATOMIC_RELEASE, "agent");
            asm volatile("s_waitcnt vmcnt(0)" ::: "memory");
            const unsigned og = xb_add(&bar[XB_TOP], 1u);
            const unsigned tg = og / nx;
            if (og + 1u == (tg + 1u) * nx) xb_add(&bar[XB_TOPGEN], 1u);
            else XB_SPIN(xb_ld(&bar[XB_TOPGEN]) == tg, bar);
            __builtin_amdgcn_fence(__ATOMIC_ACQUIRE, "agent");
            xb_add(&bar[XB_XGEN(b.x)], 1u);
            asm volatile("s_waitcnt vmcnt(0)" ::: "memory");
        } else {
            XB_SPIN(xb_ld(&bar[XB_XGEN(b.x)]) == gen, bar);
            __builtin_amdgcn_fence(__ATOMIC_ACQUIRE, "agent");
            asm volatile("s_waitcnt vmcnt(0)" ::: "memory");
        }
    }
    __syncthreads();
}

__global__ void __launch_bounds__(512, 2) hybrid_fwd(Params p) {
    extern __shared__ __attribute__((aligned(16))) unsigned char lds_raw[];
    cg::grid_group grid = cg::this_grid();
    PG8_LAS unsigned char* lds = (PG8_LAS unsigned char*)lds_raw;
    LAS float* ldsf = (LAS float*)lds_raw;
#if PROBE_CLASS >= 0
    unsigned long long tacc = 0, tst = 0;
#define TSTART() (tst = __builtin_amdgcn_s_memrealtime())
#define TSTOP(c) do { if ((c) == PROBE_CLASS) tacc += __builtin_amdgcn_s_memrealtime() - tst; } while (0)
#else
#define TSTART() ((void)0)
#define TSTOP(c) ((void)0)
#endif
    volatile LAS unsigned* xst = (volatile LAS unsigned*)(lds_raw + 131072 + 64);
    if (threadIdx.x < 2) xst[threadIdx.x] = 0u;
    __syncthreads();
    const XcdBarrier xbar = xcd_barrier_post((unsigned*)(p.ws + WS_BAR), xst);
#define GBAR() xcd_barrier(xbar)
#if PROBE_CLASS == 9
#define GSYNC(site) do { GBAR(); TSTART(); GBAR(); TSTOP(9); } while (0)
#else
#define GSYNC(site) do { TSTART(); GBAR(); if ((PROBE_SITEMASK >> (site)) & 1) TSTOP(0); } while (0)
#endif
#define PH_BEGIN int tid = threadIdx.x; asm volatile("" : "+v"(tid)); int bx = blockIdx.x, G = gridDim.x; asm volatile("" : "+s"(bx), "+s"(G)); \
    unsigned char* ws = p.ws; asm volatile("" : "+s"(ws)); float* xo = p.out; asm volatile("" : "+s"(xo)); \
    const int lane = tid & 63, wave = __builtin_amdgcn_readfirstlane(tid >> 6), gw = bx * 8 + wave, ngw = G * 8; (void)lane; (void)wave; (void)gw; (void)ngw; \
    const float* modl = (const float*)(ws + WS_MOD) + (size_t)l * 4 * NMOD; (void)modl; bf16_t* H = (bf16_t*)(ws + WS_H); (void)H;
#pragma unroll 1
    for (int l = 0; l < 2; ++l) {
        TSTART(); { PH_BEGIN
          if (l == 0) { tables_and_mod(p, ldsf, tid); __syncthreads(); }
          convert_weights(p, l, ldsf, tid); } TSTOP(4);
        if (l == 0) grid.sync();
        TSTART(); { PH_BEGIN
          norm_phase(l == 0 ? p.x : xo, p.norm_mix_g + l * DM, modl, 0, 1, H, gw, ngw, lane); } TSTOP(5);
        GSYNC(1);
#pragma unroll 1
        for (int half = 0; half < 2; ++half) {
            TSTART(); { PH_BEGIN
              pg8::Gemm g{H + (size_t)half * TH * DM, (const bf16_t*)(ws + WS_WINA), TH, 6144, DM}; pg8::StaticOrder S; S.init(TH, 6144, G, bx);
              EpiInA E{(bf16_t*)(ws + WS_X), (bf16_t*)(ws + WS_YRET) + (size_t)half * TH * 2048, (const float*)(ws + WS_COSP), (const float*)(ws + WS_SINP)};
              pg8::gemm_phase<EpiInA, pg8::StaticOrder, true, true>(lds, g, S, E); } TSTOP(1);
            TSTART(); { PH_BEGIN
              pg8::Gemm g{(const bf16_t*)(ws + WS_WINB), H + (size_t)half * TH * DM, 4096, TH, DM}; pg8::StaticOrder S; S.init(4096, TH, G, bx);
              EpiInB E{(bf16_t*)(ws + WS_KZT), (const float*)(ws + WS_COST), (const float*)(ws + WS_SINT)};
              pg8::gemm_phase<EpiInB, pg8::StaticOrder, true, true>(lds, g, S, E); } TSTOP(1);
            GSYNC(2);
            TSTART(); { PH_BEGIN
              pg8::Gemm g{(const bf16_t*)(ws + WS_VT), (const bf16_t*)(ws + WS_KZT), 256, 256, RCH, 1, TH / 16}; StateOrder S{G, bx};
              EpiU E{(bf16_t*)(ws + WS_RSNAP)};
              pg8::gemm_phase<EpiU, StateOrder, false, true>(lds, g, S, E); } TSTOP(2);
            GSYNC(10);
            TSTART(); { PH_BEGIN
              ret_scan((bf16_t*)(ws + WS_RSNAP), bx * 512 + tid, G * 512);
              unsigned* qctr = (unsigned*)(ws + WS_BAR) + (l * 2 + half) * 16;
              for (;;) {
                  unsigned it = 0; if (lane == 0) it = __hip_atomic_fetch_add(qctr, 1u, __ATOMIC_RELAXED, __HIP_MEMORY_SCOPE_AGENT);
                  it = __builtin_amdgcn_readfirstlane(it);
                  if (it >= 4096u) break;
                  sb_item((int)it, (const bf16_t*)(ws + WS_SQ), (const bf16_t*)(ws + WS_SK), (const bf16_t*)(ws + WS_SVT), (bf16_t*)(ws + WS_YSB) + (size_t)half * TH * 1024, lane);
              } } TSTOP(6);
            GSYNC(3);
            TSTART(); { PH_BEGIN
              for (int it = bx; it < 256; it += G) ret_out_item(it, (const bf16_t*)(ws + WS_QR), (const bf16_t*)(ws + WS_KN), (const bf16_t*)(ws + WS_VT), (const bf16_t*)(ws + WS_RSNAP), (bf16_t*)(ws + WS_YRET) + (size_t)half * TH * 2048, (LAS unsigned char*)lds_raw, wave, lane); } TSTOP(3);
            GSYNC(4);
        }
        TSTART(); { PH_BEGIN pg8::StaticOrder S; S.init(T, DM, G, bx);
          pg8::Gemm g{H, (const bf16_t*)(ws + WS_WG), T, DM, DM}; EpiEw<0> E{(bf16_t*)(ws + WS_MERGED), nullptr, DM}; pg8::gemm_phase<EpiEw<0>, pg8::StaticOrder, false, true>(lds, g, S, E); } TSTOP(7);
        TSTART(); { PH_BEGIN pg8::StaticOrder S; S.init(T, DM, G, bx);
          pg8::Gemm g{(const bf16_t*)(ws + WS_YRET), (const bf16_t*)(ws + WS_WRET), T, DM, 2048}; EpiEw<2> E{(bf16_t*)(ws + WS_MERGED), nullptr, DM}; pg8::gemm_phase<EpiEw<2>, pg8::StaticOrder, false, true>(lds, g, S, E); } TSTOP(7);
        TSTART(); { PH_BEGIN pg8::StaticOrder S; S.init(T, DM, G, bx);
          pg8::Gemm g{H, (const bf16_t*)(ws + WS_WG) + (size_t)1024 * 1024, T, DM, DM}; EpiEw<0> E{(bf16_t*)(ws + WS_TMP), nullptr, DM}; pg8::gemm_phase<EpiEw<0>, pg8::StaticOrder, false, true>(lds, g, S, E); } TSTOP(7);
        TSTART(); { PH_BEGIN pg8::StaticOrder S; S.init(T, DM, G, bx);
          pg8::Gemm g{(const bf16_t*)(ws + WS_YSB), (const bf16_t*)(ws + WS_WSB), T, DM, DM}; EpiEw<3> E{(bf16_t*)(ws + WS_MERGED), (const bf16_t*)(ws + WS_TMP), DM}; pg8::gemm_phase<EpiEw<3>, pg8::StaticOrder, false, true>(lds, g, S, E); } TSTOP(7);
        GSYNC(5);
        TSTART(); { PH_BEGIN pg8::StaticOrder S; S.init(T, DM, G, bx);
          pg8::Gemm g{(const bf16_t*)(ws + WS_MERGED), (const bf16_t*)(ws + WS_WMIX), T, DM, DM}; EpiRes E{l == 0 ? p.x : xo, xo, modl + 2 * 1024};
          pg8::gemm_phase<EpiRes, pg8::StaticOrder, false, true>(lds, g, S, E); } TSTOP(7);
        GSYNC(6);
        TSTART(); { PH_BEGIN
          norm_phase(xo, p.norm_mlp_g + l * DM, modl, 3, 4, H, gw, ngw, lane); } TSTOP(5);
        GSYNC(7);
        TSTART(); { PH_BEGIN pg8::StaticOrder S; S.init(T, FF, G, bx);
          pg8::Gemm g{H, (const bf16_t*)(ws + WS_WUP), T, FF, DM}; EpiEw<1> E{(bf16_t*)(ws + WS_U), nullptr, FF};
          pg8::gemm_phase<EpiEw<1>, pg8::StaticOrder, true, true>(lds, g, S, E); } TSTOP(8);
        GSYNC(8);
        TSTART(); { PH_BEGIN pg8::StaticOrder S; S.init(T, DM, G, bx);
          pg8::Gemm g{(const bf16_t*)(ws + WS_U), (const bf16_t*)(ws + WS_WDN), T, DM, FF}; EpiRes E{xo, xo, modl + 5 * 1024};
          pg8::gemm_phase<EpiRes, pg8::StaticOrder, false, true>(lds, g, S, E); } TSTOP(8);
        GSYNC(9);
    }
    TSTART(); { const int l = 0; PH_BEGIN
      final_norm_phase(xo, p.final_g, gw, ngw, lane); } TSTOP(5);
#if PROBE_CLASS >= 0
    grid.sync();
    if (blockIdx.x == 0) { const unsigned kk = (unsigned)(tacc * 4ull / 25ull);
        for (unsigned i = threadIdx.x; i < kk; i += 512) p.out[i] += 0.1f; }
#endif
#undef PH_BEGIN
}

extern "C" void kernel_launch(void* const* d_in, const int* in_sizes, int n_in, void* d_out, int out_size, void* d_ws, size_t ws_size, hipStream_t stream) {
    static int grid_blocks = 0;
    if (grid_blocks == 0) {
        if (n_in != 13 || out_size != T * DM || ws_size < WS_END) { fprintf(stderr, "kernel_launch: unexpected shapes (n_in %d out %d ws %zu need %zu)\n", n_in, out_size, ws_size, (size_t)WS_END); grid_blocks = -1; return; }
        int dev = 0, cus = 0, per_cu = 0;
        (void)hipGetDevice(&dev); (void)hipDeviceGetAttribute(&cus, hipDeviceAttributeMultiprocessorCount, dev);
        if (hipFuncSetAttribute((const void*)hybrid_fwd, hipFuncAttributeMaxDynamicSharedMemorySize, LDS_BYTES) != hipSuccess) { fprintf(stderr, "kernel_launch: hipFuncSetAttribute failed\n"); grid_blocks = -1; return; }
        if (hipOccupancyMaxActiveBlocksPerMultiprocessor(&per_cu, (const void*)hybrid_fwd, 512, LDS_BYTES) != hipSuccess || per_cu < 1) { fprintf(stderr, "kernel_launch: occupancy query gave %d\n", per_cu); per_cu = 1; (void)hipGetLastError(); }
        grid_blocks = cus * per_cu;
    }
    if (grid_blocks < 0) return;
    Params p{};
    p.x = (const float*)d_in[0]; p.c = (const float*)d_in[1]; p.norm_mix_g = (const float*)d_in[2]; p.w_in = (const float*)d_in[3]; p.w_ret_out = (const float*)d_in[4];
    p.w_sb_out = (const float*)d_in[5]; p.w_mix_out = (const float*)d_in[6]; p.norm_mlp_g = (const float*)d_in[7]; p.w_up = (const float*)d_in[8]; p.w_down = (const float*)d_in[9];
    p.w_ada = (const float*)d_in[10]; p.b_ada = (const float*)d_in[11]; p.final_g = (const float*)d_in[12];
    p.out = (float*)d_out; p.ws = (unsigned char*)d_ws;
    if (hipMemsetAsync((char*)d_ws + WS_BAR, 0, XCD_BAR_WORDS * 4, stream) != hipSuccess) { fprintf(stderr, "kernel_launch: memset failed\n"); return; }
    void* args[] = {&p};
    hipError_t e = hipLaunchCooperativeKernel((const void*)hybrid_fwd, dim3(grid_blocks), dim3(512), args, LDS_BYTES, stream);
    if (e != hipSuccess) fprintf(stderr, "kernel_launch: cooperative launch failed: %s (grid %d)\n", hipGetErrorString(e), grid_blocks);
}
```

```cpp
#include <hip/hip_runtime.h>
#include <hip/hip_cooperative_groups.h>
#include <cstdio>
#include <cstdint>
namespace cg = cooperative_groups;
#define DI __device__ __forceinline__
#define PROBE_CLASS -1
#define PROBE_SITEMASK 0xFFFF
namespace pg8 {
#define PG8_LAS __attribute__((address_space(3)))
typedef unsigned short bf16_t;
typedef short bf16x8 __attribute__((ext_vector_type(8)));
typedef float f32x4 __attribute__((ext_vector_type(4)));
typedef unsigned u32x4 __attribute__((ext_vector_type(4)));
constexpr int BM = 256, BK = 64, HALF = 128, HTB = HALF * BK * 2  , STAGE_BYTES = 8 * HTB, NXCD = 8, WGM = 8;

__host__ __device__ __forceinline__ int lds_byte(int r, int c) { const int st = (r >> 4) * 2 + (c >> 5), rr = r & 15, cc = c & 31, ob = rr * 64 + cc * 2; return st * 1024 + (ob ^ (((ob >> 9) & 1) << 5)); }
__host__ __device__ __forceinline__ void stage_rc(int b, int& R, int& C) { const int st = b / 1024, sb = b % 1024, swz = sb ^ (((sb >> 9) & 1) << 5); R = (st >> 1) * 16 + swz / 64; C = (st & 1) * 32 + (swz % 64) / 2; }
__host__ __device__ __forceinline__ int perm32(int rho) { const int n = rho >> 4, i = rho & 15; return 8 * (i >> 2) + 4 * n + (i & 3); }

struct Unit { int pm, pn; };
struct Gemm { const bf16_t* A; const bf16_t* Bt; int M, N, K; int frag, ns; };

struct StaticOrder {
    int nM, nN, nwg, G, c;
    __host__ __device__ void init(int M, int N, int G_, int c_) { nM = M / BM; nN = N / BM; nwg = nM * nN; G = G_; c = c_; }
    __host__ __device__ bool next(int i, Unit& u) const {
        const long L = (long)i * G + c; if (L >= nwg) return false;
        int wgid = (int)L; { const int q = nwg / NXCD, r = nwg % NXCD, xcd = wgid % NXCD, off = wgid / NXCD; wgid = (xcd < r ? xcd * (q + 1) : r * (q + 1) + (xcd - r) * q) + off; }
        const int nig = WGM * nN, gid = wgid / nig, fm = gid * WGM, gsz = (nM - fm) < WGM ? (nM - fm) : WGM;
        u.pm = fm + ((wgid % nig) % gsz); u.pn = (wgid % nig) / gsz; return true;
    }
    __device__ __forceinline__ void a_ready(const Unit&) const {}
    __device__ __forceinline__ void done(const Unit&) const {}
    __device__ __forceinline__ const char* aptr(const Gemm& g, const Unit& u, size_t tstep) const { return (const char*)g.A + (size_t)u.pm * tstep; }
    __device__ __forceinline__ const char* bptr(const Gemm& g, const Unit& u, size_t tstep) const { return (const char*)g.Bt + (size_t)u.pn * tstep; }
};

template <class Epi, class Sched, bool ALIGN_EPI = false, bool SP2 = false>
__device__ __forceinline__ void gemm_phase(PG8_LAS unsigned char* lds, const Gemm g, const Sched& S, const Epi& E) {
    int tid_l = threadIdx.x; asm volatile("" : "+v"(tid_l)); const int tid = tid_l, wid = __builtin_amdgcn_readfirstlane(tid >> 6), lane = tid & 63, wr = wid >> 2, wc = wid & 3, fr = lane & 15, fq = lane >> 4;
    const int K = g.K, nt = K / BK;
    unsigned voffA[2], voffB[2];
#pragma unroll
    for (int i = 0; i < 2; ++i) { int R, C; stage_rc(tid * 16 + i * 8192, R, C); const int Rb = Epi::PERM ? ((R & ~31) + perm32(R & 31)) : R;
        if (g.frag) { const unsigned rtile = (unsigned)g.ns * 1024u, kc = (unsigned)((C >> 4) * 1024 + ((C >> 3) & 1) * 512);
            voffA[i] = (unsigned)(R >> 5) * rtile + kc + (unsigned)(R & 31) * 16u; voffB[i] = (unsigned)(Rb >> 5) * rtile + kc + (unsigned)(Rb & 31) * 16u; }
        else { voffA[i] = (unsigned)(R * K + C) * 2u; voffB[i] = (unsigned)(Rb * K + C) * 2u; } }
    const size_t kstep = g.frag ? (size_t)4096 : (size_t)(BK * 2);
    const size_t hstep = g.frag ? (size_t)4 * g.ns * 1024 : (size_t)HALF * K * 2;
    const size_t tstep = 2 * hstep;
    const unsigned ldsw = (unsigned)wid * 1024u;
    const int aoff = lds_byte(wr * 64 + fr, fq * 8), boff = lds_byte(wc * 32 + fr, fq * 8);
#define PG8_SA(b, h) (((b) * 2 + (h)) * HTB)
#define PG8_SB(b, h) ((4 + (b) * 2 + (h)) * HTB)
#define PG8_STAGE(bufoff, gbase, voff) do { _Pragma("unroll") for (int _i = 0; _i < 2; ++_i) \
        __builtin_amdgcn_global_load_lds((const unsigned*)((const char*)(gbase) + (voff)[_i]), (PG8_LAS unsigned*)(lds + (bufoff) + ldsw + _i * 8192), 16, 0, 0); } while (0)
#define PG8_LDA(dst, b, h) do { _Pragma("unroll") for (int m = 0; m < 4; ++m) _Pragma("unroll") for (int k = 0; k < 2; ++k) dst[m][k] = *(const PG8_LAS bf16x8*)(lds + PG8_SA(b, h) + aoff + m * 2048 + k * 1024); } while (0)
#define PG8_LDB(dst, b, h) do { _Pragma("unroll") for (int n = 0; n < 2; ++n) _Pragma("unroll") for (int k = 0; k < 2; ++k) dst[n][k] = *(const PG8_LAS bf16x8*)(lds + PG8_SB(b, h) + boff + n * 2048 + k * 1024); } while (0)
#define PG8_MMA(ai, bj, At, Bt) do { __builtin_amdgcn_s_setprio(1); _Pragma("unroll") for (int m = 0; m < 4; ++m) _Pragma("unroll") for (int n = 0; n < 2; ++n) _Pragma("unroll") for (int k = 0; k < 2; ++k) \
        acc[ai][bj][m][n] = __builtin_amdgcn_mfma_f32_16x16x32_bf16(Bt[n][k], At[m][k], acc[ai][bj][m][n], 0, 0, 0); __builtin_amdgcn_s_setprio(0); } while (0)
#define PG8_WAIT_V(n) asm volatile("s_waitcnt vmcnt(" #n ")" ::: "memory")
#define PG8_WAIT_L(n) asm volatile("s_waitcnt lgkmcnt(" #n ")" ::: "memory")
#define PG8_BAR __builtin_amdgcn_s_barrier()
#define PG8_SCHED __builtin_amdgcn_sched_barrier(0)
    Unit cur, nxt; int ui = 0;
    if (!S.next(0, cur)) return;
    f32x4 acc[2][2][4][2];
#pragma unroll
    for (int a = 0; a < 2; ++a)
#pragma unroll
        for (int b = 0; b < 2; ++b)
#pragma unroll
            for (int m = 0; m < 4; ++m)
#pragma unroll
                for (int n = 0; n < 2; ++n) acc[a][b][m][n] = (f32x4){0.f, 0.f, 0.f, 0.f};
    bf16x8 At[4][2], B0[2][2], B1[2][2];
    const char* cA = S.aptr(g, cur, tstep); const char* cB = S.bptr(g, cur, tstep);
    S.a_ready(cur);
    if constexpr (SP2) {
        PG8_STAGE(PG8_SB(0, 0), cB, voffB); PG8_STAGE(PG8_SB(0, 1), cB + hstep, voffB); PG8_STAGE(PG8_SA(0, 0), cA, voffA); PG8_STAGE(PG8_SA(0, 1), cA + hstep, voffA);
        if (wr == 1) PG8_BAR;
        PG8_WAIT_V(2); PG8_BAR;
        PG8_STAGE(PG8_SB(1, 0), cB + kstep, voffB); PG8_STAGE(PG8_SA(1, 0), cA + kstep, voffA); PG8_STAGE(PG8_SB(1, 1), cB + hstep + kstep, voffB);
        PG8_WAIT_V(6); PG8_BAR;
    } else {
        PG8_STAGE(PG8_SB(0, 0), cB, voffB); PG8_STAGE(PG8_SA(0, 0), cA, voffA); PG8_STAGE(PG8_SB(0, 1), cB + hstep, voffB); PG8_STAGE(PG8_SA(0, 1), cA + hstep, voffA);
        if (wr == 1) PG8_BAR;
        PG8_WAIT_V(4); PG8_BAR;
        PG8_STAGE(PG8_SB(1, 0), cB + kstep, voffB); PG8_STAGE(PG8_SA(1, 0), cA + kstep, voffA); PG8_STAGE(PG8_SB(1, 1), cB + hstep + kstep, voffB);
        PG8_WAIT_V(6); PG8_BAR;
    }
    for (;;) {
        const bool has_next = S.next(ui + 1, nxt);
        const char* nA = has_next ? S.aptr(g, nxt, tstep) : cA; const char* nB = has_next ? S.bptr(g, nxt, tstep) : cB;
        for (int t = 0; t < nt; t += 2) {
            const bool last = (t == nt - 2);
            const char* a1 = cA + (size_t)(t + 1) * kstep;
            const char* a2 = last ? nA : cA + (size_t)(t + 2) * kstep; const char* b2 = last ? nB : cB + (size_t)(t + 2) * kstep;
            const char* a3 = a2 + kstep; const char* b3 = b2 + kstep;
            if (last && has_next) S.a_ready(nxt);
            if constexpr (SP2) {
            PG8_LDB(B0, 0, 0); PG8_LDB(B1, 0, 1); PG8_SCHED; PG8_LDA(At, 0, 0); PG8_STAGE(PG8_SA(1, 1), a1 + hstep, voffA);
            PG8_WAIT_V(8); PG8_WAIT_L(0); PG8_BAR; PG8_MMA(0, 0, At, B0); PG8_MMA(0, 1, At, B1); PG8_BAR; PG8_SCHED;
            PG8_LDA(At, 0, 1); PG8_STAGE(PG8_SB(0, 0), b2, voffB); PG8_STAGE(PG8_SB(0, 1), b2 + hstep, voffB); PG8_STAGE(PG8_SA(0, 0), a2, voffA);
            PG8_WAIT_V(8); PG8_WAIT_L(0); PG8_BAR; PG8_MMA(1, 0, At, B0); PG8_MMA(1, 1, At, B1); PG8_BAR; PG8_SCHED;
            PG8_LDB(B0, 1, 0); PG8_LDB(B1, 1, 1); PG8_SCHED; PG8_LDA(At, 1, 0); PG8_STAGE(PG8_SA(0, 1), a2 + hstep, voffA);
            PG8_WAIT_V(8); PG8_WAIT_L(0); PG8_BAR; PG8_MMA(0, 0, At, B0); PG8_MMA(0, 1, At, B1); PG8_BAR; PG8_SCHED;
            PG8_LDA(At, 1, 1); PG8_STAGE(PG8_SB(1, 0), b3, voffB); PG8_STAGE(PG8_SB(1, 1), b3 + hstep, voffB); PG8_STAGE(PG8_SA(1, 0), a3, voffA);
            PG8_WAIT_V(8); PG8_WAIT_L(0); PG8_BAR; PG8_MMA(1, 0, At, B0); PG8_MMA(1, 1, At, B1); PG8_BAR; PG8_SCHED;
            } else {
            PG8_LDB(B0, 0, 0); PG8_SCHED; PG8_LDA(At, 0, 0); PG8_STAGE(PG8_SA(1, 1), a1 + hstep, voffA);
            PG8_WAIT_L(8); PG8_BAR; PG8_WAIT_L(0); PG8_MMA(0, 0, At, B0); PG8_BAR; PG8_SCHED;
            PG8_LDB(B1, 0, 1); PG8_STAGE(PG8_SB(0, 0), b2, voffB);
            PG8_BAR; PG8_WAIT_L(0); PG8_MMA(0, 1, At, B1); PG8_BAR;
            PG8_LDA(At, 0, 1); PG8_STAGE(PG8_SA(0, 0), a2, voffA);
            PG8_BAR; PG8_WAIT_L(0); PG8_MMA(1, 0, At, B0); PG8_BAR; PG8_SCHED;
            PG8_STAGE(PG8_SB(0, 1), b2 + hstep, voffB);
            PG8_WAIT_V(6); PG8_BAR; PG8_MMA(1, 1, At, B1); PG8_BAR;
            PG8_LDB(B0, 1, 0); PG8_SCHED; PG8_LDA(At, 1, 0); PG8_STAGE(PG8_SA(0, 1), a2 + hstep, voffA);
            PG8_WAIT_L(8); PG8_BAR; PG8_WAIT_L(0); PG8_MMA(0, 0, At, B0); PG8_BAR; PG8_SCHED;
            PG8_LDB(B1, 1, 1); PG8_STAGE(PG8_SB(1, 0), b3, voffB);
            PG8_BAR; PG8_WAIT_L(0); PG8_MMA(0, 1, At, B1); PG8_BAR;
            PG8_LDA(At, 1, 1); PG8_STAGE(PG8_SA(1, 0), a3, voffA);
            PG8_BAR; PG8_WAIT_L(0); PG8_MMA(1, 0, At, B0); PG8_BAR; PG8_SCHED;
            PG8_STAGE(PG8_SB(1, 1), b3 + hstep, voffB);
            PG8_WAIT_V(6); PG8_BAR; PG8_MMA(1, 1, At, B1); PG8_BAR;
            }
        }
        if constexpr (ALIGN_EPI) { if (wr == 0) PG8_BAR; }
        if constexpr (!Epi::AFTER_DRAIN) { E(acc, cur, wr, wc, fr, fq); S.done(cur); }
        if (!has_next) break;
#pragma unroll
        for (int a = 0; a < 2; ++a)
#pragma unroll
            for (int b = 0; b < 2; ++b)
#pragma unroll
                for (int m = 0; m < 4; ++m)
#pragma unroll
                    for (int n = 0; n < 2; ++n) acc[a][b][m][n] = (f32x4){0.f, 0.f, 0.f, 0.f};
        cur = nxt; cA = nA; cB = nB; ++ui;
        if constexpr (ALIGN_EPI) { if (wr == 1) PG8_BAR; }
    }
    PG8_WAIT_V(0);
    if constexpr (!ALIGN_EPI) { if (wr == 0) PG8_BAR; }
    PG8_BAR;
    if constexpr (Epi::AFTER_DRAIN) { E.fused(acc, cur, wr, wc, fr, fq, lds, wid, lane); S.done(cur); }
#undef PG8_SA
#undef PG8_SB
#undef PG8_STAGE
#undef PG8_LDA
#undef PG8_LDB
#undef PG8_MMA
#undef PG8_WAIT_V
#undef PG8_WAIT_L
#undef PG8_BAR
#undef PG8_SCHED
}
}

using pg8::bf16_t; using pg8::bf16x8; using pg8::f32x4; using pg8::u32x4; using pg8::Unit;
typedef float f32x16 __attribute__((ext_vector_type(16)));
typedef float f32x2 __attribute__((ext_vector_type(2)));
typedef unsigned u32x2 __attribute__((ext_vector_type(2)));
typedef __bf16 bf16x2_t __attribute__((ext_vector_type(2)));
#define LAS __attribute__((address_space(3)))
#define MFMA32(a, b, c) __builtin_amdgcn_mfma_f32_32x32x16_bf16((a), (b), (c), 0, 0, 0)

constexpr int T = 16384, DM = 1024, SEQ = 4096, TH = 8192, FF = 4096, INW = 11264, NMOD = 6144;
constexpr int RCH = 256, NRCH = SEQ / RCH, CPG = RCH / 128;
constexpr size_t MiB = 1u << 20;
constexpr size_t WS_BAR = 768 * 1024;
constexpr size_t WS_MOD = 0, WS_COSP = 1 * MiB, WS_SINP = 3 * MiB, WS_COST = 5 * MiB, WS_SINT = 7 * MiB, WS_H = 9 * MiB;
constexpr size_t WS_WINA = 41 * MiB, WS_WINB = 53 * MiB, WS_WG = 61 * MiB, WS_WRET = 65 * MiB, WS_WSB = 69 * MiB, WS_WMIX = 71 * MiB, WS_WUP = 73 * MiB, WS_WDN = 81 * MiB;
constexpr size_t WS_YRET = 89 * MiB, WS_YSB = 153 * MiB, WS_RSNAP = 185 * MiB, WS_X = 217 * MiB, WS_END = 345 * MiB;
constexpr size_t WS_QR = WS_X, WS_KN = WS_X + 16 * MiB, WS_SQ = WS_X + 32 * MiB, WS_SK = WS_X + 48 * MiB, WS_KZT = WS_X + 64 * MiB, WS_VT = WS_X + 80 * MiB, WS_SVT = WS_X + 112 * MiB;
static_assert(WS_KN == WS_QR + 16 * MiB && WS_SQ == WS_QR + 32 * MiB && WS_SK == WS_QR + 48 * MiB && WS_VT == WS_KZT + 16 * MiB && WS_SVT == WS_KZT + 48 * MiB, "epilogue pointer arithmetic");
constexpr size_t WS_MERGED = WS_X, WS_TMP = WS_X + 32 * MiB, WS_U = WS_X;
constexpr int LDS_BYTES = 147456;
constexpr float SB_STOP = -40.0f * 1.44269504f;

DI unsigned pk2(float lo, float hi) { f32x2 v = {lo, hi}; bf16x2_t b = __builtin_convertvector(v, bf16x2_t); return __builtin_bit_cast(unsigned, b); }
DI float bflo(unsigned w) { return __uint_as_float(w << 16); }
DI float bfhi(unsigned w) { return __uint_as_float(w & 0xffff0000u); }
DI u32x4 pack8(f32x4 a, f32x4 b) { u32x4 w; w.x = pk2(a[0], a[1]); w.y = pk2(a[2], a[3]); w.z = pk2(b[0], b[1]); w.w = pk2(b[2], b[3]); return w; }
DI void unpack8(u32x4 w, f32x4& a, f32x4& b) { a = (f32x4){bflo(w.x), bfhi(w.x), bflo(w.y), bfhi(w.y)}; b = (f32x4){bflo(w.z), bfhi(w.z), bflo(w.w), bfhi(w.w)}; }
DI float wave_sum(float v) {
#pragma unroll
    for (int o = 1; o < 64; o <<= 1) v += __shfl_xor(v, o);
    return v;
}
DI float log2gamma(int h) { return log2f(1.0f - exp2f(-5.0f - (float)h)); }
DI float sigmoidf_(float v) { return 1.0f / (1.0f + __expf(-v)); }
DI int crow(int reg, int hh) { return (reg & 3) + 8 * (reg >> 2) + 4 * hh; }
DI size_t nfrag(int row, int col, int C) { return ((((size_t)(row >> 5) * (C >> 4) + (col >> 4)) * 2 + ((col >> 3) & 1)) * 32 + (row & 31)) * 8 + (col & 7); }
DI size_t tfrag0(int ch, int tok0, int NTOK) { return ((((size_t)(ch >> 5) * (NTOK >> 4) + (tok0 >> 4)) * 2) * 32 + (ch & 31)) * 8 + 4 * ((tok0 >> 3) & 1); }
DI void st_tfrag(bf16_t* base, int ch, int tok0, int NTOK, f32x4 a, f32x4 b) {
    bf16_t* q = base + tfrag0(ch, tok0, NTOK); u32x2 w0, w1; w0.x = pk2(a[0], a[1]); w0.y = pk2(a[2], a[3]); w1.x = pk2(b[0], b[1]); w1.y = pk2(b[2], b[3]);
    *(u32x2*)q = w0; *(u32x2*)(q + 256) = w1; }


struct EpiInA {
    static constexpr bool PERM = true, AFTER_DRAIN = false;
    bf16_t *xb, *yret; const float *cosP, *sinP;
    DI void operator()(const f32x4 (&acc)[2][2][4][2], const Unit& u, int wr, int wc, int fr_, int fq) const {
        int fr = fr_; asm volatile("" : "+v"(fr));
        const int pn = u.pn, row0 = u.pm * 256 + wr * 64 + fr, cl = wc * 32 + 8 * fq;
        if (pn < 8) {
            bf16_t* dst = xb + (size_t)(pn >> 2) * (8u << 20); const int hc = (pn & 3) * 256 + cl;
            const float sc = pn < 4 ? 1.0f : 0.0625f;
#pragma unroll
            for (int ai = 0; ai < 2; ++ai)
#pragma unroll
                for (int m = 0; m < 4; ++m) {
                    const int row = row0 + ai * 128 + m * 16, pos = row & (SEQ - 1);
                    const f32x4* cp = (const f32x4*)(cosP + pos * 128 + cl); const f32x4* sp = (const f32x4*)(sinP + pos * 128 + cl);
                    f32x4 o1[2], o2[2];
#pragma unroll
                    for (int n = 0; n < 2; ++n) { const f32x4 c = cp[n], s = sp[n], t1 = acc[ai][0][m][n], t2 = acc[ai][1][m][n];
                        o1[n] = (t1 * c - t2 * s) * sc; o2[n] = (t1 * s + t2 * c) * sc; }
                    *(u32x4*)(dst + nfrag(row, hc, 1024)) = pack8(o1[0], o1[1]); *(u32x4*)(dst + nfrag(row, hc + 128, 1024)) = pack8(o2[0], o2[1]);
                    __builtin_amdgcn_sched_barrier(0);
                }
        } else {
            const int mode = pn < 16 ? 0 : (pn < 20 ? 1 : 2);
            const int hc = (pn < 16 ? (pn - 8) : (pn & 3)) * 256 + cl;
            bf16_t* dst = xb + (size_t)(mode + 1) * (8u << 20);
#pragma unroll
            for (int ai = 0; ai < 2; ++ai)
#pragma unroll
                for (int m = 0; m < 4; ++m) {
                    const int row = row0 + ai * 128 + m * 16;
#pragma unroll
                    for (int bj = 0; bj < 2; ++bj) {
                        f32x4 v0 = acc[ai][bj][m][0], v1 = acc[ai][bj][m][1];
                        if (mode == 0) {
#pragma unroll
                            for (int e = 0; e < 4; ++e) { v0[e] = v0[e] * sigmoidf_(v0[e]); v1[e] = v1[e] * sigmoidf_(v1[e]); }
                        } else if (mode == 1) { v0 = v0 * (0.125f * 1.44269504f); v1 = v1 * (0.125f * 1.44269504f); }
                        if (mode == 0) *(u32x4*)(yret + (size_t)row * 2048 + hc + bj * 128) = pack8(v0, v1);
                        else *(u32x4*)(dst + nfrag(row, hc + bj * 128, 1024)) = pack8(v0, v1);
                    }
                }
        }
    }
};

struct EpiInB {
    static constexpr bool PERM = true, AFTER_DRAIN = false;
    bf16_t *kzT; const float *cosT, *sinT;
    DI void operator()(const f32x4 (&acc)[2][2][4][2], const Unit& u, int wr, int wc, int fr_, int fq) const {
        int fr = fr_; asm volatile("" : "+v"(fr));
        const int pm = u.pm, tok0 = u.pn * 256 + wc * 32 + 8 * fq;
        if (pm < 4) {
            const float l2g = log2gamma(pm), ginv = __builtin_amdgcn_exp2f(-l2g);
#pragma unroll
            for (int m = 0; m < 4; ++m) {
                const int i = wr * 64 + m * 16 + fr;
#pragma unroll
                for (int bj = 0; bj < 2; ++bj) {
                    const int tok = tok0 + bj * 128, pos = tok & (SEQ - 1);
                    const f32x4* cp = (const f32x4*)(cosT + i * SEQ + pos); const f32x4* sp = (const f32x4*)(sinT + i * SEQ + pos);
                    f32x4 o1[2], o2[2];
                    float zr = __builtin_amdgcn_exp2f((float)((RCH - 1) - (pos & (RCH - 1))) * l2g) * 0.0625f;
#pragma unroll
                    for (int n = 0; n < 2; ++n) { const f32x4 c = cp[n], s = sp[n], t1 = acc[0][bj][m][n], t2 = acc[1][bj][m][n];
                        f32x4 z;
#pragma unroll
                        for (int e = 0; e < 4; ++e) { z[e] = zr; zr *= ginv; }
                        o1[n] = (t1 * c - t2 * s) * z; o2[n] = (t1 * s + t2 * c) * z; }
                    st_tfrag(kzT, pm * 256 + i, tok, TH, o1[0], o1[1]);
                    st_tfrag(kzT, pm * 256 + 128 + i, tok, TH, o2[0], o2[1]);
                    __builtin_amdgcn_sched_barrier(0);
                }
            }
        } else {
            bf16_t* dst = kzT + (size_t)(pm < 12 ? 8u << 20 : 24u << 20); const int ch0 = (pm < 12 ? (pm - 4) : (pm - 12)) * 256 + wr * 64 + fr;
#pragma unroll
            for (int ai = 0; ai < 2; ++ai)
#pragma unroll
                for (int m = 0; m < 4; ++m)
#pragma unroll
                    for (int bj = 0; bj < 2; ++bj)
                        st_tfrag(dst, ch0 + ai * 128 + m * 16, tok0 + bj * 128, TH, acc[ai][bj][m][0], acc[ai][bj][m][1]);
        }
    }
};

template <int MODE> struct EpiEw {
    static constexpr bool PERM = true, AFTER_DRAIN = false;
    bf16_t* O; const bf16_t* P; int ld;
    DI void operator()(const f32x4 (&acc)[2][2][4][2], const Unit& u, int wr, int wc, int fr_, int fq) const {
        int fr = fr_; asm volatile("" : "+v"(fr));
        const int row0 = u.pm * 256 + wr * 64 + fr, col0 = u.pn * 256 + wc * 32 + 8 * fq;
#pragma unroll
        for (int ai = 0; ai < 2; ++ai)
#pragma unroll
            for (int m = 0; m < 4; ++m)
#pragma unroll
                for (int bj = 0; bj < 2; ++bj) {
                    const size_t off = (size_t)(row0 + ai * 128 + m * 16) * ld + col0 + bj * 128;
                    f32x4 v0 = acc[ai][bj][m][0], v1 = acc[ai][bj][m][1];
                    if (MODE == 0) {
#pragma unroll
                        for (int e = 0; e < 4; ++e) { v0[e] = sigmoidf_(v0[e]); v1[e] = sigmoidf_(v1[e]); }
                    } else if (MODE == 1) {
#pragma unroll
                        for (int e = 0; e < 4; ++e) { const float a = fmaxf(v0[e], 0.f), b = fmaxf(v1[e], 0.f); v0[e] = a * a; v1[e] = b * b; }
                    } else if (MODE == 2) {
                        f32x4 a, b; unpack8(*(const u32x4*)(O + off), a, b); v0 = v0 * a; v1 = v1 * b;
                    } else {
                        f32x4 a, b, c, d; unpack8(*(const u32x4*)(O + off), a, b); unpack8(*(const u32x4*)(P + off), c, d); v0 = a + c * v0; v1 = b + d * v1;
                    }
                    *(u32x4*)(O + off) = pack8(v0, v1);
                }
    }
};

struct EpiRes {
    static constexpr bool PERM = true, AFTER_DRAIN = false;
    const float* xin; float* xout; const float* gate;
    DI void operator()(const f32x4 (&acc)[2][2][4][2], const Unit& u, int wr, int wc, int fr_, int fq) const {
        int fr = fr_; asm volatile("" : "+v"(fr));
        const int row0 = u.pm * 256 + wr * 64 + fr, col0 = u.pn * 256 + wc * 32 + 8 * fq;
#pragma unroll
        for (int ai = 0; ai < 2; ++ai)
#pragma unroll
            for (int m = 0; m < 4; ++m) {
                const int row = row0 + ai * 128 + m * 16; const float* gp = gate + (row >> 12) * NMOD;
#pragma unroll
                for (int bj = 0; bj < 2; ++bj) {
                    const int col = col0 + bj * 128; const size_t off = (size_t)row * DM + col;
                    const f32x4 g0 = *(const f32x4*)(gp + col), g1 = *(const f32x4*)(gp + col + 4);
                    const f32x4 x0 = *(const f32x4*)(xin + off), x1 = *(const f32x4*)(xin + off + 4);
                    *(f32x4*)(xout + off) = x0 + g0 * acc[ai][bj][m][0]; *(f32x4*)(xout + off + 4) = x1 + g1 * acc[ai][bj][m][1];
                }
            }
    }
};

DI void cvt_tile(const float* src, int ldsrc, int k0, int n0, bf16_t* dst1, bf16_t* dst2, int K, LAS float* tile, int tid) {
    const int kr = tid >> 4, nc = (tid & 15) * 4;
#pragma unroll
    for (int p = 0; p < 2; ++p) { const int k = kr + 32 * p; const f32x4 v = *(const f32x4*)(src + (size_t)(k0 + k) * ldsrc + n0 + nc);
        tile[k * 65 + nc] = v[0]; tile[k * 65 + nc + 1] = v[1]; tile[k * 65 + nc + 2] = v[2]; tile[k * 65 + nc + 3] = v[3]; }
    __syncthreads();
    const int n = tid >> 3, ks = (tid & 7) * 8; const LAS float* s = tile + ks * 65 + n;
    u32x4 o; o.x = pk2(s[0], s[65]); o.y = pk2(s[2 * 65], s[3 * 65]); o.z = pk2(s[4 * 65], s[5 * 65]); o.w = pk2(s[6 * 65], s[7 * 65]);
    *(u32x4*)(dst1 + (size_t)n * K + k0 + ks) = o;
    if (dst2) *(u32x4*)(dst2 + (size_t)n * K + k0 + ks) = o;
    __syncthreads();
}

struct Params {
    const float *x, *c, *norm_mix_g, *w_in, *w_ret_out, *w_sb_out, *w_mix_out, *norm_mlp_g, *w_up, *w_down, *w_ada, *b_ada, *final_g;
    float* out; unsigned char* ws;
};

DI void convert_weights(const Params& p, int l, LAS float* tile, int tid) {
    unsigned char* ws = p.ws;
    bf16_t* WinA = (bf16_t*)(ws + WS_WINA); bf16_t* WinB = (bf16_t*)(ws + WS_WINB); bf16_t* Wg = (bf16_t*)(ws + WS_WG);
    constexpr int I_IN = 16 * 176, I_RET = 32 * 16, I_SB = 16 * 16, I_MIX = 16 * 16, I_UP = 16 * 64, I_DN = 64 * 16;
    constexpr int NIT = I_IN + I_RET + I_SB + I_MIX + I_UP + I_DN;
    for (int it = blockIdx.x; it < NIT; it += gridDim.x) {
        int r = it;
        if (r < I_IN) {
            const int kb = r / 176, nb = r % 176, n0 = nb * 64; bf16_t* d1; bf16_t* d2 = nullptr;
            if (n0 < 1024) d1 = WinA + (size_t)n0 * 1024;
            else if (n0 < 2048) { d1 = WinA + (size_t)n0 * 1024; d2 = WinB + (size_t)(n0 - 1024) * 1024; }
            else if (n0 < 4096) d1 = WinB + (size_t)(n0 - 1024) * 1024;
            else if (n0 < 8192) d1 = WinA + (size_t)(n0 - 2048) * 1024;
            else if (n0 < 9216) d1 = WinB + (size_t)(n0 - 5120) * 1024;
            else d1 = Wg + (size_t)(n0 - 9216) * 1024;
            cvt_tile(p.w_in + (size_t)l * DM * INW, INW, kb * 64, n0, d1, d2, 1024, tile, tid); continue;
        }
        r -= I_IN;
        if (r < I_RET) { const int kb = r / 16, nb = r % 16; cvt_tile(p.w_ret_out + (size_t)l * 2048 * 1024, 1024, kb * 64, nb * 64, (bf16_t*)(ws + WS_WRET) + (size_t)nb * 64 * 2048, nullptr, 2048, tile, tid); continue; }
        r -= I_RET;
        if (r < I_SB) { const int kb = r / 16, nb = r % 16; cvt_tile(p.w_sb_out + (size_t)l * 1024 * 1024, 1024, kb * 64, nb * 64, (bf16_t*)(ws + WS_WSB) + (size_t)nb * 64 * 1024, nullptr, 1024, tile, tid); continue; }
        r -= I_SB;
        if (r < I_MIX) { const int kb = r / 16, nb = r % 16; cvt_tile(p.w_mix_out + (size_t)l * 1024 * 1024, 1024, kb * 64, nb * 64, (bf16_t*)(ws + WS_WMIX) + (size_t)nb * 64 * 1024, nullptr, 1024, tile, tid); continue; }
        r -= I_MIX;
        if (r < I_UP) { const int kb = r / 64, nb = r % 64; cvt_tile(p.w_up + (size_t)l * 1024 * 4096, 4096, kb * 64, nb * 64, (bf16_t*)(ws + WS_WUP) + (size_t)nb * 64 * 1024, nullptr, 1024, tile, tid); continue; }
        r -= I_UP;
        { const int kb = r / 16, nb = r % 16; cvt_tile(p.w_down + (size_t)l * 4096 * 1024, 1024, kb * 64, nb * 64, (bf16_t*)(ws + WS_WDN) + (size_t)nb * 64 * 4096, nullptr, 4096, tile, tid); }
    }
}

DI void tables_and_mod(const Params& p, LAS float* lds, int tid) {
    float* cosP = (float*)(p.ws + WS_COSP); float* sinP = (float*)(p.ws + WS_SINP); float* cosT = (float*)(p.ws + WS_COST); float* sinT = (float*)(p.ws + WS_SINT);
    for (int idx = blockIdx.x * 512 + tid; idx < SEQ * 128; idx += gridDim.x * 512) {
        const int pos = idx >> 7, i = idx & 127;
        const float inv = powf(10000.0f, -(float)i / 128.0f); const float ang = (float)pos * inv;
        const float c = cosf(ang), s = sinf(ang);
        cosP[idx] = c; sinP[idx] = s; cosT[i * SEQ + pos] = c; sinT[i * SEQ + pos] = s;
    }
    float* mod = (float*)(p.ws + WS_MOD);
    LAS float* cact = lds; LAS float* red = lds + 4096;
    const int wave = tid >> 6, lane = tid & 63;
    bool have = false;
    for (int it = blockIdx.x; it < 2 * 96; it += gridDim.x) {
        if (!have) { for (int e = tid; e < 4096; e += 512) { const float v = p.c[e]; cact[e] = v * sigmoidf_(v); } have = true; __syncthreads(); }
        const int l = it / 96, c0 = (it % 96) * 64;
        const float* w = p.w_ada + (size_t)l * DM * NMOD + c0 + lane;
        float a0 = 0.f, a1 = 0.f, a2 = 0.f, a3 = 0.f;
#pragma unroll 8
        for (int k = wave * 128; k < wave * 128 + 128; ++k) { const float wv = w[(size_t)k * NMOD]; a0 += cact[k] * wv; a1 += cact[1024 + k] * wv; a2 += cact[2048 + k] * wv; a3 += cact[3072 + k] * wv; }
        red[(wave * 4 + 0) * 64 + lane] = a0; red[(wave * 4 + 1) * 64 + lane] = a1; red[(wave * 4 + 2) * 64 + lane] = a2; red[(wave * 4 + 3) * 64 + lane] = a3;
        __syncthreads();
        if (tid < 256) { const int b = tid >> 6; float s = p.b_ada[l * NMOD + c0 + lane];
#pragma unroll
            for (int w8 = 0; w8 < 8; ++w8) s += red[(w8 * 4 + b) * 64 + lane];
            mod[(size_t)(l * 4 + b) * NMOD + c0 + lane] = s; }
        __syncthreads();
    }
}

DI void norm_phase(const float* xin, const float* g, const float* modl, int shift_i, int scale_i, bf16_t* hout, int gw, int ngw, int lane) {
    for (int row = gw; row < T; row += ngw) {
        const f32x4* xr = (const f32x4*)(xin + (size_t)row * DM) + lane;
        f32x4 v[4]; float s = 0.f;
#pragma unroll
        for (int j = 0; j < 4; ++j) { v[j] = xr[64 * j]; s += (v[j][0] * v[j][0] + v[j][1] * v[j][1]) + (v[j][2] * v[j][2] + v[j][3] * v[j][3]); }
        const float rstd = 1.0f / sqrtf(wave_sum(s) * (1.0f / DM) + 1e-6f);
        const float* mb = modl + (row >> 12) * NMOD;
        u32x2* o8 = (u32x2*)(hout + (size_t)row * DM) + lane;
#pragma unroll
        for (int j = 0; j < 4; ++j) { const int col = 4 * (lane + 64 * j);
            const f32x4 gg = *(const f32x4*)(g + col), sc = *(const f32x4*)(mb + scale_i * 1024 + col), sh = *(const f32x4*)(mb + shift_i * 1024 + col);
            const f32x4 y = v[j] * rstd * gg * (sc + 1.0f) + sh;
            u32x2 w; w.x = pk2(y[0], y[1]); w.y = pk2(y[2], y[3]); o8[64 * j] = w; }
    }
}
DI void final_norm_phase(float* x, const float* g, int gw, int ngw, int lane) {
    for (int row = gw; row < T; row += ngw) {
        f32x4* xr = (f32x4*)(x + (size_t)row * DM) + lane;
        f32x4 v[4]; float s = 0.f;
#pragma unroll
        for (int j = 0; j < 4; ++j) { v[j] = xr[64 * j]; s += (v[j][0] * v[j][0] + v[j][1] * v[j][1]) + (v[j][2] * v[j][2] + v[j][3] * v[j][3]); }
        const float rstd = 1.0f / sqrtf(wave_sum(s) * (1.0f / DM) + 1e-6f);
#pragma unroll
        for (int j = 0; j < 4; ++j) { const f32x4 gg = *(const f32x4*)(g + 4 * (lane + 64 * j)); xr[64 * j] = v[j] * rstd * gg; }
    }
}

struct StateOrder {
    int G, c;
    __device__ __forceinline__ bool next(int i, Unit& u) const { const long L = (long)i * G + c; if (L >= 256) return false; u.pm = (int)L; u.pn = 0; return true; }
    __device__ __forceinline__ void a_ready(const Unit&) const {}
    __device__ __forceinline__ void done(const Unit&) const {}
    __device__ __forceinline__ const char* aptr(const pg8::Gemm& g, const Unit& u, size_t) const { const int bh = u.pm >> 5, n = (u.pm >> 1) & 15, dvh = u.pm & 1, bl = bh >> 2, h = bh & 3;
        return (const char*)g.A + ((size_t)(h * 16 + dvh * 8) * g.ns + bl * (SEQ / 16) + n * (RCH / 16)) * 1024; }
    __device__ __forceinline__ const char* bptr(const pg8::Gemm& g, const Unit& u, size_t) const { const int bh = u.pm >> 5, n = (u.pm >> 1) & 15, bl = bh >> 2, h = bh & 3;
        return (const char*)g.Bt + ((size_t)(h * 8) * g.ns + bl * (SEQ / 16) + n * (RCH / 16)) * 1024; }
};
static_assert(NRCH == 16 && RCH == 256, "StateOrder unit decoding");
struct EpiU {
    static constexpr bool PERM = true, AFTER_DRAIN = false;
    bf16_t* U;
    DI void operator()(const f32x4 (&acc)[2][2][4][2], const Unit& u, int wr, int wc, int fr_, int fq) const {
        int fr = fr_; asm volatile("" : "+v"(fr));
        const int bh = u.pm >> 5, n = (u.pm >> 1) & 15, dvh = u.pm & 1;
        bf16_t* base = U + (size_t)(bh * NRCH + n) * (512 * 256);
#pragma unroll
        for (int ai = 0; ai < 2; ++ai)
#pragma unroll
            for (int m = 0; m < 4; ++m) { const int dv = dvh * 256 + ai * 128 + wr * 64 + m * 16 + fr;
#pragma unroll
                for (int bj = 0; bj < 2; ++bj) { const int dk0 = bj * 128 + wc * 32 + 8 * fq;
                    *(u32x4*)(base + (size_t)((dv >> 5) * 16 + (dk0 >> 4)) * 512 + ((dk0 >> 3) & 1) * 256 + (dv & 31) * 8) = pack8(acc[ai][bj][m][0], acc[ai][bj][m][1]); } }
    }
};
DI void ret_scan(bf16_t* rs, int gtid, int nthreads) {
    for (int e = gtid; e < 8 * 16384; e += nthreads) {
        const int bh = e >> 14, piece = e & 16383; const float dec = __builtin_amdgcn_exp2f((float)RCH * log2gamma(bh & 3));
        u32x4* p = (u32x4*)(rs + (size_t)bh * NRCH * (512 * 256) + (size_t)piece * 8);
        u32x4 uv[NRCH];
#pragma unroll
        for (int n = 0; n < NRCH; ++n) uv[n] = p[(size_t)n * (512 * 256 / 8)];
        f32x4 r0 = {0.f, 0.f, 0.f, 0.f}, r1 = {0.f, 0.f, 0.f, 0.f};
#pragma unroll
        for (int n = 0; n < NRCH; ++n) { p[(size_t)n * (512 * 256 / 8)] = pack8(r0, r1); f32x4 a, b; unpack8(uv[n], a, b); r0 = r0 * dec + a; r1 = r1 * dec + b; }
    }
}

template <bool DIAG> DI void sb_tile(const f32x16& st, int j, int tq, int hh, float& carry, float (&aw)[16]) {
    float lp[16], gs[4], pg[4];
#pragma unroll
    for (int i = 0; i < 16; ++i) { const float z = st[i];
        const float spv = fmaxf(z, 0.f) + __builtin_amdgcn_logf(1.0f + __builtin_amdgcn_exp2f(-fabsf(z)));
        lp[i] = (!DIAG || (j * 32 + crow(i, hh)) < tq) ? -spv : 0.f; }
#pragma unroll
    for (int g = 0; g < 4; ++g) { gs[g] = (lp[4 * g] + lp[4 * g + 1]) + (lp[4 * g + 2] + lp[4 * g + 3]); pg[g] = __shfl_xor(gs[g], 32); }
    float after = carry;
#pragma unroll
    for (int g = 3; g >= 0; --g) {
        float run = after + (hh == 0 ? pg[g] : 0.f);
#pragma unroll
        for (int e = 3; e >= 0; --e) { const int i = 4 * g + e;
            const float w = __builtin_amdgcn_exp2f(st[i] + lp[i] + run);
            aw[i] = (!DIAG || (j * 32 + crow(i, hh)) < tq) ? w : 0.f; run += lp[i]; }
        after += gs[g] + pg[g];
    }
    carry = after;
}
DI void sb_item(int item, const bf16_t* sq, const bf16_t* sk, const bf16_t* svT, bf16_t* ysb, int lane) {
    const int qt = 127 - (item & 127), h = (item >> 7) & 15, bl = item >> 11, r = lane & 31, hh = lane >> 5;
    const size_t rowbase = (size_t)bl * SEQ; const int tq = qt * 32 + r;
    const int rt0 = (int)(rowbase >> 5);
    const bf16_t* qp = sq + (((size_t)(rt0 + qt) * 64 + h * 4) * 2 + hh) * 256 + r * 8;
    bf16x8 qf[4];
#pragma unroll
    for (int ks = 0; ks < 4; ++ks) qf[ks] = *(const bf16x8*)(qp + ks * 512);
    f32x16 o0, o1;
#pragma unroll
    for (int i = 0; i < 16; ++i) { o0[i] = 0.f; o1[i] = 0.f; }
    float carry = 0.f;
    const bf16_t* kbase = sk + (((size_t)rt0 * 64 + h * 4) * 2 + hh) * 256 + r * 8;
    const bf16_t* vbase = svT + (((size_t)(h * 2) * (TH / 16) + (rowbase >> 4)) * 2 + hh) * 256 + r * 8;
    bf16x8 kc[4], vc[4];
#pragma unroll
    for (int ks = 0; ks < 4; ++ks) kc[ks] = *(const bf16x8*)(kbase + (size_t)qt * 64 * 512 + ks * 512);
    vc[0] = *(const bf16x8*)(vbase + (size_t)qt * 1024); vc[1] = *(const bf16x8*)(vbase + (size_t)qt * 1024 + 512);
    vc[2] = *(const bf16x8*)(vbase + (size_t)(TH / 16) * 512 + (size_t)qt * 1024); vc[3] = *(const bf16x8*)(vbase + (size_t)(TH / 16) * 512 + (size_t)qt * 1024 + 512);
    for (int j = qt; j >= 0; --j) {
        bf16x8 kn[4], vn[4];
        const int jn = j > 0 ? j - 1 : 0;
#pragma unroll
        for (int ks = 0; ks < 4; ++ks) kn[ks] = *(const bf16x8*)(kbase + (size_t)jn * 64 * 512 + ks * 512);
        vn[0] = *(const bf16x8*)(vbase + (size_t)jn * 1024); vn[1] = *(const bf16x8*)(vbase + (size_t)jn * 1024 + 512);
        vn[2] = *(const bf16x8*)(vbase + (size_t)(TH / 16) * 512 + (size_t)jn * 1024); vn[3] = *(const bf16x8*)(vbase + (size_t)(TH / 16) * 512 + (size_t)jn * 1024 + 512);
        f32x16 st;
#pragma unroll
        for (int i = 0; i < 16; ++i) st[i] = 0.f;
        st = MFMA32(kc[0], qf[0], st); st = MFMA32(kc[1], qf[1], st); st = MFMA32(kc[2], qf[2], st); st = MFMA32(kc[3], qf[3], st);
        float aw[16];
        if (j == qt) sb_tile<true>(st, j, tq, hh, carry, aw); else sb_tile<false>(st, j, tq, hh, carry, aw);
        {
            u32x4 bw; bw.x = pk2(aw[0], aw[1]); bw.y = pk2(aw[2], aw[3]); bw.z = pk2(aw[4], aw[5]); bw.w = pk2(aw[6], aw[7]);
            const bf16x8 b0 = __builtin_bit_cast(bf16x8, bw);
            bw.x = pk2(aw[8], aw[9]); bw.y = pk2(aw[10], aw[11]); bw.z = pk2(aw[12], aw[13]); bw.w = pk2(aw[14], aw[15]);
            const bf16x8 b1 = __builtin_bit_cast(bf16x8, bw);
            o0 = MFMA32(vc[0], b0, o0); o1 = MFMA32(vc[2], b0, o1); o0 = MFMA32(vc[1], b1, o0); o1 = MFMA32(vc[3], b1, o1);
        }
        if (__all(carry < SB_STOP)) break;
#pragma unroll
        for (int ks = 0; ks < 4; ++ks) { kc[ks] = kn[ks]; vc[ks] = vn[ks]; }
    }
    bf16_t* op = ysb + (rowbase + tq) * 1024 + h * 64 + 4 * hh;
#pragma unroll
    for (int g = 0; g < 4; ++g) {
        u32x2 w; w.x = pk2(o0[4 * g], o0[4 * g + 1]); w.y = pk2(o0[4 * g + 2], o0[4 * g + 3]); *(u32x2*)(op + 8 * g) = w;
        u32x2 w1; w1.x = pk2(o1[4 * g], o1[4 * g + 1]); w1.y = pk2(o1[4 * g + 2], o1[4 * g + 3]); *(u32x2*)(op + 32 + 8 * g) = w1;
    }
}

DI void ret_out_item(int item, const bf16_t* qr, const bf16_t* kn, const bf16_t* vT, const bf16_t* rsnap, bf16_t* yret, LAS unsigned char* lds, int wave, int lane) {
    const int bh = item >> 5, c = (item >> 3) & 1, n = ((item >> 4) & 1) * 8 + (item & 7), tg = n * CPG + c, bl = bh >> 2, h = bh & 3, r = lane & 31, hh = lane >> 5;
    const int a = c * 4, tokg = tg * 128;
    static_assert(CPG == 2, "item decoding above assumes two 128-token groups per retention chunk");
    const size_t rowbase = (size_t)bl * SEQ; const int rt0 = (int)(rowbase >> 5);
    const float l2g = log2gamma(h);
    LAS float* stats = (LAS float*)(lds + 131072 + 256);
    {
        const int tt = wave & 3, par = wave >> 2, tq = tokg + tt * 32 + r;
        const bf16_t* qp = qr + (((size_t)(rt0 + (tokg >> 5) + tt) * 64 + h * 16) * 2 + hh) * 256 + r * 8;
        bf16x8 qf[16];
#pragma unroll
        for (int ks = 0; ks < 16; ++ks) qf[ks] = *(const bf16x8*)(qp + ks * 512);
        for (int jk = par; jk <= a + tt; jk += 2) {
            const int keyt = n * (RCH / 32) + jk;
            const bf16_t* kp = kn + (((size_t)(rt0 + keyt) * 64 + h * 16) * 2 + hh) * 256 + r * 8;
            f32x16 st;
#pragma unroll
            for (int i = 0; i < 16; ++i) st[i] = 0.f;
#pragma unroll
            for (int ks = 0; ks < 16; ++ks) st = MFMA32(*(const bf16x8*)(kp + ks * 512), qf[ks], st);
            float pw[16];
#pragma unroll
            for (int i = 0; i < 16; ++i) { const int d = tq - (keyt * 32 + crow(i, hh)); pw[i] = d >= 0 ? st[i] * __builtin_amdgcn_exp2f((float)d * l2g) : 0.f; }
#pragma unroll
            for (int s = 0; s < 2; ++s) {
                u32x4 bw; bw.x = pk2(pw[8 * s], pw[8 * s + 1]); bw.y = pk2(pw[8 * s + 2], pw[8 * s + 3]); bw.z = pk2(pw[8 * s + 4], pw[8 * s + 5]); bw.w = pk2(pw[8 * s + 6], pw[8 * s + 7]);
                *(LAS u32x4*)(lds + ((2 * jk + s) * 4 + tt) * 1024 + lane * 16) = bw;
            }
        }
    }
    __syncthreads();
    f32x16 acc[8];
#pragma unroll
    for (int q = 0; q < 8; ++q)
#pragma unroll
        for (int i = 0; i < 16; ++i) acc[q][i] = 0.f;
    {
        const bf16_t* rp = rsnap + (size_t)(bh * NRCH + n) * (512 * 256) + (size_t)(wave * 2 * 16) * 512 + hh * 256 + r * 8;
        const bf16_t* qg = qr + (((size_t)(rt0 + (tokg >> 5)) * 64 + h * 16) * 2 + hh) * 256 + r * 8;
#pragma unroll 2
        for (int ks = 0; ks < 16; ++ks) {
            const bf16x8 a0 = *(const bf16x8*)(rp + ks * 512), a1 = *(const bf16x8*)(rp + (16 + ks) * 512);
#pragma unroll
            for (int tt = 0; tt < 4; ++tt) { const bf16x8 b = *(const bf16x8*)(qg + (size_t)(tt * 64 + ks) * 512);
                acc[tt] = MFMA32(a0, b, acc[tt]); acc[4 + tt] = MFMA32(a1, b, acc[4 + tt]); }
        }
#pragma unroll
        for (int tt = 0; tt < 4; ++tt) { const float xi = __builtin_amdgcn_exp2f((float)(((tokg + tt * 32 + r) & (RCH - 1)) + 1) * l2g);
#pragma unroll
            for (int i = 0; i < 16; ++i) { acc[tt][i] *= xi; acc[4 + tt][i] *= xi; } }
    }
    {
        const bf16_t* vb = vT + (((size_t)(h * 16 + wave * 2) * (TH / 16) + (rowbase >> 4) + n * (RCH / 16)) * 2 + hh) * 256 + r * 8;
        const int ns = 2 * (a + 4);
#pragma unroll 2
        for (int s = 0; s < ns; ++s) {
            const bf16x8 a0 = *(const bf16x8*)(vb + (size_t)s * 512), a1 = *(const bf16x8*)(vb + (size_t)(TH / 16 + s) * 512);
            const int ttmin = (s >> 1) - a;
#pragma unroll
            for (int tt = 0; tt < 4; ++tt) if (tt >= ttmin) { const bf16x8 b = *(const LAS bf16x8*)(lds + (s * 4 + tt) * 1024 + lane * 16);
                acc[tt] = MFMA32(a0, b, acc[tt]); acc[4 + tt] = MFMA32(a1, b, acc[4 + tt]); }
        }
    }
#pragma unroll
    for (int tt = 0; tt < 4; ++tt) {
        float s1 = 0.f, s2 = 0.f;
#pragma unroll
        for (int i = 0; i < 16; ++i) { const float v0 = acc[tt][i], v1 = acc[4 + tt][i]; s1 += v0 + v1; s2 += v0 * v0 + v1 * v1; }
        s1 += __shfl_xor(s1, 32); s2 += __shfl_xor(s2, 32);
        if (hh == 0) { stats[(wave * 128 + tt * 32 + r) * 2] = s1; stats[(wave * 128 + tt * 32 + r) * 2 + 1] = s2; }
    }
    __syncthreads();
#pragma unroll
    for (int tt = 0; tt < 4; ++tt) {
        float s1 = 0.f, s2 = 0.f;
#pragma unroll
        for (int w = 0; w < 8; ++w) { s1 += stats[(w * 128 + tt * 32 + r) * 2]; s2 += stats[(w * 128 + tt * 32 + r) * 2 + 1]; }
        const float mu = s1 * (1.0f / 512.0f), var = fmaxf(s2 * (1.0f / 512.0f) - mu * mu, 0.f), rstd = 1.0f / sqrtf(var + 1e-5f);
        bf16_t* op = yret + (rowbase + tokg + tt * 32 + r) * 2048 + h * 512 + wave * 64 + 4 * hh;
#pragma unroll
        for (int dvt = 0; dvt < 2; ++dvt)
#pragma unroll
            for (int g = 0; g < 4; ++g) {
                u32x2* pp = (u32x2*)(op + dvt * 32 + 8 * g); const u32x2 gv = *pp; const f32x16& o = acc[dvt * 4 + tt];
                u32x2 w; w.x = pk2(bflo(gv.x) * (o[4 * g] - mu) * rstd, bfhi(gv.x) * (o[4 * g + 1] - mu) * rstd);
                w.y = pk2(bflo(gv.y) * (o[4 * g + 2] - mu) * rstd, bfhi(gv.y) * (o[4 * g + 3] - mu) * rstd); *pp = w;
            }
    }
    __syncthreads();
}

#define XB_TMO      128
#define XB_XCNT(j)  (256  + 64 * (j))
#define XB_XSUB(j)  (1280 + 64 * (j))
#define XB_XGEN(j)  (2304 + 64 * (j))
#define XB_TOP      3328
#define XB_TOPGEN   3392
#define XCD_BAR_WORDS 3456
#define XB_SPIN_CAP (1u << 18)

__device__ __forceinline__ unsigned xb_ld(unsigned* p)              { return __hip_atomic_load(p, __ATOMIC_RELAXED, __HIP_MEMORY_SCOPE_AGENT); }
__device__ __forceinline__ unsigned xb_add(unsigned* p, unsigned v) { return __hip_atomic_fetch_add(p, v, __ATOMIC_RELAXED, __HIP_MEMORY_SCOPE_AGENT); }
__device__ __forceinline__ unsigned xb_xcc_id() { return (unsigned)__builtin_amdgcn_s_getreg((3 << 11) | 20) & 0xFu; }
#define XB_SPIN(cond, bar) do { unsigned _sp = 0; while (cond) { __builtin_amdgcn_s_sleep(1); \
    if ((++_sp & 255u) == 0u) { if (xb_ld(&(bar)[XB_TMO])) break; if (_sp > XB_SPIN_CAP) { atomicAdd(&(bar)[XB_TMO], 1u); break; } } } } while (0)

struct XcdBarrier {
    unsigned* bar; unsigned x;
    volatile LAS unsigned* st;
};

__device__ __forceinline__ XcdBarrier xcd_barrier_post(unsigned* bar, volatile LAS unsigned* st) {
    XcdBarrier b; b.bar = bar; b.x = xb_xcc_id(); b.st = st;
    if (threadIdx.x == 0) (void)xb_add(&bar[XB_XCNT(b.x)], 1u);
    return b;
}
__device__ __forceinline__ void xcd_barrier_complete(unsigned* bar, unsigned x, unsigned& nloc, unsigned& nx) {
    const unsigned G = gridDim.x * gridDim.y * gridDim.z;
    unsigned sum, cnt, mine, sp = 0u;
    for (;;) {
        sum = 0u; cnt = 0u; mine = 0u;
#pragma unroll
        for (unsigned j = 0; j < 16; ++j) { const unsigned c = xb_ld(&bar[XB_XCNT(j)]); sum += c; cnt += (c > 0u) ? 1u : 0u; mine = (j == x) ? c : mine; }
        if (sum == G) break;
        __builtin_amdgcn_s_sleep(1);
        if ((++sp & 255u) == 0u) { if (xb_ld(&bar[XB_TMO])) break; if (sp > XB_SPIN_CAP) { atomicAdd(&bar[XB_TMO], 1u); break; } }
    }
    nloc = mine > 0u ? mine : 1u; nx = cnt > 0u ? cnt : 1u;
}

__device__ __forceinline__ void xcd_barrier(const XcdBarrier& b) {
    asm volatile("s_waitcnt vmcnt(0)" ::: "memory");
    __syncthreads();
    if (threadIdx.x == 0) {
        unsigned* bar = b.bar;
        __builtin_amdgcn_s_waitcnt(0);
        unsigned nloc = b.st[0], nx = b.st[1];
        if (nloc == 0u) { xcd_barrier_complete(bar, b.x, nloc, nx); b.st[0] = nloc; b.st[1] = nx; }
        const unsigned old = xb_add(&bar[XB_XSUB(b.x)], 1u);
        const unsigned gen = old / nloc;
        if (old + 1u == (gen + 1u) * nloc) {
            __builtin_amdgcn_fence(__ATOMIC_RELEASE, "agent");
            asm volatile("s_waitcnt vmcnt(0)" ::: "memory");
            const unsigned og = xb_add(&bar[XB_TOP], 1u);
            const unsigned tg = og / nx;
            if (og + 1u == (tg + 1u) * nx) xb_add(&bar[XB_TOPGEN], 1u);
            else XB_SPIN(xb_ld(&bar[XB_TOPGEN]) == tg, bar);
            __builtin_amdgcn_fence(__ATOMIC_ACQUIRE, "agent");
            xb_add(&bar[XB_XGEN(b.x)], 1u);
            asm volatile("s_waitcnt vmcnt(0)" ::: "memory");
        } else {
            XB_SPIN(xb_ld(&bar[XB_XGEN(b.x)]) == gen, bar);
            __builtin_amdgcn_fence(__ATOMIC_ACQUIRE, "agent");
            asm volatile("s_waitcnt vmcnt(0)" ::: "memory");
        }
    }
    __syncthreads();
}

__global__ void __launch_bounds__(512, 2) hybrid_fwd(Params p) {
    extern __shared__ __attribute__((aligned(16))) unsigned char lds_raw[];
    cg::grid_group grid = cg::this_grid();
    PG8_LAS unsigned char* lds = (PG8_LAS unsigned char*)lds_raw;
    LAS float* ldsf = (LAS float*)lds_raw;
#if PROBE_CLASS >= 0
    unsigned long long tacc = 0, tst = 0;
#define TSTART() (tst = __builtin_amdgcn_s_memrealtime())
#define TSTOP(c) do { if ((c) == PROBE_CLASS) tacc += __builtin_amdgcn_s_memrealtime() - tst; } while (0)
#else
#define TSTART() ((void)0)
#define TSTOP(c) ((void)0)
#endif
    volatile LAS unsigned* xst = (volatile LAS unsigned*)(lds_raw + 131072 + 64);
    if (threadIdx.x < 2) xst[threadIdx.x] = 0u;
    __syncthreads();
    const XcdBarrier xbar = xcd_barrier_post((unsigned*)(p.ws + WS_BAR), xst);
#define GBAR() xcd_barrier(xbar)
#if PROBE_CLASS == 9
#define GSYNC(site) do { GBAR(); TSTART(); GBAR(); TSTOP(9); } while (0)
#else
#define GSYNC(site) do { TSTART(); GBAR(); if ((PROBE_SITEMASK >> (site)) & 1) TSTOP(0); } while (0)
#endif
#define PH_BEGIN int tid = threadIdx.x; asm volatile("" : "+v"(tid)); int bx = blockIdx.x, G = gridDim.x; asm volatile("" : "+s"(bx), "+s"(G)); \
    unsigned char* ws = p.ws; asm volatile("" : "+s"(ws)); float* xo = p.out; asm volatile("" : "+s"(xo)); \
    const int lane = tid & 63, wave = __builtin_amdgcn_readfirstlane(tid >> 6), gw = bx * 8 + wave, ngw = G * 8; (void)lane; (void)wave; (void)gw; (void)ngw; \
    const float* modl = (const float*)(ws + WS_MOD) + (size_t)l * 4 * NMOD; (void)modl; bf16_t* H = (bf16_t*)(ws + WS_H); (void)H;
#pragma unroll 1
    for (int l = 0; l < 2; ++l) {
        TSTART(); { PH_BEGIN
          if (l == 0) { tables_and_mod(p, ldsf, tid); __syncthreads(); }
          convert_weights(p, l, ldsf, tid); } TSTOP(4);
        if (l == 0) grid.sync();
        TSTART(); { PH_BEGIN
          norm_phase(l == 0 ? p.x : xo, p.norm_mix_g + l * DM, modl, 0, 1, H, gw, ngw, lane); } TSTOP(5);
        GSYNC(1);
#pragma unroll 1
        for (int half = 0; half < 2; ++half) {
            TSTART(); { PH_BEGIN
              pg8::Gemm g{H + (size_t)half * TH * DM, (const bf16_t*)(ws + WS_WINA), TH, 6144, DM}; pg8::StaticOrder S; S.init(TH, 6144, G, bx);
              EpiInA E{(bf16_t*)(ws + WS_X), (bf16_t*)(ws + WS_YRET) + (size_t)half * TH * 2048, (const float*)(ws + WS_COSP), (const float*)(ws + WS_SINP)};
              pg8::gemm_phase<EpiInA, pg8::StaticOrder, true, true>(lds, g, S, E); } TSTOP(1);
            TSTART(); { PH_BEGIN
              pg8::Gemm g{(const bf16_t*)(ws + WS_WINB), H + (size_t)half * TH * DM, 4096, TH, DM}; pg8::StaticOrder S; S.init(4096, TH, G, bx);
              EpiInB E{(bf16_t*)(ws + WS_KZT), (const float*)(ws + WS_COST), (const float*)(ws + WS_SINT)};
              pg8::gemm_phase<EpiInB, pg8::StaticOrder, true, true>(lds, g, S, E); } TSTOP(1);
            GSYNC(2);
            TSTART(); { PH_BEGIN
              pg8::Gemm g{(const bf16_t*)(ws + WS_VT), (const bf16_t*)(ws + WS_KZT), 256, 256, RCH, 1, TH / 16}; StateOrder S{G, bx};
              EpiU E{(bf16_t*)(ws + WS_RSNAP)};
              pg8::gemm_phase<EpiU, StateOrder, false, true>(lds, g, S, E); } TSTOP(2);
            GSYNC(10);
            TSTART(); { PH_BEGIN
              ret_scan((bf16_t*)(ws + WS_RSNAP), bx * 512 + tid, G * 512);
              unsigned* qctr = (unsigned*)(ws + WS_BAR) + (l * 2 + half) * 16;
              for (unsigned it = (unsigned)gw;;) {
                  if (it >= 4096u) break;
                  sb_item((int)it, (const bf16_t*)(ws + WS_SQ), (const bf16_t*)(ws + WS_SK), (const bf16_t*)(ws + WS_SVT), (bf16_t*)(ws + WS_YSB) + (size_t)half * TH * 1024, lane);
                  unsigned nx = 0; if (lane == 0) nx = __hip_atomic_fetch_add(qctr, 1u, __ATOMIC_RELAXED, __HIP_MEMORY_SCOPE_AGENT);
                  it = (unsigned)ngw + (unsigned)__builtin_amdgcn_readfirstlane(nx);
              } } TSTOP(6);
            GSYNC(3);
            TSTART(); { PH_BEGIN
              for (int it = bx; it < 256; it += G) ret_out_item(it, (const bf16_t*)(ws + WS_QR), (const bf16_t*)(ws + WS_KN), (const bf16_t*)(ws + WS_VT), (const bf16_t*)(ws + WS_RSNAP), (bf16_t*)(ws + WS_YRET) + (size_t)half * TH * 2048, (LAS unsigned char*)lds_raw, wave, lane); } TSTOP(3);
            GSYNC(4);
        }
        TSTART(); { PH_BEGIN pg8::StaticOrder S; S.init(T, DM, G, bx);
          pg8::Gemm g{H, (const bf16_t*)(ws + WS_WG), T, DM, DM}; EpiEw<0> E{(bf16_t*)(ws + WS_MERGED), nullptr, DM}; pg8::gemm_phase<EpiEw<0>, pg8::StaticOrder, false, true>(lds, g, S, E); } TSTOP(7);
        TSTART(); { PH_BEGIN pg8::StaticOrder S; S.init(T, DM, G, bx);
          pg8::Gemm g{(const bf16_t*)(ws + WS_YRET), (const bf16_t*)(ws + WS_WRET), T, DM, 2048}; EpiEw<2> E{(bf16_t*)(ws + WS_MERGED), nullptr, DM}; pg8::gemm_phase<EpiEw<2>, pg8::StaticOrder, false, true>(lds, g, S, E); } TSTOP(7);
        TSTART(); { PH_BEGIN pg8::StaticOrder S; S.init(T, DM, G, bx);
          pg8::Gemm g{H, (const bf16_t*)(ws + WS_WG) + (size_t)1024 * 1024, T, DM, DM}; EpiEw<0> E{(bf16_t*)(ws + WS_TMP), nullptr, DM}; pg8::gemm_phase<EpiEw<0>, pg8::StaticOrder, false, true>(lds, g, S, E); } TSTOP(7);
        TSTART(); { PH_BEGIN pg8::StaticOrder S; S.init(T, DM, G, bx);
          pg8::Gemm g{(const bf16_t*)(ws + WS_YSB), (const bf16_t*)(ws + WS_WSB), T, DM, DM}; EpiEw<3> E{(bf16_t*)(ws + WS_MERGED), (const bf16_t*)(ws + WS_TMP), DM}; pg8::gemm_phase<EpiEw<3>, pg8::StaticOrder, false, true>(lds, g, S, E); } TSTOP(7);
        GSYNC(5);
        TSTART(); { PH_BEGIN pg8::StaticOrder S; S.init(T, DM, G, bx);
          pg8::Gemm g{(const bf16_t*)(ws + WS_MERGED), (const bf16_t*)(ws + WS_WMIX), T, DM, DM}; EpiRes E{l == 0 ? p.x : xo, xo, modl + 2 * 1024};
          pg8::gemm_phase<EpiRes, pg8::StaticOrder, false, true>(lds, g, S, E); } TSTOP(7);
        GSYNC(6);
        TSTART(); { PH_BEGIN
          norm_phase(xo, p.norm_mlp_g + l * DM, modl, 3, 4, H, gw, ngw, lane); } TSTOP(5);
        GSYNC(7);
        TSTART(); { PH_BEGIN pg8::StaticOrder S; S.init(T, FF, G, bx);
          pg8::Gemm g{H, (const bf16_t*)(ws + WS_WUP), T, FF, DM}; EpiEw<1> E{(bf16_t*)(ws + WS_U), nullptr, FF};
          pg8::gemm_phase<EpiEw<1>, pg8::StaticOrder, true, true>(lds, g, S, E); } TSTOP(8);
        GSYNC(8);
        TSTART(); { PH_BEGIN pg8::StaticOrder S; S.init(T, DM, G, bx);
          pg8::Gemm g{(const bf16_t*)(ws + WS_U), (const bf16_t*)(ws + WS_WDN), T, DM, FF}; EpiRes E{xo, xo, modl + 5 * 1024};
          pg8::gemm_phase<EpiRes, pg8::StaticOrder, false, true>(lds, g, S, E); } TSTOP(8);
        GSYNC(9);
    }
    TSTART(); { const int l = 0; PH_BEGIN
      final_norm_phase(xo, p.final_g, gw, ngw, lane); } TSTOP(5);
#if PROBE_CLASS >= 0
    grid.sync();
    if (blockIdx.x == 0) { const unsigned kk = (unsigned)(tacc * 4ull / 25ull);
        for (unsigned i = threadIdx.x; i < kk; i += 512) p.out[i] += 0.1f; }
#endif
#undef PH_BEGIN
}

extern "C" void kernel_launch(void* const* d_in, const int* in_sizes, int n_in, void* d_out, int out_size, void* d_ws, size_t ws_size, hipStream_t stream) {
    static int grid_blocks = 0;
    if (grid_blocks == 0) {
        if (n_in != 13 || out_size != T * DM || ws_size < WS_END) { fprintf(stderr, "kernel_launch: unexpected shapes (n_in %d out %d ws %zu need %zu)\n", n_in, out_size, ws_size, (size_t)WS_END); grid_blocks = -1; return; }
        int dev = 0, cus = 0, per_cu = 0;
        (void)hipGetDevice(&dev); (void)hipDeviceGetAttribute(&cus, hipDeviceAttributeMultiprocessorCount, dev);
        if (hipFuncSetAttribute((const void*)hybrid_fwd, hipFuncAttributeMaxDynamicSharedMemorySize, LDS_BYTES) != hipSuccess) { fprintf(stderr, "kernel_launch: hipFuncSetAttribute failed\n"); grid_blocks = -1; return; }
        if (hipOccupancyMaxActiveBlocksPerMultiprocessor(&per_cu, (const void*)hybrid_fwd, 512, LDS_BYTES) != hipSuccess || per_cu < 1) { fprintf(stderr, "kernel_launch: occupancy query gave %d\n", per_cu); per_cu = 1; (void)hipGetLastError(); }
        grid_blocks = cus * per_cu;
    }
    if (grid_blocks < 0) return;
    Params p{};
    p.x = (const float*)d_in[0]; p.c = (const float*)d_in[1]; p.norm_mix_g = (const float*)d_in[2]; p.w_in = (const float*)d_in[3]; p.w_ret_out = (const float*)d_in[4];
    p.w_sb_out = (const float*)d_in[5]; p.w_mix_out = (const float*)d_in[6]; p.norm_mlp_g = (const float*)d_in[7]; p.w_up = (const float*)d_in[8]; p.w_down = (const float*)d_in[9];
    p.w_ada = (const float*)d_in[10]; p.b_ada = (const float*)d_in[11]; p.final_g = (const float*)d_in[12];
    p.out = (float*)d_out; p.ws = (unsigned char*)d_ws;
    if (hipMemsetAsync((char*)d_ws + WS_BAR, 0, XCD_BAR_WORDS * 4, stream) != hipSuccess) { fprintf(stderr, "kernel_launch: memset failed\n"); return; }
    void* args[] = {&p};
    hipError_t e = hipLaunchCooperativeKernel((const void*)hybrid_fwd, dim3(grid_blocks), dim3(512), args, LDS_BYTES, stream);
    if (e != hipSuccess) fprintf(stderr, "kernel_launch: cooperative launch failed: %s (grid %d)\n", hipGetErrorString(e), grid_blocks);
}
```

```cpp
#include <hip/hip_runtime.h>
#include <hip/hip_cooperative_groups.h>
#include <cstdio>
#include <cstdint>
namespace cg = cooperative_groups;
#define DI __device__ __forceinline__
#define PROBE_CLASS -1
#define PROBE_SITEMASK 0xFFFF
namespace pg8 {
#define PG8_LAS __attribute__((address_space(3)))
typedef unsigned short bf16_t;
typedef short bf16x8 __attribute__((ext_vector_type(8)));
typedef float f32x4 __attribute__((ext_vector_type(4)));
typedef unsigned u32x4 __attribute__((ext_vector_type(4)));
constexpr int BM = 256, BK = 64, HALF = 128, HTB = HALF * BK * 2  , STAGE_BYTES = 8 * HTB, NXCD = 8, WGM = 8;

__host__ __device__ __forceinline__ int lds_byte(int r, int c) { const int st = (r >> 4) * 2 + (c >> 5), rr = r & 15, cc = c & 31, ob = rr * 64 + cc * 2; return st * 1024 + (ob ^ (((ob >> 9) & 1) << 5)); }
__host__ __device__ __forceinline__ void stage_rc(int b, int& R, int& C) { const int st = b / 1024, sb = b % 1024, swz = sb ^ (((sb >> 9) & 1) << 5); R = (st >> 1) * 16 + swz / 64; C = (st & 1) * 32 + (swz % 64) / 2; }
__host__ __device__ __forceinline__ int perm32(int rho) { const int n = rho >> 4, i = rho & 15; return 8 * (i >> 2) + 4 * n + (i & 3); }

struct Unit { int pm, pn; };
struct Gemm { const bf16_t* A; const bf16_t* Bt; int M, N, K; int frag, ns; };

struct StaticOrder {
    int nM, nN, nwg, G, c;
    __host__ __device__ void init(int M, int N, int G_, int c_) { nM = M / BM; nN = N / BM; nwg = nM * nN; G = G_; c = c_; }
    __host__ __device__ bool next(int i, Unit& u) const {
        const long L = (long)i * G + c; if (L >= nwg) return false;
        int wgid = (int)L; { const int q = nwg / NXCD, r = nwg % NXCD, xcd = wgid % NXCD, off = wgid / NXCD; wgid = (xcd < r ? xcd * (q + 1) : r * (q + 1) + (xcd - r) * q) + off; }
        const int nig = WGM * nN, gid = wgid / nig, fm = gid * WGM, gsz = (nM - fm) < WGM ? (nM - fm) : WGM;
        u.pm = fm + ((wgid % nig) % gsz); u.pn = (wgid % nig) / gsz; return true;
    }
    __device__ __forceinline__ void a_ready(const Unit&) const {}
    __device__ __forceinline__ void done(const Unit&) const {}
    __device__ __forceinline__ const char* aptr(const Gemm& g, const Unit& u, size_t tstep) const { return (const char*)g.A + (size_t)u.pm * tstep; }
    __device__ __forceinline__ const char* bptr(const Gemm& g, const Unit& u, size_t tstep) const { return (const char*)g.Bt + (size_t)u.pn * tstep; }
};

template <class Epi, class Sched, bool ALIGN_EPI = false, bool SP2 = false>
__device__ __forceinline__ void gemm_phase(PG8_LAS unsigned char* lds, const Gemm g, const Sched& S, const Epi& E) {
    int tid_l = threadIdx.x; asm volatile("" : "+v"(tid_l)); const int tid = tid_l, wid = __builtin_amdgcn_readfirstlane(tid >> 6), lane = tid & 63, wr = wid >> 2, wc = wid & 3, fr = lane & 15, fq = lane >> 4;
    const int K = g.K, nt = K / BK;
    unsigned voffA[2], voffB[2];
#pragma unroll
    for (int i = 0; i < 2; ++i) { int R, C; stage_rc(tid * 16 + i * 8192, R, C); const int Rb = Epi::PERM ? ((R & ~31) + perm32(R & 31)) : R;
        if (g.frag) { const unsigned rtile = (unsigned)g.ns * 1024u, kc = (unsigned)((C >> 4) * 1024 + ((C >> 3) & 1) * 512);
            voffA[i] = (unsigned)(R >> 5) * rtile + kc + (unsigned)(R & 31) * 16u; voffB[i] = (unsigned)(Rb >> 5) * rtile + kc + (unsigned)(Rb & 31) * 16u; }
        else { voffA[i] = (unsigned)(R * K + C) * 2u; voffB[i] = (unsigned)(Rb * K + C) * 2u; } }
    const size_t kstep = g.frag ? (size_t)4096 : (size_t)(BK * 2);
    const size_t hstep = g.frag ? (size_t)4 * g.ns * 1024 : (size_t)HALF * K * 2;
    const size_t tstep = 2 * hstep;
    const unsigned ldsw = (unsigned)wid * 1024u;
    const int aoff = lds_byte(wr * 64 + fr, fq * 8), boff = lds_byte(wc * 32 + fr, fq * 8);
#define PG8_SA(b, h) (((b) * 2 + (h)) * HTB)
#define PG8_SB(b, h) ((4 + (b) * 2 + (h)) * HTB)
#define PG8_STAGE(bufoff, gbase, voff) do { _Pragma("unroll") for (int _i = 0; _i < 2; ++_i) \
        __builtin_amdgcn_global_load_lds((const unsigned*)((const char*)(gbase) + (voff)[_i]), (PG8_LAS unsigned*)(lds + (bufoff) + ldsw + _i * 8192), 16, 0, 0); } while (0)
#define PG8_LDA(dst, b, h) do { _Pragma("unroll") for (int m = 0; m < 4; ++m) _Pragma("unroll") for (int k = 0; k < 2; ++k) dst[m][k] = *(const PG8_LAS bf16x8*)(lds + PG8_SA(b, h) + aoff + m * 2048 + k * 1024); } while (0)
#define PG8_LDB(dst, b, h) do { _Pragma("unroll") for (int n = 0; n < 2; ++n) _Pragma("unroll") for (int k = 0; k < 2; ++k) dst[n][k] = *(const PG8_LAS bf16x8*)(lds + PG8_SB(b, h) + boff + n * 2048 + k * 1024); } while (0)
#define PG8_MMA(ai, bj, At, Bt) do { __builtin_amdgcn_s_setprio(1); _Pragma("unroll") for (int m = 0; m < 4; ++m) _Pragma("unroll") for (int n = 0; n < 2; ++n) _Pragma("unroll") for (int k = 0; k < 2; ++k) \
        acc[ai][bj][m][n] = __builtin_amdgcn_mfma_f32_16x16x32_bf16(Bt[n][k], At[m][k], acc[ai][bj][m][n], 0, 0, 0); __builtin_amdgcn_s_setprio(0); } while (0)
#define PG8_WAIT_V(n) asm volatile("s_waitcnt vmcnt(" #n ")" ::: "memory")
#define PG8_WAIT_L(n) asm volatile("s_waitcnt lgkmcnt(" #n ")" ::: "memory")
#define PG8_BAR __builtin_amdgcn_s_barrier()
#define PG8_SCHED __builtin_amdgcn_sched_barrier(0)
    Unit cur, nxt; int ui = 0;
    if (!S.next(0, cur)) return;
    f32x4 acc[2][2][4][2];
#pragma unroll
    for (int a = 0; a < 2; ++a)
#pragma unroll
        for (int b = 0; b < 2; ++b)
#pragma unroll
            for (int m = 0; m < 4; ++m)
#pragma unroll
                for (int n = 0; n < 2; ++n) acc[a][b][m][n] = (f32x4){0.f, 0.f, 0.f, 0.f};
    bf16x8 At[4][2], B0[2][2], B1[2][2];
    const char* cA = S.aptr(g, cur, tstep); const char* cB = S.bptr(g, cur, tstep);
    S.a_ready(cur);
    if constexpr (SP2) {
        PG8_STAGE(PG8_SB(0, 0), cB, voffB); PG8_STAGE(PG8_SB(0, 1), cB + hstep, voffB); PG8_STAGE(PG8_SA(0, 0), cA, voffA); PG8_STAGE(PG8_SA(0, 1), cA + hstep, voffA);
        if (wr == 1) PG8_BAR;
        PG8_WAIT_V(2); PG8_BAR;
        PG8_STAGE(PG8_SB(1, 0), cB + kstep, voffB); PG8_STAGE(PG8_SA(1, 0), cA + kstep, voffA); PG8_STAGE(PG8_SB(1, 1), cB + hstep + kstep, voffB);
        PG8_WAIT_V(6); PG8_BAR;
    } else {
        PG8_STAGE(PG8_SB(0, 0), cB, voffB); PG8_STAGE(PG8_SA(0, 0), cA, voffA); PG8_STAGE(PG8_SB(0, 1), cB + hstep, voffB); PG8_STAGE(PG8_SA(0, 1), cA + hstep, voffA);
        if (wr == 1) PG8_BAR;
        PG8_WAIT_V(4); PG8_BAR;
        PG8_STAGE(PG8_SB(1, 0), cB + kstep, voffB); PG8_STAGE(PG8_SA(1, 0), cA + kstep, voffA); PG8_STAGE(PG8_SB(1, 1), cB + hstep + kstep, voffB);
        PG8_WAIT_V(6); PG8_BAR;
    }
    for (;;) {
        const bool has_next = S.next(ui + 1, nxt);
        const char* nA = has_next ? S.aptr(g, nxt, tstep) : cA; const char* nB = has_next ? S.bptr(g, nxt, tstep) : cB;
        for (int t = 0; t < nt; t += 2) {
            const bool last = (t == nt - 2);
            const char* a1 = cA + (size_t)(t + 1) * kstep;
            const char* a2 = last ? nA : cA + (size_t)(t + 2) * kstep; const char* b2 = last ? nB : cB + (size_t)(t + 2) * kstep;
            const char* a3 = a2 + kstep; const char* b3 = b2 + kstep;
            if (last && has_next) S.a_ready(nxt);
            if constexpr (SP2) {
            PG8_LDB(B0, 0, 0); PG8_LDB(B1, 0, 1); PG8_SCHED; PG8_LDA(At, 0, 0); PG8_STAGE(PG8_SA(1, 1), a1 + hstep, voffA);
            PG8_WAIT_V(8); PG8_WAIT_L(0); PG8_BAR; PG8_MMA(0, 0, At, B0); PG8_MMA(0, 1, At, B1); PG8_BAR; PG8_SCHED;
            PG8_LDA(At, 0, 1); PG8_STAGE(PG8_SB(0, 0), b2, voffB); PG8_STAGE(PG8_SB(0, 1), b2 + hstep, voffB); PG8_STAGE(PG8_SA(0, 0), a2, voffA);
            PG8_WAIT_V(8); PG8_WAIT_L(0); PG8_BAR; PG8_MMA(1, 0, At, B0); PG8_MMA(1, 1, At, B1); PG8_BAR; PG8_SCHED;
            PG8_LDB(B0, 1, 0); PG8_LDB(B1, 1, 1); PG8_SCHED; PG8_LDA(At, 1, 0); PG8_STAGE(PG8_SA(0, 1), a2 + hstep, voffA);
            PG8_WAIT_V(8); PG8_WAIT_L(0); PG8_BAR; PG8_MMA(0, 0, At, B0); PG8_MMA(0, 1, At, B1); PG8_BAR; PG8_SCHED;
            PG8_LDA(At, 1, 1); PG8_STAGE(PG8_SB(1, 0), b3, voffB); PG8_STAGE(PG8_SB(1, 1), b3 + hstep, voffB); PG8_STAGE(PG8_SA(1, 0), a3, voffA);
            PG8_WAIT_V(8); PG8_WAIT_L(0); PG8_BAR; PG8_MMA(1, 0, At, B0); PG8_MMA(1, 1, At, B1); PG8_BAR; PG8_SCHED;
            } else {
            PG8_LDB(B0, 0, 0); PG8_SCHED; PG8_LDA(At, 0, 0); PG8_STAGE(PG8_SA(1, 1), a1 + hstep, voffA);
            PG8_WAIT_L(8); PG8_BAR; PG8_WAIT_L(0); PG8_MMA(0, 0, At, B0); PG8_BAR; PG8_SCHED;
            PG8_LDB(B1, 0, 1); PG8_STAGE(PG8_SB(0, 0), b2, voffB);
            PG8_BAR; PG8_WAIT_L(0); PG8_MMA(0, 1, At, B1); PG8_BAR;
            PG8_LDA(At, 0, 1); PG8_STAGE(PG8_SA(0, 0), a2, voffA);
            PG8_BAR; PG8_WAIT_L(0); PG8_MMA(1, 0, At, B0); PG8_BAR; PG8_SCHED;
            PG8_STAGE(PG8_SB(0, 1), b2 + hstep, voffB);
            PG8_WAIT_V(6); PG8_BAR; PG8_MMA(1, 1, At, B1); PG8_BAR;
            PG8_LDB(B0, 1, 0); PG8_SCHED; PG8_LDA(At, 1, 0); PG8_STAGE(PG8_SA(0, 1), a2 + hstep, voffA);
            PG8_WAIT_L(8); PG8_BAR; PG8_WAIT_L(0); PG8_MMA(0, 0, At, B0); PG8_BAR; PG8_SCHED;
            PG8_LDB(B1, 1, 1); PG8_STAGE(PG8_SB(1, 0), b3, voffB);
            PG8_BAR; PG8_WAIT_L(0); PG8_MMA(0, 1, At, B1); PG8_BAR;
            PG8_LDA(At, 1, 1); PG8_STAGE(PG8_SA(1, 0), a3, voffA);
            PG8_BAR; PG8_WAIT_L(0); PG8_MMA(1, 0, At, B0); PG8_BAR; PG8_SCHED;
            PG8_STAGE(PG8_SB(1, 1), b3 + hstep, voffB);
            PG8_WAIT_V(6); PG8_BAR; PG8_MMA(1, 1, At, B1); PG8_BAR;
            }
        }
        if constexpr (ALIGN_EPI) { if (wr == 0) PG8_BAR; }
        if constexpr (!Epi::AFTER_DRAIN) { E(acc, cur, wr, wc, fr, fq); S.done(cur); }
        if (!has_next) break;
#pragma unroll
        for (int a = 0; a < 2; ++a)
#pragma unroll
            for (int b = 0; b < 2; ++b)
#pragma unroll
                for (int m = 0; m < 4; ++m)
#pragma unroll
                    for (int n = 0; n < 2; ++n) acc[a][b][m][n] = (f32x4){0.f, 0.f, 0.f, 0.f};
        cur = nxt; cA = nA; cB = nB; ++ui;
        if constexpr (ALIGN_EPI) { if (wr == 1) PG8_BAR; }
    }
    PG8_WAIT_V(0);
    if constexpr (!ALIGN_EPI) { if (wr == 0) PG8_BAR; }
    PG8_BAR;
    if constexpr (Epi::AFTER_DRAIN) { E.fused(acc, cur, wr, wc, fr, fq, lds, wid, lane); S.done(cur); }
#undef PG8_SA
#undef PG8_SB
#undef PG8_STAGE
#undef PG8_LDA
#undef PG8_LDB
#undef PG8_MMA
#undef PG8_WAIT_V
#undef PG8_WAIT_L
#undef PG8_BAR
#undef PG8_SCHED
}
}

using pg8::bf16_t; using pg8::bf16x8; using pg8::f32x4; using pg8::u32x4; using pg8::Unit;
typedef float f32x16 __attribute__((ext_vector_type(16)));
typedef float f32x2 __attribute__((ext_vector_type(2)));
typedef unsigned u32x2 __attribute__((ext_vector_type(2)));
typedef __bf16 bf16x2_t __attribute__((ext_vector_type(2)));
#define LAS __attribute__((address_space(3)))
#define MFMA32(a, b, c) __builtin_amdgcn_mfma_f32_32x32x16_bf16((a), (b), (c), 0, 0, 0)

constexpr int T = 16384, DM = 1024, SEQ = 4096, TH = 8192, FF = 4096, INW = 11264, NMOD = 6144;
constexpr int RCH = 256, NRCH = SEQ / RCH, CPG = RCH / 128;
constexpr size_t MiB = 1u << 20;
constexpr size_t WS_BAR = 768 * 1024;
constexpr size_t WS_MOD = 0, WS_COSP = 1 * MiB, WS_SINP = 3 * MiB, WS_COST = 5 * MiB, WS_SINT = 7 * MiB, WS_H = 9 * MiB;
constexpr size_t WS_WINA = 41 * MiB, WS_WINB = 53 * MiB, WS_WG = 61 * MiB, WS_WRET = 65 * MiB, WS_WSB = 69 * MiB, WS_WMIX = 71 * MiB, WS_WUP = 73 * MiB, WS_WDN = 81 * MiB;
constexpr size_t WS_YRET = 89 * MiB, WS_YSB = 153 * MiB, WS_RSNAP = 185 * MiB, WS_X = 217 * MiB, WS_END = 345 * MiB;
constexpr size_t WS_QR = WS_X, WS_KN = WS_X + 16 * MiB, WS_SQ = WS_X + 32 * MiB, WS_SK = WS_X + 48 * MiB, WS_KZT = WS_X + 64 * MiB, WS_VT = WS_X + 80 * MiB, WS_SVT = WS_X + 112 * MiB;
static_assert(WS_KN == WS_QR + 16 * MiB && WS_SQ == WS_QR + 32 * MiB && WS_SK == WS_QR + 48 * MiB && WS_VT == WS_KZT + 16 * MiB && WS_SVT == WS_KZT + 48 * MiB, "epilogue pointer arithmetic");
constexpr size_t WS_MERGED = WS_X, WS_TMP = WS_X + 32 * MiB, WS_U = WS_X;
constexpr int LDS_BYTES = 147456;
constexpr int SB_STATIC = 2048;
constexpr float SB_STOP = -40.0f * 1.44269504f;

DI unsigned pk2(float lo, float hi) { f32x2 v = {lo, hi}; bf16x2_t b = __builtin_convertvector(v, bf16x2_t); return __builtin_bit_cast(unsigned, b); }
DI float bflo(unsigned w) { return __uint_as_float(w << 16); }
DI float bfhi(unsigned w) { return __uint_as_float(w & 0xffff0000u); }
DI u32x4 pack8(f32x4 a, f32x4 b) { u32x4 w; w.x = pk2(a[0], a[1]); w.y = pk2(a[2], a[3]); w.z = pk2(b[0], b[1]); w.w = pk2(b[2], b[3]); return w; }
DI void unpack8(u32x4 w, f32x4& a, f32x4& b) { a = (f32x4){bflo(w.x), bfhi(w.x), bflo(w.y), bfhi(w.y)}; b = (f32x4){bflo(w.z), bfhi(w.z), bflo(w.w), bfhi(w.w)}; }
DI float wave_sum(float v) {
#pragma unroll
    for (int o = 1; o < 64; o <<= 1) v += __shfl_xor(v, o);
    return v;
}
DI float log2gamma(int h) { return log2f(1.0f - exp2f(-5.0f - (float)h)); }
DI float sigmoidf_(float v) { return 1.0f / (1.0f + __expf(-v)); }
DI int crow(int reg, int hh) { return (reg & 3) + 8 * (reg >> 2) + 4 * hh; }
DI size_t nfrag(int row, int col, int C) { return ((((size_t)(row >> 5) * (C >> 4) + (col >> 4)) * 2 + ((col >> 3) & 1)) * 32 + (row & 31)) * 8 + (col & 7); }
DI size_t tfrag0(int ch, int tok0, int NTOK) { return ((((size_t)(ch >> 5) * (NTOK >> 4) + (tok0 >> 4)) * 2) * 32 + (ch & 31)) * 8 + 4 * ((tok0 >> 3) & 1); }
DI void st_tfrag(bf16_t* base, int ch, int tok0, int NTOK, f32x4 a, f32x4 b) {
    bf16_t* q = base + tfrag0(ch, tok0, NTOK); u32x2 w0, w1; w0.x = pk2(a[0], a[1]); w0.y = pk2(a[2], a[3]); w1.x = pk2(b[0], b[1]); w1.y = pk2(b[2], b[3]);
    *(u32x2*)q = w0; *(u32x2*)(q + 256) = w1; }


struct EpiInA {
    static constexpr bool PERM = true, AFTER_DRAIN = false;
    bf16_t *xb, *yret; const float *cosP, *sinP;
    DI void operator()(const f32x4 (&acc)[2][2][4][2], const Unit& u, int wr, int wc, int fr_, int fq) const {
        int fr = fr_; asm volatile("" : "+v"(fr));
        const int pn = u.pn, row0 = u.pm * 256 + wr * 64 + fr, cl = wc * 32 + 8 * fq;
        if (pn < 8) {
            bf16_t* dst = xb + (size_t)(pn >> 2) * (8u << 20); const int hc = (pn & 3) * 256 + cl;
            const float sc = pn < 4 ? 1.0f : 0.0625f;
#pragma unroll
            for (int ai = 0; ai < 2; ++ai)
#pragma unroll
                for (int m = 0; m < 4; ++m) {
                    const int row = row0 + ai * 128 + m * 16, pos = row & (SEQ - 1);
                    const f32x4* cp = (const f32x4*)(cosP + pos * 128 + cl); const f32x4* sp = (const f32x4*)(sinP + pos * 128 + cl);
                    f32x4 o1[2], o2[2];
#pragma unroll
                    for (int n = 0; n < 2; ++n) { const f32x4 c = cp[n], s = sp[n], t1 = acc[ai][0][m][n], t2 = acc[ai][1][m][n];
                        o1[n] = (t1 * c - t2 * s) * sc; o2[n] = (t1 * s + t2 * c) * sc; }
                    *(u32x4*)(dst + nfrag(row, hc, 1024)) = pack8(o1[0], o1[1]); *(u32x4*)(dst + nfrag(row, hc + 128, 1024)) = pack8(o2[0], o2[1]);
                    __builtin_amdgcn_sched_barrier(0);
                }
        } else {
            const int mode = pn < 16 ? 0 : (pn < 20 ? 1 : 2);
            const int hc = (pn < 16 ? (pn - 8) : (pn & 3)) * 256 + cl;
            bf16_t* dst = xb + (size_t)(mode + 1) * (8u << 20);
#pragma unroll
            for (int ai = 0; ai < 2; ++ai)
#pragma unroll
                for (int m = 0; m < 4; ++m) {
                    const int row = row0 + ai * 128 + m * 16;
#pragma unroll
                    for (int bj = 0; bj < 2; ++bj) {
                        f32x4 v0 = acc[ai][bj][m][0], v1 = acc[ai][bj][m][1];
                        if (mode == 0) {
#pragma unroll
                            for (int e = 0; e < 4; ++e) { v0[e] = v0[e] * sigmoidf_(v0[e]); v1[e] = v1[e] * sigmoidf_(v1[e]); }
                        } else if (mode == 1) { v0 = v0 * (0.125f * 1.44269504f); v1 = v1 * (0.125f * 1.44269504f); }
                        if (mode == 0) *(u32x4*)(yret + (size_t)row * 2048 + hc + bj * 128) = pack8(v0, v1);
                        else *(u32x4*)(dst + nfrag(row, hc + bj * 128, 1024)) = pack8(v0, v1);
                    }
                }
        }
    }
};

struct EpiInB {
    static constexpr bool PERM = true, AFTER_DRAIN = false;
    bf16_t *kzT; const float *cosT, *sinT;
    DI void operator()(const f32x4 (&acc)[2][2][4][2], const Unit& u, int wr, int wc, int fr_, int fq) const {
        int fr = fr_; asm volatile("" : "+v"(fr));
        const int pm = u.pm, tok0 = u.pn * 256 + wc * 32 + 8 * fq;
        if (pm < 4) {
            const float l2g = log2gamma(pm), ginv = __builtin_amdgcn_exp2f(-l2g);
#pragma unroll
            for (int m = 0; m < 4; ++m) {
                const int i = wr * 64 + m * 16 + fr;
#pragma unroll
                for (int bj = 0; bj < 2; ++bj) {
                    const int tok = tok0 + bj * 128, pos = tok & (SEQ - 1);
                    const f32x4* cp = (const f32x4*)(cosT + i * SEQ + pos); const f32x4* sp = (const f32x4*)(sinT + i * SEQ + pos);
                    f32x4 o1[2], o2[2];
                    float zr = __builtin_amdgcn_exp2f((float)((RCH - 1) - (pos & (RCH - 1))) * l2g) * 0.0625f;
#pragma unroll
                    for (int n = 0; n < 2; ++n) { const f32x4 c = cp[n], s = sp[n], t1 = acc[0][bj][m][n], t2 = acc[1][bj][m][n];
                        f32x4 z;
#pragma unroll
                        for (int e = 0; e < 4; ++e) { z[e] = zr; zr *= ginv; }
                        o1[n] = (t1 * c - t2 * s) * z; o2[n] = (t1 * s + t2 * c) * z; }
                    st_tfrag(kzT, pm * 256 + i, tok, TH, o1[0], o1[1]);
                    st_tfrag(kzT, pm * 256 + 128 + i, tok, TH, o2[0], o2[1]);
                    __builtin_amdgcn_sched_barrier(0);
                }
            }
        } else {
            bf16_t* dst = kzT + (size_t)(pm < 12 ? 8u << 20 : 24u << 20); const int ch0 = (pm < 12 ? (pm - 4) : (pm - 12)) * 256 + wr * 64 + fr;
#pragma unroll
            for (int ai = 0; ai < 2; ++ai)
#pragma unroll
                for (int m = 0; m < 4; ++m)
#pragma unroll
                    for (int bj = 0; bj < 2; ++bj)
                        st_tfrag(dst, ch0 + ai * 128 + m * 16, tok0 + bj * 128, TH, acc[ai][bj][m][0], acc[ai][bj][m][1]);
        }
    }
};

template <int MODE> struct EpiEw {
    static constexpr bool PERM = true, AFTER_DRAIN = false;
    bf16_t* O; const bf16_t* P; int ld;
    DI void operator()(const f32x4 (&acc)[2][2][4][2], const Unit& u, int wr, int wc, int fr_, int fq) const {
        int fr = fr_; asm volatile("" : "+v"(fr));
        const int row0 = u.pm * 256 + wr * 64 + fr, col0 = u.pn * 256 + wc * 32 + 8 * fq;
#pragma unroll
        for (int ai = 0; ai < 2; ++ai)
#pragma unroll
            for (int m = 0; m < 4; ++m)
#pragma unroll
                for (int bj = 0; bj < 2; ++bj) {
                    const size_t off = (size_t)(row0 + ai * 128 + m * 16) * ld + col0 + bj * 128;
                    f32x4 v0 = acc[ai][bj][m][0], v1 = acc[ai][bj][m][1];
                    if (MODE == 0) {
#pragma unroll
                        for (int e = 0; e < 4; ++e) { v0[e] = sigmoidf_(v0[e]); v1[e] = sigmoidf_(v1[e]); }
                    } else if (MODE == 1) {
#pragma unroll
                        for (int e = 0; e < 4; ++e) { const float a = fmaxf(v0[e], 0.f), b = fmaxf(v1[e], 0.f); v0[e] = a * a; v1[e] = b * b; }
                    } else if (MODE == 2) {
                        f32x4 a, b; unpack8(*(const u32x4*)(O + off), a, b); v0 = v0 * a; v1 = v1 * b;
                    } else {
                        f32x4 a, b, c, d; unpack8(*(const u32x4*)(O + off), a, b); unpack8(*(const u32x4*)(P + off), c, d); v0 = a + c * v0; v1 = b + d * v1;
                    }
                    *(u32x4*)(O + off) = pack8(v0, v1);
                }
    }
};

struct EpiRes {
    static constexpr bool PERM = true, AFTER_DRAIN = false;
    const float* xin; float* xout; const float* gate;
    DI void operator()(const f32x4 (&acc)[2][2][4][2], const Unit& u, int wr, int wc, int fr_, int fq) const {
        int fr = fr_; asm volatile("" : "+v"(fr));
        const int row0 = u.pm * 256 + wr * 64 + fr, col0 = u.pn * 256 + wc * 32 + 8 * fq;
#pragma unroll
        for (int ai = 0; ai < 2; ++ai)
#pragma unroll
            for (int m = 0; m < 4; ++m) {
                const int row = row0 + ai * 128 + m * 16; const float* gp = gate + (row >> 12) * NMOD;
#pragma unroll
                for (int bj = 0; bj < 2; ++bj) {
                    const int col = col0 + bj * 128; const size_t off = (size_t)row * DM + col;
                    const f32x4 g0 = *(const f32x4*)(gp + col), g1 = *(const f32x4*)(gp + col + 4);
                    const f32x4 x0 = *(const f32x4*)(xin + off), x1 = *(const f32x4*)(xin + off + 4);
                    *(f32x4*)(xout + off) = x0 + g0 * acc[ai][bj][m][0]; *(f32x4*)(xout + off + 4) = x1 + g1 * acc[ai][bj][m][1];
                }
            }
    }
};

DI void cvt_tile(const float* src, int ldsrc, int k0, int n0, bf16_t* dst1, bf16_t* dst2, int K, LAS float* tile, int tid) {
    const int kr = tid >> 4, nc = (tid & 15) * 4;
#pragma unroll
    for (int p = 0; p < 2; ++p) { const int k = kr + 32 * p; const f32x4 v = *(const f32x4*)(src + (size_t)(k0 + k) * ldsrc + n0 + nc);
        tile[k * 65 + nc] = v[0]; tile[k * 65 + nc + 1] = v[1]; tile[k * 65 + nc + 2] = v[2]; tile[k * 65 + nc + 3] = v[3]; }
    __syncthreads();
    const int n = tid >> 3, ks = (tid & 7) * 8; const LAS float* s = tile + ks * 65 + n;
    u32x4 o; o.x = pk2(s[0], s[65]); o.y = pk2(s[2 * 65], s[3 * 65]); o.z = pk2(s[4 * 65], s[5 * 65]); o.w = pk2(s[6 * 65], s[7 * 65]);
    *(u32x4*)(dst1 + (size_t)n * K + k0 + ks) = o;
    if (dst2) *(u32x4*)(dst2 + (size_t)n * K + k0 + ks) = o;
    __syncthreads();
}

struct Params {
    const float *x, *c, *norm_mix_g, *w_in, *w_ret_out, *w_sb_out, *w_mix_out, *norm_mlp_g, *w_up, *w_down, *w_ada, *b_ada, *final_g;
    float* out; unsigned char* ws;
};

DI void convert_weights(const Params& p, int l, LAS float* tile, int tid) {
    unsigned char* ws = p.ws;
    bf16_t* WinA = (bf16_t*)(ws + WS_WINA); bf16_t* WinB = (bf16_t*)(ws + WS_WINB); bf16_t* Wg = (bf16_t*)(ws + WS_WG);
    constexpr int I_IN = 16 * 176, I_RET = 32 * 16, I_SB = 16 * 16, I_MIX = 16 * 16, I_UP = 16 * 64, I_DN = 64 * 16;
    constexpr int NIT = I_IN + I_RET + I_SB + I_MIX + I_UP + I_DN;
    for (int it = blockIdx.x; it < NIT; it += gridDim.x) {
        int r = it;
        if (r < I_IN) {
            const int kb = r / 176, nb = r % 176, n0 = nb * 64; bf16_t* d1; bf16_t* d2 = nullptr;
            if (n0 < 1024) d1 = WinA + (size_t)n0 * 1024;
            else if (n0 < 2048) { d1 = WinA + (size_t)n0 * 1024; d2 = WinB + (size_t)(n0 - 1024) * 1024; }
            else if (n0 < 4096) d1 = WinB + (size_t)(n0 - 1024) * 1024;
            else if (n0 < 8192) d1 = WinA + (size_t)(n0 - 2048) * 1024;
            else if (n0 < 9216) d1 = WinB + (size_t)(n0 - 5120) * 1024;
            else d1 = Wg + (size_t)(n0 - 9216) * 1024;
            cvt_tile(p.w_in + (size_t)l * DM * INW, INW, kb * 64, n0, d1, d2, 1024, tile, tid); continue;
        }
        r -= I_IN;
        if (r < I_RET) { const int kb = r / 16, nb = r % 16; cvt_tile(p.w_ret_out + (size_t)l * 2048 * 1024, 1024, kb * 64, nb * 64, (bf16_t*)(ws + WS_WRET) + (size_t)nb * 64 * 2048, nullptr, 2048, tile, tid); continue; }
        r -= I_RET;
        if (r < I_SB) { const int kb = r / 16, nb = r % 16; cvt_tile(p.w_sb_out + (size_t)l * 1024 * 1024, 1024, kb * 64, nb * 64, (bf16_t*)(ws + WS_WSB) + (size_t)nb * 64 * 1024, nullptr, 1024, tile, tid); continue; }
        r -= I_SB;
        if (r < I_MIX) { const int kb = r / 16, nb = r % 16; cvt_tile(p.w_mix_out + (size_t)l * 1024 * 1024, 1024, kb * 64, nb * 64, (bf16_t*)(ws + WS_WMIX) + (size_t)nb * 64 * 1024, nullptr, 1024, tile, tid); continue; }
        r -= I_MIX;
        if (r < I_UP) { const int kb = r / 64, nb = r % 64; cvt_tile(p.w_up + (size_t)l * 1024 * 4096, 4096, kb * 64, nb * 64, (bf16_t*)(ws + WS_WUP) + (size_t)nb * 64 * 1024, nullptr, 1024, tile, tid); continue; }
        r -= I_UP;
        { const int kb = r / 16, nb = r % 16; cvt_tile(p.w_down + (size_t)l * 4096 * 1024, 1024, kb * 64, nb * 64, (bf16_t*)(ws + WS_WDN) + (size_t)nb * 64 * 4096, nullptr, 4096, tile, tid); }
    }
}

DI void tables_and_mod(const Params& p, LAS float* lds, int tid) {
    float* cosP = (float*)(p.ws + WS_COSP); float* sinP = (float*)(p.ws + WS_SINP); float* cosT = (float*)(p.ws + WS_COST); float* sinT = (float*)(p.ws + WS_SINT);
    for (int idx = blockIdx.x * 512 + tid; idx < SEQ * 128; idx += gridDim.x * 512) {
        const int pos = idx >> 7, i = idx & 127;
        const float inv = powf(10000.0f, -(float)i / 128.0f); const float ang = (float)pos * inv;
        const float c = cosf(ang), s = sinf(ang);
        cosP[idx] = c; sinP[idx] = s; cosT[i * SEQ + pos] = c; sinT[i * SEQ + pos] = s;
    }
    float* mod = (float*)(p.ws + WS_MOD);
    LAS float* cact = lds; LAS float* red = lds + 4096;
    const int wave = tid >> 6, lane = tid & 63;
    bool have = false;
    for (int it = blockIdx.x; it < 2 * 96; it += gridDim.x) {
        if (!have) { for (int e = tid; e < 4096; e += 512) { const float v = p.c[e]; cact[e] = v * sigmoidf_(v); } have = true; __syncthreads(); }
        const int l = it / 96, c0 = (it % 96) * 64;
        const float* w = p.w_ada + (size_t)l * DM * NMOD + c0 + lane;
        float a0 = 0.f, a1 = 0.f, a2 = 0.f, a3 = 0.f;
#pragma unroll 8
        for (int k = wave * 128; k < wave * 128 + 128; ++k) { const float wv = w[(size_t)k * NMOD]; a0 += cact[k] * wv; a1 += cact[1024 + k] * wv; a2 += cact[2048 + k] * wv; a3 += cact[3072 + k] * wv; }
        red[(wave * 4 + 0) * 64 + lane] = a0; red[(wave * 4 + 1) * 64 + lane] = a1; red[(wave * 4 + 2) * 64 + lane] = a2; red[(wave * 4 + 3) * 64 + lane] = a3;
        __syncthreads();
        if (tid < 256) { const int b = tid >> 6; float s = p.b_ada[l * NMOD + c0 + lane];
#pragma unroll
            for (int w8 = 0; w8 < 8; ++w8) s += red[(w8 * 4 + b) * 64 + lane];
            mod[(size_t)(l * 4 + b) * NMOD + c0 + lane] = s; }
        __syncthreads();
    }
}

DI void norm_phase(const float* xin, const float* g, const float* modl, int shift_i, int scale_i, bf16_t* hout, int gw, int ngw, int lane) {
    for (int row = gw; row < T; row += ngw) {
        const f32x4* xr = (const f32x4*)(xin + (size_t)row * DM) + lane;
        f32x4 v[4]; float s = 0.f;
#pragma unroll
        for (int j = 0; j < 4; ++j) { v[j] = xr[64 * j]; s += (v[j][0] * v[j][0] + v[j][1] * v[j][1]) + (v[j][2] * v[j][2] + v[j][3] * v[j][3]); }
        const float rstd = 1.0f / sqrtf(wave_sum(s) * (1.0f / DM) + 1e-6f);
        const float* mb = modl + (row >> 12) * NMOD;
        u32x2* o8 = (u32x2*)(hout + (size_t)row * DM) + lane;
#pragma unroll
        for (int j = 0; j < 4; ++j) { const int col = 4 * (lane + 64 * j);
            const f32x4 gg = *(const f32x4*)(g + col), sc = *(const f32x4*)(mb + scale_i * 1024 + col), sh = *(const f32x4*)(mb + shift_i * 1024 + col);
            const f32x4 y = v[j] * rstd * gg * (sc + 1.0f) + sh;
            u32x2 w; w.x = pk2(y[0], y[1]); w.y = pk2(y[2], y[3]); o8[64 * j] = w; }
    }
}
DI void final_norm_phase(float* x, const float* g, int gw, int ngw, int lane) {
    for (int row = gw; row < T; row += ngw) {
        f32x4* xr = (f32x4*)(x + (size_t)row * DM) + lane;
        f32x4 v[4]; float s = 0.f;
#pragma unroll
        for (int j = 0; j < 4; ++j) { v[j] = xr[64 * j]; s += (v[j][0] * v[j][0] + v[j][1] * v[j][1]) + (v[j][2] * v[j][2] + v[j][3] * v[j][3]); }
        const float rstd = 1.0f / sqrtf(wave_sum(s) * (1.0f / DM) + 1e-6f);
#pragma unroll
        for (int j = 0; j < 4; ++j) { const f32x4 gg = *(const f32x4*)(g + 4 * (lane + 64 * j)); xr[64 * j] = v[j] * rstd * gg; }
    }
}

struct StateOrder {
    int G, c;
    __device__ __forceinline__ bool next(int i, Unit& u) const { const long L = (long)i * G + c; if (L >= 256) return false; u.pm = (int)L; u.pn = 0; return true; }
    __device__ __forceinline__ void a_ready(const Unit&) const {}
    __device__ __forceinline__ void done(const Unit&) const {}
    __device__ __forceinline__ const char* aptr(const pg8::Gemm& g, const Unit& u, size_t) const { const int bh = u.pm >> 5, n = (u.pm >> 1) & 15, dvh = u.pm & 1, bl = bh >> 2, h = bh & 3;
        return (const char*)g.A + ((size_t)(h * 16 + dvh * 8) * g.ns + bl * (SEQ / 16) + n * (RCH / 16)) * 1024; }
    __device__ __forceinline__ const char* bptr(const pg8::Gemm& g, const Unit& u, size_t) const { const int bh = u.pm >> 5, n = (u.pm >> 1) & 15, bl = bh >> 2, h = bh & 3;
        return (const char*)g.Bt + ((size_t)(h * 8) * g.ns + bl * (SEQ / 16) + n * (RCH / 16)) * 1024; }
};
static_assert(NRCH == 16 && RCH == 256, "StateOrder unit decoding");
struct EpiU {
    static constexpr bool PERM = true, AFTER_DRAIN = false;
    bf16_t* U;
    DI void operator()(const f32x4 (&acc)[2][2][4][2], const Unit& u, int wr, int wc, int fr_, int fq) const {
        int fr = fr_; asm volatile("" : "+v"(fr));
        const int bh = u.pm >> 5, n = (u.pm >> 1) & 15, dvh = u.pm & 1;
        bf16_t* base = U + (size_t)(bh * NRCH + n) * (512 * 256);
#pragma unroll
        for (int ai = 0; ai < 2; ++ai)
#pragma unroll
            for (int m = 0; m < 4; ++m) { const int dv = dvh * 256 + ai * 128 + wr * 64 + m * 16 + fr;
#pragma unroll
                for (int bj = 0; bj < 2; ++bj) { const int dk0 = bj * 128 + wc * 32 + 8 * fq;
                    *(u32x4*)(base + (size_t)((dv >> 5) * 16 + (dk0 >> 4)) * 512 + ((dk0 >> 3) & 1) * 256 + (dv & 31) * 8) = pack8(acc[ai][bj][m][0], acc[ai][bj][m][1]); } }
    }
};
DI void ret_scan(bf16_t* rs, int gtid, int nthreads) {
    for (int e = gtid; e < 8 * 16384; e += nthreads) {
        const int bh = e >> 14, piece = e & 16383; const float dec = __builtin_amdgcn_exp2f((float)RCH * log2gamma(bh & 3));
        u32x4* p = (u32x4*)(rs + (size_t)bh * NRCH * (512 * 256) + (size_t)piece * 8);
        u32x4 uv[NRCH];
#pragma unroll
        for (int n = 0; n < NRCH; ++n) uv[n] = p[(size_t)n * (512 * 256 / 8)];
        f32x4 r0 = {0.f, 0.f, 0.f, 0.f}, r1 = {0.f, 0.f, 0.f, 0.f};
#pragma unroll
        for (int n = 0; n < NRCH; ++n) { p[(size_t)n * (512 * 256 / 8)] = pack8(r0, r1); f32x4 a, b; unpack8(uv[n], a, b); r0 = r0 * dec + a; r1 = r1 * dec + b; }
    }
}

template <bool DIAG> DI void sb_tile(const f32x16& st, int j, int tq, int hh, float& carry, float (&aw)[16]) {
    float lp[16], gs[4], pg[4];
#pragma unroll
    for (int i = 0; i < 16; ++i) { const float z = st[i];
        const float spv = fmaxf(z, 0.f) + __builtin_amdgcn_logf(1.0f + __builtin_amdgcn_exp2f(-fabsf(z)));
        lp[i] = (!DIAG || (j * 32 + crow(i, hh)) < tq) ? -spv : 0.f; }
#pragma unroll
    for (int g = 0; g < 4; ++g) { gs[g] = (lp[4 * g] + lp[4 * g + 1]) + (lp[4 * g + 2] + lp[4 * g + 3]); pg[g] = __shfl_xor(gs[g], 32); }
    float after = carry;
#pragma unroll
    for (int g = 3; g >= 0; --g) {
        float run = after + (hh == 0 ? pg[g] : 0.f);
#pragma unroll
        for (int e = 3; e >= 0; --e) { const int i = 4 * g + e;
            const float w = __builtin_amdgcn_exp2f(st[i] + lp[i] + run);
            aw[i] = (!DIAG || (j * 32 + crow(i, hh)) < tq) ? w : 0.f; run += lp[i]; }
        after += gs[g] + pg[g];
    }
    carry = after;
}
DI void sb_item(int item, const bf16_t* sq, const bf16_t* sk, const bf16_t* svT, bf16_t* ysb, int lane) {
    const int qt = 127 - (item & 127), h = (item >> 7) & 15, bl = item >> 11, r = lane & 31, hh = lane >> 5;
    const size_t rowbase = (size_t)bl * SEQ; const int tq = qt * 32 + r;
    const int rt0 = (int)(rowbase >> 5);
    const bf16_t* qp = sq + (((size_t)(rt0 + qt) * 64 + h * 4) * 2 + hh) * 256 + r * 8;
    bf16x8 qf[4];
#pragma unroll
    for (int ks = 0; ks < 4; ++ks) qf[ks] = *(const bf16x8*)(qp + ks * 512);
    f32x16 o0, o1;
#pragma unroll
    for (int i = 0; i < 16; ++i) { o0[i] = 0.f; o1[i] = 0.f; }
    float carry = 0.f;
    const bf16_t* kbase = sk + (((size_t)rt0 * 64 + h * 4) * 2 + hh) * 256 + r * 8;
    const bf16_t* vbase = svT + (((size_t)(h * 2) * (TH / 16) + (rowbase >> 4)) * 2 + hh) * 256 + r * 8;
    bf16x8 kc[4], vc[4];
#pragma unroll
    for (int ks = 0; ks < 4; ++ks) kc[ks] = *(const bf16x8*)(kbase + (size_t)qt * 64 * 512 + ks * 512);
    vc[0] = *(const bf16x8*)(vbase + (size_t)qt * 1024); vc[1] = *(const bf16x8*)(vbase + (size_t)qt * 1024 + 512);
    vc[2] = *(const bf16x8*)(vbase + (size_t)(TH / 16) * 512 + (size_t)qt * 1024); vc[3] = *(const bf16x8*)(vbase + (size_t)(TH / 16) * 512 + (size_t)qt * 1024 + 512);
    for (int j = qt; j >= 0; --j) {
        bf16x8 kn[4], vn[4];
        const int jn = j > 0 ? j - 1 : 0;
#pragma unroll
        for (int ks = 0; ks < 4; ++ks) kn[ks] = *(const bf16x8*)(kbase + (size_t)jn * 64 * 512 + ks * 512);
        vn[0] = *(const bf16x8*)(vbase + (size_t)jn * 1024); vn[1] = *(const bf16x8*)(vbase + (size_t)jn * 1024 + 512);
        vn[2] = *(const bf16x8*)(vbase + (size_t)(TH / 16) * 512 + (size_t)jn * 1024); vn[3] = *(const bf16x8*)(vbase + (size_t)(TH / 16) * 512 + (size_t)jn * 1024 + 512);
        f32x16 st;
#pragma unroll
        for (int i = 0; i < 16; ++i) st[i] = 0.f;
        st = MFMA32(kc[0], qf[0], st); st = MFMA32(kc[1], qf[1], st); st = MFMA32(kc[2], qf[2], st); st = MFMA32(kc[3], qf[3], st);
        float aw[16];
        if (j == qt) sb_tile<true>(st, j, tq, hh, carry, aw); else sb_tile<false>(st, j, tq, hh, carry, aw);
        {
            u32x4 bw; bw.x = pk2(aw[0], aw[1]); bw.y = pk2(aw[2], aw[3]); bw.z = pk2(aw[4], aw[5]); bw.w = pk2(aw[6], aw[7]);
            const bf16x8 b0 = __builtin_bit_cast(bf16x8, bw);
            bw.x = pk2(aw[8], aw[9]); bw.y = pk2(aw[10], aw[11]); bw.z = pk2(aw[12], aw[13]); bw.w = pk2(aw[14], aw[15]);
            const bf16x8 b1 = __builtin_bit_cast(bf16x8, bw);
            o0 = MFMA32(vc[0], b0, o0); o1 = MFMA32(vc[2], b0, o1); o0 = MFMA32(vc[1], b1, o0); o1 = MFMA32(vc[3], b1, o1);
        }
        if (__all(carry < SB_STOP)) break;
#pragma unroll
        for (int ks = 0; ks < 4; ++ks) { kc[ks] = kn[ks]; vc[ks] = vn[ks]; }
    }
    bf16_t* op = ysb + (rowbase + tq) * 1024 + h * 64 + 4 * hh;
#pragma unroll
    for (int g = 0; g < 4; ++g) {
        u32x2 w; w.x = pk2(o0[4 * g], o0[4 * g + 1]); w.y = pk2(o0[4 * g + 2], o0[4 * g + 3]); *(u32x2*)(op + 8 * g) = w;
        u32x2 w1; w1.x = pk2(o1[4 * g], o1[4 * g + 1]); w1.y = pk2(o1[4 * g + 2], o1[4 * g + 3]); *(u32x2*)(op + 32 + 8 * g) = w1;
    }
}

DI void ret_out_item(int item, const bf16_t* qr, const bf16_t* kn, const bf16_t* vT, const bf16_t* rsnap, bf16_t* yret, LAS unsigned char* lds, int wave, int lane) {
    const int bh = item >> 5, c = (item >> 3) & 1, n = ((item >> 4) & 1) * 8 + (item & 7), tg = n * CPG + c, bl = bh >> 2, h = bh & 3, r = lane & 31, hh = lane >> 5;
    const int a = c * 4, tokg = tg * 128;
    static_assert(CPG == 2, "item decoding above assumes two 128-token groups per retention chunk");
    const size_t rowbase = (size_t)bl * SEQ; const int rt0 = (int)(rowbase >> 5);
    const float l2g = log2gamma(h);
    LAS float* stats = (LAS float*)(lds + 131072 + 256);
    {
        const int tt = wave & 3, par = wave >> 2, tq = tokg + tt * 32 + r;
        const bf16_t* qp = qr + (((size_t)(rt0 + (tokg >> 5) + tt) * 64 + h * 16) * 2 + hh) * 256 + r * 8;
        bf16x8 qf[16];
#pragma unroll
        for (int ks = 0; ks < 16; ++ks) qf[ks] = *(const bf16x8*)(qp + ks * 512);
        for (int jk = par; jk <= a + tt; jk += 2) {
            const int keyt = n * (RCH / 32) + jk;
            const bf16_t* kp = kn + (((size_t)(rt0 + keyt) * 64 + h * 16) * 2 + hh) * 256 + r * 8;
            f32x16 st;
#pragma unroll
            for (int i = 0; i < 16; ++i) st[i] = 0.f;
#pragma unroll
            for (int ks = 0; ks < 16; ++ks) st = MFMA32(*(const bf16x8*)(kp + ks * 512), qf[ks], st);
            float pw[16];
#pragma unroll
            for (int i = 0; i < 16; ++i) { const int d = tq - (keyt * 32 + crow(i, hh)); pw[i] = d >= 0 ? st[i] * __builtin_amdgcn_exp2f((float)d * l2g) : 0.f; }
#pragma unroll
            for (int s = 0; s < 2; ++s) {
                u32x4 bw; bw.x = pk2(pw[8 * s], pw[8 * s + 1]); bw.y = pk2(pw[8 * s + 2], pw[8 * s + 3]); bw.z = pk2(pw[8 * s + 4], pw[8 * s + 5]); bw.w = pk2(pw[8 * s + 6], pw[8 * s + 7]);
                *(LAS u32x4*)(lds + ((2 * jk + s) * 4 + tt) * 1024 + lane * 16) = bw;
            }
        }
    }
    __syncthreads();
    f32x16 acc[8];
#pragma unroll
    for (int q = 0; q < 8; ++q)
#pragma unroll
        for (int i = 0; i < 16; ++i) acc[q][i] = 0.f;
    {
        const bf16_t* rp = rsnap + (size_t)(bh * NRCH + n) * (512 * 256) + (size_t)(wave * 2 * 16) * 512 + hh * 256 + r * 8;
        const bf16_t* qg = qr + (((size_t)(rt0 + (tokg >> 5)) * 64 + h * 16) * 2 + hh) * 256 + r * 8;
#pragma unroll 2
        for (int ks = 0; ks < 16; ++ks) {
            const bf16x8 a0 = *(const bf16x8*)(rp + ks * 512), a1 = *(const bf16x8*)(rp + (16 + ks) * 512);
#pragma unroll
            for (int tt = 0; tt < 4; ++tt) { const bf16x8 b = *(const bf16x8*)(qg + (size_t)(tt * 64 + ks) * 512);
                acc[tt] = MFMA32(a0, b, acc[tt]); acc[4 + tt] = MFMA32(a1, b, acc[4 + tt]); }
        }
#pragma unroll
        for (int tt = 0; tt < 4; ++tt) { const float xi = __builtin_amdgcn_exp2f((float)(((tokg + tt * 32 + r) & (RCH - 1)) + 1) * l2g);
#pragma unroll
            for (int i = 0; i < 16; ++i) { acc[tt][i] *= xi; acc[4 + tt][i] *= xi; } }
    }
    {
        const bf16_t* vb = vT + (((size_t)(h * 16 + wave * 2) * (TH / 16) + (rowbase >> 4) + n * (RCH / 16)) * 2 + hh) * 256 + r * 8;
        const int ns = 2 * (a + 4);
#pragma unroll 2
        for (int s = 0; s < ns; ++s) {
            const bf16x8 a0 = *(const bf16x8*)(vb + (size_t)s * 512), a1 = *(const bf16x8*)(vb + (size_t)(TH / 16 + s) * 512);
            const int ttmin = (s >> 1) - a;
#pragma unroll
            for (int tt = 0; tt < 4; ++tt) if (tt >= ttmin) { const bf16x8 b = *(const LAS bf16x8*)(lds + (s * 4 + tt) * 1024 + lane * 16);
                acc[tt] = MFMA32(a0, b, acc[tt]); acc[4 + tt] = MFMA32(a1, b, acc[4 + tt]); }
        }
    }
#pragma unroll
    for (int tt = 0; tt < 4; ++tt) {
        float s1 = 0.f, s2 = 0.f;
#pragma unroll
        for (int i = 0; i < 16; ++i) { const float v0 = acc[tt][i], v1 = acc[4 + tt][i]; s1 += v0 + v1; s2 += v0 * v0 + v1 * v1; }
        s1 += __shfl_xor(s1, 32); s2 += __shfl_xor(s2, 32);
        if (hh == 0) { stats[(wave * 128 + tt * 32 + r) * 2] = s1; stats[(wave * 128 + tt * 32 + r) * 2 + 1] = s2; }
    }
    __syncthreads();
#pragma unroll
    for (int tt = 0; tt < 4; ++tt) {
        float s1 = 0.f, s2 = 0.f;
#pragma unroll
        for (int w = 0; w < 8; ++w) { s1 += stats[(w * 128 + tt * 32 + r) * 2]; s2 += stats[(w * 128 + tt * 32 + r) * 2 + 1]; }
        const float mu = s1 * (1.0f / 512.0f), var = fmaxf(s2 * (1.0f / 512.0f) - mu * mu, 0.f), rstd = 1.0f / sqrtf(var + 1e-5f);
        bf16_t* op = yret + (rowbase + tokg + tt * 32 + r) * 2048 + h * 512 + wave * 64 + 4 * hh;
#pragma unroll
        for (int dvt = 0; dvt < 2; ++dvt)
#pragma unroll
            for (int g = 0; g < 4; ++g) {
                u32x2* pp = (u32x2*)(op + dvt * 32 + 8 * g); const u32x2 gv = *pp; const f32x16& o = acc[dvt * 4 + tt];
                u32x2 w; w.x = pk2(bflo(gv.x) * (o[4 * g] - mu) * rstd, bfhi(gv.x) * (o[4 * g + 1] - mu) * rstd);
                w.y = pk2(bflo(gv.y) * (o[4 * g + 2] - mu) * rstd, bfhi(gv.y) * (o[4 * g + 3] - mu) * rstd); *pp = w;
            }
    }
    __syncthreads();
}

#define XB_TMO      128
#define XB_XCNT(j)  (256  + 64 * (j))
#define XB_XSUB(j)  (1280 + 64 * (j))
#define XB_XGEN(j)  (2304 + 64 * (j))
#define XB_TOP      3328
#define XB_TOPGEN   3392
#define XCD_BAR_WORDS 3456
#define XB_SPIN_CAP (1u << 18)

__device__ __forceinline__ unsigned xb_ld(unsigned* p)              { return __hip_atomic_load(p, __ATOMIC_RELAXED, __HIP_MEMORY_SCOPE_AGENT); }
__device__ __forceinline__ unsigned xb_add(unsigned* p, unsigned v) { return __hip_atomic_fetch_add(p, v, __ATOMIC_RELAXED, __HIP_MEMORY_SCOPE_AGENT); }
__device__ __forceinline__ unsigned xb_xcc_id() { return (unsigned)__builtin_amdgcn_s_getreg((3 << 11) | 20) & 0xFu; }
#define XB_SPIN(cond, bar) do { unsigned _sp = 0; while (cond) { __builtin_amdgcn_s_sleep(1); \
    if ((++_sp & 255u) == 0u) { if (xb_ld(&(bar)[XB_TMO])) break; if (_sp > XB_SPIN_CAP) { atomicAdd(&(bar)[XB_TMO], 1u); break; } } } } while (0)

struct XcdBarrier {
    unsigned* bar; unsigned x;
    volatile LAS unsigned* st;
};

__device__ __forceinline__ XcdBarrier xcd_barrier_post(unsigned* bar, volatile LAS unsigned* st) {
    XcdBarrier b; b.bar = bar; b.x = xb_xcc_id(); b.st = st;
    if (threadIdx.x == 0) (void)xb_add(&bar[XB_XCNT(b.x)], 1u);
    return b;
}
__device__ __forceinline__ void xcd_barrier_complete(unsigned* bar, unsigned x, unsigned& nloc, unsigned& nx) {
    const unsigned G = gridDim.x * gridDim.y * gridDim.z;
    unsigned sum, cnt, mine, sp = 0u;
    for (;;) {
        sum = 0u; cnt = 0u; mine = 0u;
#pragma unroll
        for (unsigned j = 0; j < 16; ++j) { const unsigned c = xb_ld(&bar[XB_XCNT(j)]); sum += c; cnt += (c > 0u) ? 1u : 0u; mine = (j == x) ? c : mine; }
        if (sum == G) break;
        __builtin_amdgcn_s_sleep(1);
        if ((++sp & 255u) == 0u) { if (xb_ld(&bar[XB_TMO])) break; if (sp > XB_SPIN_CAP) { atomicAdd(&bar[XB_TMO], 1u); break; } }
    }
    nloc = mine > 0u ? mine : 1u; nx = cnt > 0u ? cnt : 1u;
}

__device__ __forceinline__ void xcd_barrier(const XcdBarrier& b) {
    asm volatile("s_waitcnt vmcnt(0)" ::: "memory");
    __syncthreads();
    if (threadIdx.x == 0) {
        unsigned* bar = b.bar;
        __builtin_amdgcn_s_waitcnt(0);
        unsigned nloc = b.st[0], nx = b.st[1];
        if (nloc == 0u) { xcd_barrier_complete(bar, b.x, nloc, nx); b.st[0] = nloc; b.st[1] = nx; }
        const unsigned old = xb_add(&bar[XB_XSUB(b.x)], 1u);
        const unsigned gen = old / nloc;
        if (old + 1u == (gen + 1u) * nloc) {
            __builtin_amdgcn_fence(__ATOMIC_RELEASE, "agent");
            asm volatile("s_waitcnt vmcnt(0)" ::: "memory");
            const unsigned og = xb_add(&bar[XB_TOP], 1u);
            const unsigned tg = og / nx;
            if (og + 1u == (tg + 1u) * nx) xb_add(&bar[XB_TOPGEN], 1u);
            else XB_SPIN(xb_ld(&bar[XB_TOPGEN]) == tg, bar);
            __builtin_amdgcn_fence(__ATOMIC_ACQUIRE, "agent");
            xb_add(&bar[XB_XGEN(b.x)], 1u);
            asm volatile("s_waitcnt vmcnt(0)" ::: "memory");
        } else {
            XB_SPIN(xb_ld(&bar[XB_XGEN(b.x)]) == gen, bar);
            __builtin_amdgcn_fence(__ATOMIC_ACQUIRE, "agent");
            asm volatile("s_waitcnt vmcnt(0)" ::: "memory");
        }
    }
    __syncthreads();
}

__global__ void __launch_bounds__(512, 2) hybrid_fwd(Params p) {
    extern __shared__ __attribute__((aligned(16))) unsigned char lds_raw[];
    cg::grid_group grid = cg::this_grid();
    PG8_LAS unsigned char* lds = (PG8_LAS unsigned char*)lds_raw;
    LAS float* ldsf = (LAS float*)lds_raw;
#if PROBE_CLASS >= 0
    unsigned long long tacc = 0, tst = 0;
#define TSTART() (tst = __builtin_amdgcn_s_memrealtime())
#define TSTOP(c) do { if ((c) == PROBE_CLASS) tacc += __builtin_amdgcn_s_memrealtime() - tst; } while (0)
#else
#define TSTART() ((void)0)
#define TSTOP(c) ((void)0)
#endif
    volatile LAS unsigned* xst = (volatile LAS unsigned*)(lds_raw + 131072 + 64);
    if (threadIdx.x < 2) xst[threadIdx.x] = 0u;
    __syncthreads();
    const XcdBarrier xbar = xcd_barrier_post((unsigned*)(p.ws + WS_BAR), xst);
#define GBAR() xcd_barrier(xbar)
#if PROBE_CLASS == 9
#define GSYNC(site) do { GBAR(); TSTART(); GBAR(); TSTOP(9); } while (0)
#else
#define GSYNC(site) do { TSTART(); GBAR(); if ((PROBE_SITEMASK >> (site)) & 1) TSTOP(0); } while (0)
#endif
#define PH_BEGIN int tid = threadIdx.x; asm volatile("" : "+v"(tid)); int bx = blockIdx.x, G = gridDim.x; asm volatile("" : "+s"(bx), "+s"(G)); \
    unsigned char* ws = p.ws; asm volatile("" : "+s"(ws)); float* xo = p.out; asm volatile("" : "+s"(xo)); \
    const int lane = tid & 63, wave = __builtin_amdgcn_readfirstlane(tid >> 6), gw = bx * 8 + wave, ngw = G * 8; (void)lane; (void)wave; (void)gw; (void)ngw; \
    const float* modl = (const float*)(ws + WS_MOD) + (size_t)l * 4 * NMOD; (void)modl; bf16_t* H = (bf16_t*)(ws + WS_H); (void)H;
#pragma unroll 1
    for (int l = 0; l < 2; ++l) {
        TSTART(); { PH_BEGIN
          if (l == 0) { tables_and_mod(p, ldsf, tid); __syncthreads(); }
          convert_weights(p, l, ldsf, tid); } TSTOP(4);
        if (l == 0) grid.sync();
        TSTART(); { PH_BEGIN
          norm_phase(l == 0 ? p.x : xo, p.norm_mix_g + l * DM, modl, 0, 1, H, gw, ngw, lane); } TSTOP(5);
        GSYNC(1);
#pragma unroll 1
        for (int half = 0; half < 2; ++half) {
            TSTART(); { PH_BEGIN
              pg8::Gemm g{H + (size_t)half * TH * DM, (const bf16_t*)(ws + WS_WINA), TH, 6144, DM}; pg8::StaticOrder S; S.init(TH, 6144, G, bx);
              EpiInA E{(bf16_t*)(ws + WS_X), (bf16_t*)(ws + WS_YRET) + (size_t)half * TH * 2048, (const float*)(ws + WS_COSP), (const float*)(ws + WS_SINP)};
              pg8::gemm_phase<EpiInA, pg8::StaticOrder, true, true>(lds, g, S, E); } TSTOP(1);
            TSTART(); { PH_BEGIN
              pg8::Gemm g{(const bf16_t*)(ws + WS_WINB), H + (size_t)half * TH * DM, 4096, TH, DM}; pg8::StaticOrder S; S.init(4096, TH, G, bx);
              EpiInB E{(bf16_t*)(ws + WS_KZT), (const float*)(ws + WS_COST), (const float*)(ws + WS_SINT)};
              pg8::gemm_phase<EpiInB, pg8::StaticOrder, true, true>(lds, g, S, E); } TSTOP(1);
            GSYNC(2);
            TSTART(); { PH_BEGIN
              pg8::Gemm g{(const bf16_t*)(ws + WS_VT), (const bf16_t*)(ws + WS_KZT), 256, 256, RCH, 1, TH / 16}; StateOrder S{G, bx};
              EpiU E{(bf16_t*)(ws + WS_RSNAP)};
              pg8::gemm_phase<EpiU, StateOrder, false, true>(lds, g, S, E); } TSTOP(2);
            GSYNC(10);
            TSTART(); { PH_BEGIN
              ret_scan((bf16_t*)(ws + WS_RSNAP), bx * 512 + tid, G * 512);
              for (int it = gw; it < SB_STATIC; it += ngw)
                  sb_item(it, (const bf16_t*)(ws + WS_SQ), (const bf16_t*)(ws + WS_SK), (const bf16_t*)(ws + WS_SVT), (bf16_t*)(ws + WS_YSB) + (size_t)half * TH * 1024, lane); } TSTOP(6);
            GSYNC(3);
            TSTART(); { PH_BEGIN
              for (int it = bx; it < 256; it += G) ret_out_item(it, (const bf16_t*)(ws + WS_QR), (const bf16_t*)(ws + WS_KN), (const bf16_t*)(ws + WS_VT), (const bf16_t*)(ws + WS_RSNAP), (bf16_t*)(ws + WS_YRET) + (size_t)half * TH * 2048, (LAS unsigned char*)lds_raw, wave, lane);
              unsigned* qctr = (unsigned*)(ws + WS_BAR) + (l * 2 + half) * 16;
              for (;;) {
                  unsigned nx = 0; if (lane == 0) nx = __hip_atomic_fetch_add(qctr, 1u, __ATOMIC_RELAXED, __HIP_MEMORY_SCOPE_AGENT);
                  const unsigned it = (unsigned)SB_STATIC + (unsigned)__builtin_amdgcn_readfirstlane(nx);
                  if (it >= 4096u) break;
                  sb_item((int)it, (const bf16_t*)(ws + WS_SQ), (const bf16_t*)(ws + WS_SK), (const bf16_t*)(ws + WS_SVT), (bf16_t*)(ws + WS_YSB) + (size_t)half * TH * 1024, lane);
              } } TSTOP(3);
            GSYNC(4);
        }
        TSTART(); { PH_BEGIN pg8::StaticOrder S; S.init(T, DM, G, bx);
          pg8::Gemm g{H, (const bf16_t*)(ws + WS_WG), T, DM, DM}; EpiEw<0> E{(bf16_t*)(ws + WS_MERGED), nullptr, DM}; pg8::gemm_phase<EpiEw<0>, pg8::StaticOrder, false, true>(lds, g, S, E); } TSTOP(7);
        TSTART(); { PH_BEGIN pg8::StaticOrder S; S.init(T, DM, G, bx);
          pg8::Gemm g{(const bf16_t*)(ws + WS_YRET), (const bf16_t*)(ws + WS_WRET), T, DM, 2048}; EpiEw<2> E{(bf16_t*)(ws + WS_MERGED), nullptr, DM}; pg8::gemm_phase<EpiEw<2>, pg8::StaticOrder, false, true>(lds, g, S, E); } TSTOP(7);
        TSTART(); { PH_BEGIN pg8::StaticOrder S; S.init(T, DM, G, bx);
          pg8::Gemm g{H, (const bf16_t*)(ws + WS_WG) + (size_t)1024 * 1024, T, DM, DM}; EpiEw<0> E{(bf16_t*)(ws + WS_TMP), nullptr, DM}; pg8::gemm_phase<EpiEw<0>, pg8::StaticOrder, false, true>(lds, g, S, E); } TSTOP(7);
        TSTART(); { PH_BEGIN pg8::StaticOrder S; S.init(T, DM, G, bx);
          pg8::Gemm g{(const bf16_t*)(ws + WS_YSB), (const bf16_t*)(ws + WS_WSB), T, DM, DM}; EpiEw<3> E{(bf16_t*)(ws + WS_MERGED), (const bf16_t*)(ws + WS_TMP), DM}; pg8::gemm_phase<EpiEw<3>, pg8::StaticOrder, false, true>(lds, g, S, E); } TSTOP(7);
        GSYNC(5);
        TSTART(); { PH_BEGIN pg8::StaticOrder S; S.init(T, DM, G, bx);
          pg8::Gemm g{(const bf16_t*)(ws + WS_MERGED), (const bf16_t*)(ws + WS_WMIX), T, DM, DM}; EpiRes E{l == 0 ? p.x : xo, xo, modl + 2 * 1024};
          pg8::gemm_phase<EpiRes, pg8::StaticOrder, false, true>(lds, g, S, E); } TSTOP(7);
        GSYNC(6);
        TSTART(); { PH_BEGIN
          norm_phase(xo, p.norm_mlp_g + l * DM, modl, 3, 4, H, gw, ngw, lane); } TSTOP(5);
        GSYNC(7);
        TSTART(); { PH_BEGIN pg8::StaticOrder S; S.init(T, FF, G, bx);
          pg8::Gemm g{H, (const bf16_t*)(ws + WS_WUP), T, FF, DM}; EpiEw<1> E{(bf16_t*)(ws + WS_U), nullptr, FF};
          pg8::gemm_phase<EpiEw<1>, pg8::StaticOrder, true, true>(lds, g, S, E); } TSTOP(8);
        GSYNC(8);
        TSTART(); { PH_BEGIN pg8::StaticOrder S; S.init(T, DM, G, bx);
          pg8::Gemm g{(const bf16_t*)(ws + WS_U), (const bf16_t*)(ws + WS_WDN), T, DM, FF}; EpiRes E{xo, xo, modl + 5 * 1024};
          pg8::gemm_phase<EpiRes, pg8::StaticOrder, false, true>(lds, g, S, E); } TSTOP(8);
        GSYNC(9);
    }
    TSTART(); { const int l = 0; PH_BEGIN
      final_norm_phase(xo, p.final_g, gw, ngw, lane); } TSTOP(5);
#if PROBE_CLASS >= 0
    grid.sync();
    if (blockIdx.x == 0) { const unsigned kk = (unsigned)(tacc * 4ull / 25ull);
        for (unsigned i = threadIdx.x; i < kk; i += 512) p.out[i] += 0.1f; }
#endif
#undef PH_BEGIN
}

extern "C" void kernel_launch(void* const* d_in, const int* in_sizes, int n_in, void* d_out, int out_size, void* d_ws, size_t ws_size, hipStream_t stream) {
    static int grid_blocks = 0;
    if (grid_blocks == 0) {
        if (n_in != 13 || out_size != T * DM || ws_size < WS_END) { fprintf(stderr, "kernel_launch: unexpected shapes (n_in %d out %d ws %zu need %zu)\n", n_in, out_size, ws_size, (size_t)WS_END); grid_blocks = -1; return; }
        int dev = 0, cus = 0, per_cu = 0;
        (void)hipGetDevice(&dev); (void)hipDeviceGetAttribute(&cus, hipDeviceAttributeMultiprocessorCount, dev);
        if (hipFuncSetAttribute((const void*)hybrid_fwd, hipFuncAttributeMaxDynamicSharedMemorySize, LDS_BYTES) != hipSuccess) { fprintf(stderr, "kernel_launch: hipFuncSetAttribute failed\n"); grid_blocks = -1; return; }
        if (hipOccupancyMaxActiveBlocksPerMultiprocessor(&per_cu, (const void*)hybrid_fwd, 512, LDS_BYTES) != hipSuccess || per_cu < 1) { fprintf(stderr, "kernel_launch: occupancy query gave %d\n", per_cu); per_cu = 1; (void)hipGetLastError(); }
        grid_blocks = cus * per_cu;
    }
    if (grid_blocks < 0) return;
    Params p{};
    p.x = (const float*)d_in[0]; p.c = (const float*)d_in[1]; p.norm_mix_g = (const float*)d_in[2]; p.w_in = (const float*)d_in[3]; p.w_ret_out = (const float*)d_in[4];
    p.w_sb_out = (const float*)d_in[5]; p.w_mix_out = (const float*)d_in[6]; p.norm_mlp_g = (const float*)d_in[7]; p.w_up = (const float*)d_in[8]; p.w_down = (const float*)d_in[9];
    p.w_ada = (const float*)d_in[10]; p.b_ada = (const float*)d_in[11]; p.final_g = (const float*)d_in[12];
    p.out = (float*)d_out; p.ws = (unsigned char*)d_ws;
    if (hipMemsetAsync((char*)d_ws + WS_BAR, 0, XCD_BAR_WORDS * 4, stream) != hipSuccess) { fprintf(stderr, "kernel_launch: memset failed\n"); return; }
    void* args[] = {&p};
    hipError_t e = hipLaunchCooperativeKernel((const void*)hybrid_fwd, dim3(grid_blocks), dim3(512), args, LDS_BYTES, stream);
    if (e != hipSuccess) fprintf(stderr, "kernel_launch: cooperative launch failed: %s (grid %d)\n", hipGetErrorString(e), grid_blocks);
}
```
